# Optimizing an MI355X kernel written in HIP

```python
import jax, jax.numpy as jnp
from jax import lax
import numpy as np

D_MODEL = 1024
BATCH = 4
SEQ = 8192
DEPTH = 4

N_MIXERS = 2
PLE_DIM = 256
EPS = 1e-6
NEG_BIG = -1e30

A_HEADS = 16
A_KV_HEADS = 4
A_GROUP = A_HEADS // A_KV_HEADS
A_HEAD_DIM = D_MODEL // A_HEADS
A_WIDTH = A_HEADS * A_HEAD_DIM
A_KV_WIDTH = A_KV_HEADS * A_HEAD_DIM
A_IN = A_WIDTH + 2 * A_KV_WIDTH + A_WIDTH
WINDOW = 128
BLOCK = 128

B_HEADS = 16
B_NOPE = 64
B_ROPE = 32
B_VDIM = 64
B_WIDTH = B_HEADS * B_VDIM
Q_LORA = 384
KV_LORA = 256
B_IN = Q_LORA + KV_LORA + B_ROPE + B_WIDTH
ROPE_THETA = 10000.0
Q_BLOCK = 128

N_A = (DEPTH + 1) // 2
N_B = DEPTH // 2

kernel_name = "hybrid_swa_sink_alibi_mla_encoder"


def rms_norm(x, g):
    xf = x.astype(jnp.float32)
    y = xf * lax.rsqrt(jnp.mean(xf * xf, axis=-1, keepdims=True) + EPS)
    return (y * g.astype(jnp.float32)).astype(x.dtype)


def alibi_slopes(n):
    return 2.0 ** (-8.0 * jnp.arange(1, n + 1, dtype=jnp.float32) / n)


def rotate(x, cos, sin):
    half = x.shape[-1] // 2
    x1, x2 = x[..., :half], x[..., half:]
    return jnp.concatenate([x1 * cos - x2 * sin, x1 * sin + x2 * cos], axis=-1)


def windowed_gqa(u, w_in, sink, w_out):
    B_, S, _ = u.shape
    nb = S // BLOCK
    proj = u @ w_in
    q, k, v, z = jnp.split(proj, [A_WIDTH, A_WIDTH + A_KV_WIDTH, A_WIDTH + 2 * A_KV_WIDTH], axis=-1)
    q = q.reshape(B_, nb, BLOCK, A_KV_HEADS, A_GROUP, A_HEAD_DIM).swapaxes(0, 1)
    k = k.reshape(B_, S, A_KV_HEADS, A_HEAD_DIM)
    v = v.reshape(B_, S, A_KV_HEADS, A_HEAD_DIM)
    pad = ((0, 0), (BLOCK, BLOCK), (0, 0), (0, 0))
    kp = jnp.pad(k, pad)
    vp = jnp.pad(v, pad)
    scale = A_HEAD_DIM ** -0.5
    slopes = alibi_slopes(A_HEADS).reshape(A_KV_HEADS, A_GROUP)
    sink_l = sink.astype(jnp.float32).reshape(A_KV_HEADS, A_GROUP)
    qi = jnp.arange(BLOCK)
    kj = jnp.arange(3 * BLOCK)
    rel = (kj[None, :] - BLOCK) - qi[:, None]
    dist = jnp.abs(rel).astype(jnp.float32)
    in_window = jnp.abs(rel) <= WINDOW

    def block_fn(args):
        q_blk, b = args
        start = b * BLOCK
        k_blk = lax.dynamic_slice_in_dim(kp, start, 3 * BLOCK, axis=1)
        v_blk = lax.dynamic_slice_in_dim(vp, start, 3 * BLOCK, axis=1)
        s_pos = start - BLOCK + kj
        valid = in_window & ((s_pos >= 0) & (s_pos < S))[None, :]
        logits = jnp.einsum('bqkgd,bskd->bkgqs', q_blk, k_blk).astype(jnp.float32) * scale
        logits = logits - slopes[:, :, None, None] * dist
        logits = jnp.where(valid, logits, NEG_BIG)
        sink_col = jnp.broadcast_to(sink_l[None, :, :, None, None], logits.shape[:-1] + (1,))
        probs = jax.nn.softmax(jnp.concatenate([logits, sink_col], axis=-1), axis=-1)[..., :-1]
        return jnp.einsum('bkgqs,bskd->bqkgd', probs.astype(v_blk.dtype), v_blk)

    o = lax.map(block_fn, (q, jnp.arange(nb)))
    o = o.swapaxes(0, 1).reshape(B_, S, A_WIDTH)
    return (o * jax.nn.silu(z)) @ w_out


def mla(u, w_in, q_norm, w_qb, kv_norm, w_kvb, w_out):
    B_, S, _ = u.shape
    nb = S // Q_BLOCK
    proj = u @ w_in
    cq, ckv, k_rope, z = jnp.split(proj, [Q_LORA, Q_LORA + KV_LORA, Q_LORA + KV_LORA + B_ROPE], axis=-1)
    q = (rms_norm(cq, q_norm) @ w_qb).reshape(B_, S, B_HEADS, B_NOPE + B_ROPE)
    q_nope, q_rope = q[..., :B_NOPE], q[..., B_NOPE:]
    kv = (rms_norm(ckv, kv_norm) @ w_kvb).reshape(B_, S, B_HEADS, B_NOPE + B_VDIM)
    k_nope, v = kv[..., :B_NOPE], kv[..., B_NOPE:]
    half = B_ROPE // 2
    inv_freq = ROPE_THETA ** (-jnp.arange(half, dtype=jnp.float32) / half)
    ang = jnp.arange(S, dtype=jnp.float32)[:, None] * inv_freq[None, :]
    cos, sin = jnp.cos(ang).astype(u.dtype), jnp.sin(ang).astype(u.dtype)
    q_rope = rotate(q_rope, cos[:, None, :], sin[:, None, :])
    k_rope = rotate(k_rope, cos, sin)
    scale = (B_NOPE + B_ROPE) ** -0.5
    qn = q_nope.reshape(B_, nb, Q_BLOCK, B_HEADS, B_NOPE).swapaxes(0, 1)
    qr = q_rope.reshape(B_, nb, Q_BLOCK, B_HEADS, B_ROPE).swapaxes(0, 1)

    def block_fn(args):
        qn_b, qr_b = args
        logits = (jnp.einsum('bqhd,bshd->bhqs', qn_b, k_nope)
                  + jnp.einsum('bqhr,bsr->bhqs', qr_b, k_rope)).astype(jnp.float32) * scale
        probs = jax.nn.softmax(logits, axis=-1)
        return jnp.einsum('bhqs,bshd->bqhd', probs.astype(v.dtype), v)

    o = lax.map(block_fn, (qn, qr)).swapaxes(0, 1).reshape(B_, S, B_WIDTH)
    return (o * jax.nn.silu(z)) @ w_out


def setup_inputs(seed: int = 0) -> dict:
    key = jax.random.key(seed)
    ks = jax.random.split(key, 18)
    f32 = jnp.float32
    nrm = lambda k, shape, s: jax.random.normal(k, shape, f32) * s
    gain = lambda k, shape: 1.0 + 0.05 * jax.random.normal(k, shape, f32)
    return {
        "x": jax.random.normal(ks[0], (BATCH, SEQ, D_MODEL), f32),
        "p": jax.random.normal(ks[1], (DEPTH, BATCH, SEQ, PLE_DIM), f32),
        "norm_g": gain(ks[2], (DEPTH, D_MODEL)),
        "a_w_in": nrm(ks[3], (N_A, D_MODEL, A_IN), D_MODEL ** -0.5),
        "a_sink": nrm(ks[4], (N_A, A_HEADS), 1.0),
        "a_w_out": nrm(ks[5], (N_A, A_WIDTH, D_MODEL), A_WIDTH ** -0.5),
        "b_w_in": nrm(ks[6], (N_B, D_MODEL, B_IN), D_MODEL ** -0.5),
        "b_q_norm": gain(ks[7], (N_B, Q_LORA)),
        "b_w_qb": nrm(ks[8], (N_B, Q_LORA, B_HEADS * (B_NOPE + B_ROPE)), Q_LORA ** -0.5),
        "b_kv_norm": gain(ks[9], (N_B, KV_LORA)),
        "b_w_kvb": nrm(ks[10], (N_B, KV_LORA, B_HEADS * (B_NOPE + B_VDIM)), KV_LORA ** -0.5),
        "b_w_out": nrm(ks[11], (N_B, B_WIDTH, D_MODEL), B_WIDTH ** -0.5),
        "ple_w": nrm(ks[12], (DEPTH, PLE_DIM, D_MODEL), PLE_DIM ** -0.5),
        "ple_norm_g": gain(ks[13], (DEPTH, D_MODEL)),
        "ple_w_gate": nrm(ks[14], (DEPTH, D_MODEL, D_MODEL), D_MODEL ** -0.5),
        "final_norm_g": gain(ks[15], (D_MODEL,)),
    }


def reference(x, p, norm_g, a_w_in, a_sink, a_w_out, b_w_in, b_q_norm, b_w_qb,
              b_kv_norm, b_w_kvb, b_w_out, ple_w, ple_norm_g, ple_w_gate, final_norm_g):
    h = x
    for i in range(DEPTH):
        u = rms_norm(h, norm_g[i])
        j = i // N_MIXERS
        if i % N_MIXERS == 0:
            y = windowed_gqa(u, a_w_in[j], a_sink[j], a_w_out[j])
        else:
            y = mla(u, b_w_in[j], b_q_norm[j], b_w_qb[j], b_kv_norm[j], b_w_kvb[j], b_w_out[j])
        h = h + y
        gate = jax.nn.sigmoid(rms_norm(h, ple_norm_g[i]) @ ple_w_gate[i])
        h = h + (p[i] @ ple_w[i]) * gate
    return rms_norm(h, final_norm_g)
```

```cpp
#include <hip/hip_runtime.h>
#include <hip/hip_cooperative_groups.h>
#include <cstdio>
#include <cstring>
namespace cg = cooperative_groups;

#ifndef PROBE_REPEAT
#define PROBE_REPEAT 0
#endif
#ifndef PROBE_SYNC2
#define PROBE_SYNC2 0
#endif
#if PROBE_SYNC2
#define GSYNC() do { xcd_barrier(xb); xcd_barrier(xb); } while (0)
#else
#define GSYNC() xcd_barrier(xb)
#endif
#ifndef MULTI_LAUNCH
#define MULTI_LAUNCH 0
#endif

#define DI __device__ __forceinline__
typedef __attribute__((ext_vector_type(8))) short bf16x8;
typedef __attribute__((ext_vector_type(16))) float f32x16;
typedef unsigned short bf16_t;

constexpr int T = 32768, S = 8192, NB = 4, DM = 1024, PLE = 256;
constexpr int NTHREADS = 512;
constexpr float LOG2E = 1.4426950408889634f;
constexpr float EPS = 1e-6f;

constexpr size_t MiB = 1024ull * 1024ull;
constexpr size_t OFF_HB = 0;
constexpr size_t OFF_Z = 64 * MiB;
constexpr size_t OFF_Q = 128 * MiB;
constexpr size_t OFF_K = 224 * MiB;
constexpr size_t OFF_VT = 288 * MiB;
constexpr size_t OFF_CQ = 352 * MiB;
constexpr size_t OFF_CKV = 376 * MiB;
constexpr size_t OFF_KR = 392 * MiB;
constexpr size_t OFF_SSQH = 394 * MiB;
constexpr size_t OFF_SSQM = 395 * MiB;
constexpr size_t OFF_SSQC = 396 * MiB;
constexpr size_t OFF_ROPE = 397 * MiB;
constexpr size_t OFF_W = 398 * MiB;
constexpr size_t OFF_PB = 438 * MiB;
constexpr size_t OFF_BAR = 502 * MiB;
constexpr size_t W_A_IN = 0;
constexpr size_t W_A_OUT = W_A_IN + 2ull * 2560 * 1024;
constexpr size_t W_B_IN = W_A_OUT + 2ull * 1024 * 1024;
constexpr size_t W_B_QB = W_B_IN + 2ull * 1792 * 1024;
constexpr size_t W_B_KVB = W_B_QB + 2ull * 1536 * 384;
constexpr size_t W_B_OUT = W_B_KVB + 2ull * 2048 * 256;
constexpr size_t W_PLE = W_B_OUT + 2ull * 1024 * 1024;
constexpr size_t W_GATE = W_PLE + 4ull * 1024 * 256;
constexpr size_t W_END = W_GATE + 4ull * 1024 * 1024;
static_assert(OFF_W + W_END * 2 <= OFF_PB, "weights overflow");
constexpr size_t WS_NEEDED = OFF_BAR + 1 * MiB;

struct Seg {
  const float* src;
  const float* gain;
  bf16_t* dst;
  int src_ld, ncols, K, tile0;
  int fp8, pad0;
};
constexpr int MAXSEG = 32;

struct Params {
  const float *x, *p, *a_sink, *final_g;
  float* out;
  char* ws;
  Seg seg[MAXSEG];
  int nseg, ntile_w;
  int phase_lo, phase_hi;
};

typedef __attribute__((ext_vector_type(2))) float f32x2_t;
typedef __attribute__((ext_vector_type(2))) __bf16 bf16x2_t;
DI unsigned pack2(float a, float b) {
  f32x2_t v = {a, b};
  return __builtin_bit_cast(unsigned, __builtin_convertvector(v, bf16x2_t));
}
DI unsigned f2bf(float x) { return pack2(x, 0.f) & 0xffffu; }
DI float xhalf_max(float x) {
  return fmaxf(x, __shfl_xor(x, 32));
}
DI float bf2f(unsigned h) { return __uint_as_float(h << 16); }
DI int crow(int i, int h) { return (i & 3) + 8 * (i >> 2) + 4 * h; }
DI int perm16(int s) {
  int k = s & 15;
  int c = k >> 2;
  int pc = ((c & 1) << 1) | (c >> 1);
  return (s & ~15) | (pc << 2) | (k & 3);
}
#define MFMA(a, b, c) __builtin_amdgcn_mfma_f32_32x32x16_bf16((a), (b), (c), 0, 0, 0)
DI int get_tid() {
  int t = threadIdx.x;
  asm volatile("" : "+v"(t));
  return t;
}
template <typename TP>
DI TP* uniform_ptr(TP* p) {
  unsigned lo = (unsigned)(size_t)p, hi = (unsigned)((size_t)p >> 32);
  lo = __builtin_amdgcn_readfirstlane(lo);
  hi = __builtin_amdgcn_readfirstlane(hi);
  asm volatile("" : "+s"(lo), "+s"(hi));
  return (TP*)(((size_t)hi << 32) | (size_t)lo);
}
DI unsigned pack4_fp8(float a, float b, float c, float d);
DI unsigned pack4_fp8c(float a, float b, float c, float d);
DI float clamp8(float x);
DI float wave_xor_sum32(float v) { return v + __shfl_xor(v, 32); }

DI void prep_phase(const Params& P, char* lds) {
  const int tid = get_tid();
  float* tl = (float*)lds;
  for (int t = blockIdx.x; t < P.ntile_w; t += gridDim.x) {
    int si = 0;
    for (int i = 1; i < P.nseg; ++i)
      if (t >= P.seg[i].tile0) si = i;
    const Seg sg = P.seg[si];
    const int lt = t - sg.tile0;
    const int ncb = sg.ncols >> 5;
    const int kb = lt / ncb, nb = lt - kb * ncb;
    const int k0 = kb * 64, n0 = nb * 32;
    __syncthreads();
    {
      const int n = tid & 31;
#pragma unroll
      for (int i = 0; i < 4; ++i) {
        const int k = (tid >> 5) + 16 * i;
        float v = 0.f;
        if (sg.src) {
          v = sg.src[(size_t)(k0 + k) * sg.src_ld + n0 + n];
          if (sg.gain) v *= sg.gain[k0 + k];
        }
        tl[k * 33 + n] = v;
      }
    }
    __syncthreads();
    {
      const int kk4 = (tid & 15) * 4, n = tid >> 4;
      const float w0 = tl[(kk4 + 0) * 33 + n], w1 = tl[(kk4 + 1) * 33 + n], w2 = tl[(kk4 + 2) * 33 + n], w3 = tl[(kk4 + 3) * 33 + n];
      if (sg.fp8) {
        *(unsigned*)((unsigned char*)sg.dst + (size_t)(n0 + n) * sg.K + k0 + kk4) = pack4_fp8c(w0 * 64.f, w1 * 64.f, w2 * 64.f, w3 * 64.f);
      } else {
        uint2 o2;
        o2.x = pack2(w0, w1);
        o2.y = pack2(w2, w3);
        *(uint2*)(sg.dst + (size_t)(n0 + n) * sg.K + k0 + kk4) = o2;
      }
    }
  }
  {
    char* ws = uniform_ptr(P.ws);
    bf16_t* hb = (bf16_t*)(ws + OFF_HB);
    float* ssq = (float*)(ws + OFF_SSQH);
    const int w = tid >> 6, lane = tid & 63;
    for (int row = blockIdx.x * 8 + w; row < T; row += gridDim.x * 8) {
      const float4* xr = (const float4*)(P.x + (size_t)row * DM);
      float s = 0.f;
#pragma unroll
      for (int i = 0; i < 4; ++i) {
        float4 v = xr[lane + 64 * i];
        s += v.x * v.x + v.y * v.y + v.z * v.z + v.w * v.w;
        uint2 o;
        o.x = pack2(v.x, v.y);
        o.y = pack2(v.z, v.w);
        *(uint2*)(hb + (size_t)row * DM + (lane + 64 * i) * 4) = o;
      }
#pragma unroll
      for (int o = 32; o >= 1; o >>= 1) s += __shfl_xor(s, o);
      if (lane < 8) ssq[(size_t)row * 8 + lane] = (lane == 0) ? s : 0.f;
    }
  }
  {
    bf16_t* pb = (bf16_t*)(uniform_ptr(P.ws) + OFF_PB);
    const size_t n8 = (size_t)4 * T * PLE / 8;
    for (size_t e = (size_t)blockIdx.x * NTHREADS + tid; e < n8; e += (size_t)gridDim.x * NTHREADS) {
      const float4 v0 = ((const float4*)P.p)[2 * e], v1 = ((const float4*)P.p)[2 * e + 1];
      uint4 o;
      o.x = pack2(v0.x, v0.y);
      o.y = pack2(v0.z, v0.w);
      o.z = pack2(v1.x, v1.y);
      o.w = pack2(v1.z, v1.w);
      ((uint4*)pb)[e] = o;
    }
  }
  {
    float* rt = (float*)(uniform_ptr(P.ws) + OFF_ROPE);
    for (int e = blockIdx.x * NTHREADS + tid; e < S * 16; e += gridDim.x * NTHREADS) {
      const int s = e >> 4, i = e & 15;
      const double inv = exp2(-(double)i * (13.287712379549449 / 16.0));
      const double rev = (double)s * inv * 0.15915494309189535;
      const float fr = (float)(rev - floor(rev));
      rt[s * 32 + i] = __builtin_amdgcn_cosf(fr);
      rt[s * 32 + 16 + i] = __builtin_amdgcn_sinf(fr);
    }
  }
}

typedef __attribute__((ext_vector_type(4))) float f32x4;
constexpr int GBK = 64, GKS = 2;
constexpr int GTILE_B = 256 * GBK * 2;
constexpr int GSTAGE_B = 2 * GTILE_B;
constexpr int LDS_BYTES = 2 * GSTAGE_B;

DI int lds_byte(int r, int c) {
  int st = (r >> 4) * GKS + (c >> 5), ob = (r & 15) * 64 + (c & 31) * 2;
  return st * 1024 + (ob ^ (((ob >> 9) & 1) << 5));
}
DI void stage_rc(int b, int& R, int& C) {
  int st = b >> 10, sb = b & 1023, swz = sb ^ (((sb >> 9) & 1) << 5);
  R = (st / GKS) * 16 + swz / 64;
  C = (st % GKS) * 32 + (swz % 64) / 2;
}
#define WAIT_V0() asm volatile("s_waitcnt vmcnt(0)" ::: "memory")

DI void gemm_core(f32x4 (&acc)[8][4], const bf16_t* Wb, const bf16_t* Xb, int K, char* shm) {
  const int tid = get_tid();
  const int wid = tid >> 6, lane = tid & 63, wr = wid >> 2, wc = wid & 3, fr = lane & 15, fq = lane >> 4;
  int sR[4], sC[4];
#pragma unroll
  for (int i = 0; i < 4; ++i) stage_rc(wid * 1024 + i * 8192 + lane * 16, sR[i], sC[i]);
  const int nt = K / GBK;
#define GSRC(base, i, kt) ((base) + (size_t)sR[i] * K + (kt) * GBK + sC[i])
#define GLDS_STAGE(buf, kt)                                                                                           \
  do {                                                                                                                \
    _Pragma("unroll") for (int i = 0; i < 4; ++i) {                                                                   \
      __builtin_amdgcn_global_load_lds((const unsigned*)GSRC(Wb, i, kt),                                             \
                                       (unsigned*)(shm + (buf) * GSTAGE_B + wid * 1024 + i * 8192), 16, 0, 0);        \
      __builtin_amdgcn_global_load_lds((const unsigned*)GSRC(Xb, i, kt),                                             \
                                       (unsigned*)(shm + (buf) * GSTAGE_B + GTILE_B + wid * 1024 + i * 8192), 16, 0, 0); \
    }                                                                                                                 \
  } while (0)
  __syncthreads();
  GLDS_STAGE(0, 0);
  WAIT_V0();
  __syncthreads();
#pragma unroll 1
  for (int t = 0; t < nt; ++t) {
    const int cur = t & 1;
    if (t + 1 < nt) GLDS_STAGE(cur ^ 1, t + 1);
    const char* sa = shm + cur * GSTAGE_B;
    const char* sb = sa + GTILE_B;
#pragma unroll
    for (int ks = 0; ks < GKS; ++ks) {
      bf16x8 At[8], Bf[4];
#pragma unroll
      for (int m = 0; m < 8; ++m) At[m] = *(const bf16x8*)(sa + lds_byte(wr * 128 + m * 16 + fr, ks * 32 + fq * 8));
#pragma unroll
      for (int n = 0; n < 4; ++n) Bf[n] = *(const bf16x8*)(sb + lds_byte(wc * 64 + n * 16 + fr, ks * 32 + fq * 8));
#pragma unroll
      for (int m = 0; m < 8; ++m)
#pragma unroll
        for (int n = 0; n < 4; ++n) acc[m][n] = __builtin_amdgcn_mfma_f32_16x16x32_bf16(At[m], Bf[n], acc[m][n], 0, 0, 0);
      __builtin_amdgcn_sched_barrier(0);
    }
    WAIT_V0();
    __syncthreads();
  }
#undef GSRC
#undef GLDS_STAGE
}

typedef __attribute__((ext_vector_type(8))) int i32x8g;
DI i32x8g ld32g(const char* p0, const char* p1) {
  const uint4 a = *(const uint4*)p0, b = *(const uint4*)p1;
  i32x8g r = {(int)a.x, (int)a.y, (int)a.z, (int)a.w, (int)b.x, (int)b.y, (int)b.z, (int)b.w};
  return r;
}
DI void gemm_core8(f32x4 (&acc)[8][4], const unsigned char* Wb, const unsigned char* Xb, int K, char* shm, int sw, int sx) {
  const int tid = get_tid();
  const int wid = tid >> 6, lane = tid & 63, wr = wid >> 2, wc = wid & 3, fr = lane & 15, fq = lane >> 4;
  int sR[4], sC[4];
#pragma unroll
  for (int i = 0; i < 4; ++i) stage_rc(wid * 1024 + i * 8192 + lane * 16, sR[i], sC[i]);
  const int nt = K / 128;
#define GSRC8(base, i, kt) ((base) + (size_t)sR[i] * K + (kt) * 128 + sC[i] * 2)
#define GLDS_STAGE8(buf, kt)                                                                                          \
  do {                                                                                                                \
    _Pragma("unroll") for (int i = 0; i < 4; ++i) {                                                                   \
      __builtin_amdgcn_global_load_lds((const unsigned*)GSRC8(Wb, i, kt),                                            \
                                       (unsigned*)(shm + (buf) * GSTAGE_B + wid * 1024 + i * 8192), 16, 0, 0);        \
      __builtin_amdgcn_global_load_lds((const unsigned*)GSRC8(Xb, i, kt),                                            \
                                       (unsigned*)(shm + (buf) * GSTAGE_B + GTILE_B + wid * 1024 + i * 8192), 16, 0, 0); \
    }                                                                                                                 \
  } while (0)
  __syncthreads();
  GLDS_STAGE8(0, 0);
  WAIT_V0();
  __syncthreads();
#pragma unroll 1
  for (int t = 0; t < nt; ++t) {
    const int cur = t & 1;
    if (t + 1 < nt) GLDS_STAGE8(cur ^ 1, t + 1);
    const char* sa = shm + cur * GSTAGE_B;
    const char* sb = sa + GTILE_B;
    i32x8g Bf[4];
#pragma unroll
    for (int n = 0; n < 4; ++n)
      Bf[n] = ld32g(sb + lds_byte(wc * 64 + n * 16 + fr, fq * 8), sb + lds_byte(wc * 64 + n * 16 + fr, 32 + fq * 8));
#pragma unroll
    for (int mh = 0; mh < 2; ++mh) {
      i32x8g At[4];
#pragma unroll
      for (int m = 0; m < 4; ++m)
        At[m] = ld32g(sa + lds_byte(wr * 128 + (mh * 4 + m) * 16 + fr, fq * 8), sa + lds_byte(wr * 128 + (mh * 4 + m) * 16 + fr, 32 + fq * 8));
#pragma unroll
      for (int m = 0; m < 4; ++m)
#pragma unroll
        for (int n = 0; n < 4; ++n)
          acc[mh * 4 + m][n] = __builtin_amdgcn_mfma_scale_f32_16x16x128_f8f6f4(At[m], Bf[n], acc[mh * 4 + m][n], 0, 0, 0, sw, 0, sx);
    }
    __builtin_amdgcn_sched_barrier(0);
    WAIT_V0();
    __syncthreads();
  }
#undef GSRC8
#undef GLDS_STAGE8
}
constexpr int SC_ONE = 0x7f7f7f7f;
constexpr int SC_M6 = 0x79797979;
constexpr int SC_M4 = 0x7b7b7b7b;

DI float sum8(const float* p) {
  const float4* q = (const float4*)p;
  float4 a = q[0], b = q[1];
  return (a.x + a.y + a.z + a.w) + (b.x + b.y + b.z + b.w);
}
DI float quad_sum(float v) {
  v += __shfl_xor(v, 16);
  v += __shfl_xor(v, 32);
  return v;
}

DI unsigned pack4_fp8(float a, float b, float c, float d);
DI int perm64(int s);
enum { EPI_A_IN = 0, EPI_B_IN = 1, EPI_QKV_UP = 2, EPI_OUT = 3, EPI_PLE = 4 };

DI void store4bf(bf16_t* dst, float a, float b, float c, float d) {
  uint2 o;
  o.x = pack2(a, b);
  o.y = pack2(c, d);
  *(uint2*)dst = o;
}
DI void store_vt4(bf16_t* dst, float a, float b, float c, float d) {
  dst[0] = (bf16_t)f2bf(a);
  dst[S] = (bf16_t)f2bf(b);
  dst[2 * S] = (bf16_t)f2bf(c);
  dst[3 * S] = (bf16_t)f2bf(d);
}

template <int EPI>
DI void gemm_phase(const Params& P, int layer, char* lds) {
  const int tid = get_tid();
  const int wid = tid >> 6, lane = tid & 63, wr = wid >> 2, wc = wid & 3, fr = lane & 15, fq = lane >> 4;
  const int j = layer >> 1;
  char* ws = uniform_ptr(P.ws);
  bf16_t* wbase = (bf16_t*)(ws + OFF_W);
  bf16_t* hb = (bf16_t*)(ws + OFF_HB);
  bf16_t* og = (bf16_t*)(ws + OFF_HB);
  bf16_t* zb = (bf16_t*)(ws + OFF_Z);
  bf16_t* hmb = (bf16_t*)(ws + OFF_Z);
  bf16_t* qb = (bf16_t*)(ws + OFF_Q);
  bf16_t* eb = (bf16_t*)(ws + OFF_Q);
  bf16_t* kb = (bf16_t*)(ws + OFF_K);
  bf16_t* vt = (bf16_t*)(ws + OFF_VT);
  bf16_t* cqb = (bf16_t*)(ws + OFF_CQ);
  bf16_t* ckvb = (bf16_t*)(ws + OFF_CKV);
  bf16_t* krb = (bf16_t*)(ws + OFF_KR);
  const bf16_t* pbb = (const bf16_t*)(ws + OFF_PB);
  float* ssqh = (float*)(ws + OFF_SSQH);
  float* ssqm = (float*)(ws + OFF_SSQM);
  float* ssqc = (float*)(ws + OFF_SSQC);
  const float* rope = (const float*)(ws + OFF_ROPE);

  int NT, ntiles;
  if constexpr (EPI == EPI_A_IN) { NT = 10; ntiles = 128 * 10; }
  else if constexpr (EPI == EPI_B_IN) { NT = 7; ntiles = 128 * 7; }
  else if constexpr (EPI == EPI_QKV_UP) { NT = 14; ntiles = 128 * 14; }
  else if constexpr (EPI == EPI_OUT) { NT = 4; ntiles = 128 * 8; }
  else { NT = 4; ntiles = 128 * 4; }

  for (int tile = blockIdx.x; tile < ntiles; tile += gridDim.x) {
    int t2 = tile;
    bool second = false;
    if constexpr (EPI == EPI_OUT) {
      if (t2 >= 512) { second = true; t2 -= 512; }
    }
    int mt = t2 / NT, nt = t2 - mt * NT;
    if (gridDim.x == 256) {
      const int x = blockIdx.x & 7, s = blockIdx.x >> 3, k = t2 >> 8;
      const int idx = s + 32 * k;
      mt = (idx / NT) * 8 + x;
      nt = idx - (idx / NT) * NT;
    }
    const int m0 = mt * 256, n0 = nt * 256;
    f32x4 acc[8][4];
#pragma unroll
    for (int m = 0; m < 8; ++m)
#pragma unroll
      for (int n = 0; n < 4; ++n) acc[m][n] = f32x4{0.f, 0.f, 0.f, 0.f};

    if constexpr (EPI == EPI_A_IN) {
      gemm_core(acc, wbase + W_A_IN + (size_t)j * 2560 * 1024 + (size_t)n0 * 1024, hb + (size_t)m0 * 1024, 1024, lds);
      const float qs = 0.125f * LOG2E;
#pragma unroll
      for (int n = 0; n < 4; ++n) {
        const int tok = m0 + wc * 64 + n * 16 + fr;
        const float rstd = rsqrtf(sum8(ssqh + (size_t)tok * 8) * (1.f / 1024.f) + EPS);
        const int b = tok >> 13, s = tok & (S - 1);
#pragma unroll
        for (int m = 0; m < 8; ++m) {
          const int f = n0 + wr * 128 + m * 16 + fq * 4;
          const float v0 = acc[m][n][0] * rstd, v1 = acc[m][n][1] * rstd, v2 = acc[m][n][2] * rstd, v3 = acc[m][n][3] * rstd;
          if (nt < 4) store4bf(qb + (size_t)tok * 1024 + f, v0 * qs, v1 * qs, v2 * qs, v3 * qs);
          else if (nt == 4) store4bf(kb + (size_t)tok * 256 + (f - 1024), v0, v1, v2, v3);
          else if (nt == 5) store_vt4(vt + ((size_t)(b * 4) * 64 + (f - 1280)) * S + perm16(s), v0, v1, v2, v3);
          else store4bf(zb + (size_t)tok * 1024 + (f - 1536), v0, v1, v2, v3);
        }
      }
    } else if constexpr (EPI == EPI_B_IN) {
      gemm_core8(acc, (const unsigned char*)(wbase + W_B_IN + (size_t)j * 1792 * 1024) + (size_t)n0 * 1024, (const unsigned char*)hb + (size_t)m0 * 1024, 1024, lds, SC_M6, SC_ONE);
      const int fbase = n0 + wr * 128;
#pragma unroll
      for (int n = 0; n < 4; ++n) {
        const int tok = m0 + wc * 64 + n * 16 + fr;
        const float rstd = rsqrtf(sum8(ssqh + (size_t)tok * 8) * (1.f / 1024.f) + EPS);
        const int s = tok & (S - 1);
        if (fbase < 1024) {
#pragma unroll
          for (int m = 0; m < 8; ++m)
            store4bf(zb + (size_t)tok * 1024 + fbase + m * 16 + fq * 4, acc[m][n][0] * rstd, acc[m][n][1] * rstd,
                     acc[m][n][2] * rstd, acc[m][n][3] * rstd);
        } else if (fbase < 1664) {
          float sq = 0.f;
          const bool iscq = fbase < 1408;
#pragma unroll
          for (int m = 0; m < 8; ++m) {
            const float v0 = acc[m][n][0] * rstd, v1 = acc[m][n][1] * rstd, v2 = acc[m][n][2] * rstd, v3 = acc[m][n][3] * rstd;
            sq += v0 * v0 + v1 * v1 + v2 * v2 + v3 * v3;
            const int f = fbase + m * 16 + fq * 4;
            if (iscq) *(unsigned*)((unsigned char*)cqb + (size_t)tok * 384 + (f - 1024)) = pack4_fp8c(v0, v1, v2, v3);
            else *(unsigned*)((unsigned char*)ckvb + (size_t)tok * 256 + (f - 1408)) = pack4_fp8c(v0, v1, v2, v3);
          }
          sq = quad_sum(sq);
          if (fq == 0) {
            const int pi = iscq ? ((fbase - 1024) >> 7) : (4 + ((fbase - 1408) >> 7));
            ssqc[(size_t)tok * 8 + pi] = sq;
          }
        } else {
          const float4 cs = *(const float4*)(rope + s * 32 + fq * 4);
          const float4 sn = *(const float4*)(rope + s * 32 + 16 + fq * 4);
          const float x10 = acc[0][n][0] * rstd, x11 = acc[0][n][1] * rstd, x12 = acc[0][n][2] * rstd, x13 = acc[0][n][3] * rstd;
          const float x20 = acc[1][n][0] * rstd, x21 = acc[1][n][1] * rstd, x22 = acc[1][n][2] * rstd, x23 = acc[1][n][3] * rstd;
          unsigned char* kr8 = (unsigned char*)krb;
          *(unsigned*)(kr8 + (size_t)tok * 32 + fq * 4) =
              pack4_fp8c(x10 * cs.x - x20 * sn.x, x11 * cs.y - x21 * sn.y, x12 * cs.z - x22 * sn.z, x13 * cs.w - x23 * sn.w);
          *(unsigned*)(kr8 + (size_t)tok * 32 + 16 + fq * 4) =
              pack4_fp8c(x10 * sn.x + x20 * cs.x, x11 * sn.y + x21 * cs.y, x12 * sn.z + x22 * cs.z, x13 * sn.w + x23 * cs.w);
        }
      }
    } else if constexpr (EPI == EPI_QKV_UP) {
      if (nt < 6) {
        gemm_core8(acc, (const unsigned char*)(wbase + W_B_QB + (size_t)j * 1536 * 384) + (size_t)n0 * 384, (const unsigned char*)cqb + (size_t)m0 * 384, 384, lds, SC_M6, SC_ONE);
        const float qs = 0.10206207261596575f * LOG2E;
#pragma unroll
        for (int n = 0; n < 4; ++n) {
          const int tok = m0 + wc * 64 + n * 16 + fr;
          const float* pc = ssqc + (size_t)tok * 8;
          const float rstd = rsqrtf((pc[0] + pc[1] + pc[2]) * (1.f / 384.f) + EPS) * qs;
          const int s = tok & (S - 1);
          const float4 cs = *(const float4*)(rope + s * 32 + fq * 4);
          const float4 sn = *(const float4*)(rope + s * 32 + 16 + fq * 4);
#pragma unroll
          for (int mp = 0; mp < 4; ++mp) {
            const int fb = n0 + wr * 128 + mp * 32;
            const int cb = fb >> 5;
            unsigned char* dst = (unsigned char*)qb + (size_t)tok * 1536 + fb + fq * 4;
            const float x10 = acc[2 * mp][n][0] * rstd, x11 = acc[2 * mp][n][1] * rstd, x12 = acc[2 * mp][n][2] * rstd,
                        x13 = acc[2 * mp][n][3] * rstd;
            const float x20 = acc[2 * mp + 1][n][0] * rstd, x21 = acc[2 * mp + 1][n][1] * rstd, x22 = acc[2 * mp + 1][n][2] * rstd,
                        x23 = acc[2 * mp + 1][n][3] * rstd;
            if ((cb % 3) == 2) {
              *(unsigned*)dst = pack4_fp8c(x10 * cs.x - x20 * sn.x, x11 * cs.y - x21 * sn.y, x12 * cs.z - x22 * sn.z, x13 * cs.w - x23 * sn.w);
              *(unsigned*)(dst + 16) = pack4_fp8c(x10 * sn.x + x20 * cs.x, x11 * sn.y + x21 * cs.y, x12 * sn.z + x22 * cs.z, x13 * sn.w + x23 * cs.w);
            } else {
              *(unsigned*)dst = pack4_fp8c(x10, x11, x12, x13);
              *(unsigned*)(dst + 16) = pack4_fp8c(x20, x21, x22, x23);
            }
          }
        }
      } else {
        const int n0k = (nt - 6) * 256;
        gemm_core8(acc, (const unsigned char*)(wbase + W_B_KVB + (size_t)j * 2048 * 256) + (size_t)n0k * 256, (const unsigned char*)ckvb + (size_t)m0 * 256, 256, lds, SC_M6, SC_ONE);
        const int hd = (nt - 6) * 2 + wr;
#pragma unroll
        for (int n = 0; n < 4; ++n) {
          const int tok = m0 + wc * 64 + n * 16 + fr;
          const float* pc = ssqc + (size_t)tok * 8 + 4;
          const float rstd = rsqrtf((pc[0] + pc[1]) * (1.f / 256.f) + EPS);
          const int b = tok >> 13, s = tok & (S - 1);
#pragma unroll
          for (int m = 0; m < 8; ++m) {
            const float v0 = acc[m][n][0] * rstd, v1 = acc[m][n][1] * rstd, v2 = acc[m][n][2] * rstd, v3 = acc[m][n][3] * rstd;
            if (m < 4) {
              *(unsigned*)((unsigned char*)kb + (size_t)tok * 1024 + hd * 64 + m * 16 + fq * 4) = pack4_fp8c(v0, v1, v2, v3);
            } else {
              const float p0 = __shfl_xor(v0, 1), p1 = __shfl_xor(v1, 1), p2 = __shfl_xor(v2, 1), p3 = __shfl_xor(v3, 1);
              const bool odd = fr & 1;
              const float a0 = odd ? p2 : v0, b0 = odd ? v2 : p0;
              const float a1 = odd ? p3 : v1, b1 = odd ? v3 : p1;
              const int d = (m - 4) * 16 + fq * 4 + (odd ? 2 : 0);
              unsigned char* dst = (unsigned char*)vt + ((size_t)(b * 16 + hd) * 64 + d) * S + perm64(s & ~1);
              *(unsigned short*)dst = (unsigned short)(__builtin_amdgcn_cvt_pk_fp8_f32(clamp8(a0), clamp8(b0), 0, false) & 0xffff);
              *(unsigned short*)(dst + S) = (unsigned short)(__builtin_amdgcn_cvt_pk_fp8_f32(clamp8(a1), clamp8(b1), 0, false) & 0xffff);
            }
          }
        }
      }
    } else if constexpr (EPI == EPI_OUT) {
      if (!second) {
        if (layer & 1) {
          const unsigned char* wt = (const unsigned char*)(wbase + W_B_OUT + (size_t)j * 1024 * 1024);
          gemm_core8(acc, wt + (size_t)n0 * 1024, (const unsigned char*)og + (size_t)m0 * 1024, 1024, lds, SC_M6, SC_M4);
        } else {
          gemm_core(acc, wbase + W_A_OUT + (size_t)j * 1024 * 1024 + (size_t)n0 * 1024, og + (size_t)m0 * 1024, 1024, lds);
        }
        float* outp = uniform_ptr(P.out);
        const float* resid = (layer == 0) ? uniform_ptr(P.x) : outp;
#pragma unroll
        for (int n = 0; n < 4; ++n) {
          const int tok = m0 + wc * 64 + n * 16 + fr;
          float sq = 0.f;
#pragma unroll
          for (int m = 0; m < 8; ++m) {
            const int f = n0 + wr * 128 + m * 16 + fq * 4;
            float4 rv = *(const float4*)(resid + (size_t)tok * DM + f);
            rv.x += acc[m][n][0];
            rv.y += acc[m][n][1];
            rv.z += acc[m][n][2];
            rv.w += acc[m][n][3];
            sq += rv.x * rv.x + rv.y * rv.y + rv.z * rv.z + rv.w * rv.w;
            *(float4*)(outp + (size_t)tok * DM + f) = rv;
            store4bf(hmb + (size_t)tok * DM + f, rv.x, rv.y, rv.z, rv.w);
          }
          sq = quad_sum(sq);
          if (fq == 0) ssqm[(size_t)tok * 8 + nt * 2 + wr] = sq;
        }
      } else {
        gemm_core(acc, wbase + W_PLE + (size_t)layer * 1024 * 256 + (size_t)n0 * 256, pbb + ((size_t)layer * T + m0) * 256, 256, lds);
#pragma unroll
        for (int n = 0; n < 4; ++n) {
          const int tok = m0 + wc * 64 + n * 16 + fr;
#pragma unroll
          for (int m = 0; m < 8; ++m)
            store4bf(eb + (size_t)tok * DM + n0 + wr * 128 + m * 16 + fq * 4, acc[m][n][0], acc[m][n][1], acc[m][n][2], acc[m][n][3]);
        }
      }
    } else {
      gemm_core(acc, wbase + W_GATE + (size_t)layer * 1024 * 1024 + (size_t)n0 * 1024, hmb + (size_t)m0 * 1024, 1024, lds);
      float* outp = uniform_ptr(P.out);
#pragma unroll
      for (int n = 0; n < 4; ++n) {
        const int tok = m0 + wc * 64 + n * 16 + fr;
        const float rstd = rsqrtf(sum8(ssqm + (size_t)tok * 8) * (1.f / 1024.f) + EPS);
        float sq = 0.f;
#pragma unroll
        for (int m = 0; m < 8; ++m) {
          const int f = n0 + wr * 128 + m * 16 + fq * 4;
          float4 hv = *(const float4*)(outp + (size_t)tok * DM + f);
          const uint2 ee = *(const uint2*)(eb + (size_t)tok * DM + f);
          hv.x += bf2f(ee.x & 0xffffu) / (1.f + __expf(-acc[m][n][0] * rstd));
          hv.y += bf2f(ee.x >> 16) / (1.f + __expf(-acc[m][n][1] * rstd));
          hv.z += bf2f(ee.y & 0xffffu) / (1.f + __expf(-acc[m][n][2] * rstd));
          hv.w += bf2f(ee.y >> 16) / (1.f + __expf(-acc[m][n][3] * rstd));
          sq += hv.x * hv.x + hv.y * hv.y + hv.z * hv.z + hv.w * hv.w;
          *(float4*)(outp + (size_t)tok * DM + f) = hv;
          if ((layer & 1) == 0) *(unsigned*)((unsigned char*)hb + (size_t)tok * DM + f) = pack4_fp8c(hv.x, hv.y, hv.z, hv.w);
          else if (layer != 3) store4bf(hb + (size_t)tok * DM + f, hv.x, hv.y, hv.z, hv.w);
        }
        sq = quad_sum(sq);
        if (fq == 0) ssqh[(size_t)tok * 8 + nt * 2 + wr] = sq;
      }
    }
  }
}

template <bool MLA>
DI void attn_phase(const Params& P, int layer, char* lds) {
  constexpr int DQK = MLA ? 96 : 64;
  constexpr int KSTR = DQK * 2 + 16;
  constexpr int VSTR = 144;
  constexpr int KBYTES = 64 * KSTR;
  constexpr int ASTAGE = KBYTES + 64 * VSTR;
  constexpr int NKS = DQK / 16;
  const int tid = get_tid();
  const int lane = tid & 63, w = tid >> 6;
  const int r = lane & 31, h = lane >> 5;
  char* ws = uniform_ptr(P.ws);
  const bf16_t* qg = (const bf16_t*)(ws + OFF_Q);
  const bf16_t* kg = (const bf16_t*)(ws + OFF_K);
  const bf16_t* vtg = (const bf16_t*)(ws + OFF_VT);
  const bf16_t* krg = (const bf16_t*)(ws + OFF_KR);
  const bf16_t* zg = (const bf16_t*)(ws + OFF_Z);
  bf16_t* og = (bf16_t*)(ws + OFF_HB);
  const int j = layer >> 1;

  const int nitems = 2048;
  for (int item = blockIdx.x; item < nitems; item += gridDim.x) {
    int b, head, hkv, q0, t_lo, t_hi;
    int nheads_kv;
    if constexpr (MLA) {
      const int xcd = item & 7, slot = (item >> 3) & 31, grp = item >> 8;
      const int bh = grp * 8 + xcd;
      b = bh >> 4;
      head = bh & 15;
      hkv = head;
      nheads_kv = 16;
      q0 = slot * 256 + w * 32;
      t_lo = 0;
      t_hi = S / 64;
    } else {
      const int hp = item & 7, qblk = (item >> 3) & 63;
      b = item >> 9;
      head = hp * 2 + (w >> 2);
      hkv = hp >> 1;
      nheads_kv = 4;
      const int t0 = qblk * 128;
      q0 = t0 + (w & 3) * 32;
      const int lo = (t0 - 128 > 0) ? (t0 - 128) : 0;
      const int hi = (t0 + 256 < S) ? (t0 + 256) : S;
      t_lo = lo >> 6;
      t_hi = hi >> 6;
    }
    const int qld = MLA ? 1536 : 1024;
    const int tokq = b * S + q0 + r;
    bf16x8 qf[NKS];
#pragma unroll
    for (int ks = 0; ks < NKS; ++ks)
      qf[ks] = *(const bf16x8*)(qg + (size_t)tokq * qld + head * DQK + ks * 16 + 8 * h);

    float m_run, l_run;
    float slope2 = 0.f;
    if constexpr (MLA) {
      m_run = 0.f;
      l_run = 0.f;
    } else {
      m_run = P.a_sink[j * 16 + head] * LOG2E;
      l_run = (h == 0) ? 1.f : 0.f;
      slope2 = exp2f(-0.5f * (float)(head + 1)) * LOG2E;
    }
    f32x16 o[2], negm;
#pragma unroll
    for (int i = 0; i < 16; ++i) { o[0][i] = 0.f; o[1][i] = 0.f; negm[i] = -m_run; }

    const int lrow = tid >> 3, lc = tid & 7;
    uint4 kreg, vreg, rreg;
    auto load_regs = [&](int t) {
      const int kbase = t * 64;
      if constexpr (MLA) {
        kreg = *(const uint4*)(kg + (size_t)(b * S + kbase + lrow) * 1024 + head * 64 + lc * 8);
        if (tid < 256) rreg = *(const uint4*)(krg + (size_t)(b * S + kbase + (tid >> 2)) * 32 + (tid & 3) * 8);
      } else {
        kreg = *(const uint4*)(kg + (size_t)(b * S + kbase + lrow) * 256 + hkv * 64 + lc * 8);
      }
      vreg = *(const uint4*)(vtg + ((size_t)(b * nheads_kv + hkv) * 64 + lrow) * S + kbase + lc * 8);
    };
    auto write_lds = [&](int st) {
      char* base = lds + st * ASTAGE;
      *(uint4*)(base + lrow * KSTR + lc * 16) = kreg;
      if constexpr (MLA) {
        if (tid < 256) *(uint4*)(base + (tid >> 2) * KSTR + 128 + (tid & 3) * 16) = rreg;
      }
      *(uint4*)(base + KBYTES + lrow * VSTR + lc * 16) = vreg;
    };

    __syncthreads();
    load_regs(t_lo);
    write_lds(0);
    __syncthreads();
#pragma unroll 1
    for (int t = t_lo; t < t_hi; ++t) {
      load_regs((t + 1 < t_hi) ? (t + 1) : t);
      const char* base = lds + ((t - t_lo) & 1) * ASTAGE;
      const int kbase = t * 64;
      bool active = true;
      if constexpr (!MLA) active = (kbase + 63 >= q0 - 128) && (kbase <= q0 + 159);
      if (active) {
        f32x16 sc[2];
        {
          bf16x8 kf[2][NKS];
#pragma unroll
          for (int kb = 0; kb < 2; ++kb)
#pragma unroll
            for (int ks = 0; ks < NKS; ++ks) kf[kb][ks] = *(const bf16x8*)(base + (kb * 32 + r) * KSTR + h * 16 + ks * 32);
#pragma unroll
          for (int kb = 0; kb < 2; ++kb) {
            sc[kb] = MFMA(kf[kb][0], qf[0], negm);
#pragma unroll
            for (int ks = 1; ks < NKS; ++ks) sc[kb] = MFMA(kf[kb][ks], qf[ks], sc[kb]);
          }
        }
        if constexpr (!MLA) {
          const int tq = q0 + r;
#pragma unroll
          for (int kb = 0; kb < 2; ++kb)
#pragma unroll
            for (int i = 0; i < 16; ++i) {
              const int kp = kbase + kb * 32 + crow(i, h);
              int d = kp - tq;
              d = d < 0 ? -d : d;
              sc[kb][i] = (d <= 128) ? (sc[kb][i] - slope2 * (float)d) : -1e30f;
            }
        }
        int imx = max(__float_as_int(sc[0][0]), __float_as_int(sc[1][0]));
#pragma unroll
        for (int i = 1; i < 16; ++i) imx = max(imx, max(__float_as_int(sc[0][i]), __float_as_int(sc[1][i])));
        bool slow = __any(imx > 0x41000000);
        if constexpr (MLA) slow = slow || (t == t_lo);
        if (slow) {
          float mx = fmaxf(sc[0][0], sc[1][0]);
#pragma unroll
          for (int i = 1; i < 16; ++i) mx = fmaxf(mx, fmaxf(sc[0][i], sc[1][i]));
          mx = xhalf_max(mx);
          float delta = fmaxf(mx, 0.f);
          if constexpr (MLA) { if (t == t_lo) delta = mx; }
          float alpha = __builtin_amdgcn_exp2f(-delta);
          if constexpr (MLA) { if (t == t_lo) alpha = 1.f; }
          m_run += delta;
          l_run *= alpha;
#pragma unroll
          for (int i = 0; i < 16; ++i) {
            o[0][i] *= alpha;
            o[1][i] *= alpha;
            sc[0][i] -= delta;
            sc[1][i] -= delta;
            negm[i] = -m_run;
          }
        }
        f32x2_t ps2 = {0.f, 0.f};
        bf16x8 pf[2][2];
#pragma unroll
        for (int kb = 0; kb < 2; ++kb) {
#pragma unroll
          for (int i = 0; i < 16; i += 2) {
            const float p0 = __builtin_amdgcn_exp2f(sc[kb][i]);
            const float p1 = __builtin_amdgcn_exp2f(sc[kb][i + 1]);
            sc[kb][i] = p0;
            sc[kb][i + 1] = p1;
            ps2 += f32x2_t{p0, p1};
          }
#pragma unroll
          for (int sidx = 0; sidx < 2; ++sidx) {
            uint4 u;
            u.x = pack2(sc[kb][8 * sidx + 0], sc[kb][8 * sidx + 1]);
            u.y = pack2(sc[kb][8 * sidx + 2], sc[kb][8 * sidx + 3]);
            u.z = pack2(sc[kb][8 * sidx + 4], sc[kb][8 * sidx + 5]);
            u.w = pack2(sc[kb][8 * sidx + 6], sc[kb][8 * sidx + 7]);
            pf[kb][sidx] = __builtin_bit_cast(bf16x8, u);
          }
        }
        l_run += ps2[0] + ps2[1];
#pragma unroll
        for (int db = 0; db < 2; ++db) {
          const char* lv = base + KBYTES + (db * 32 + r) * VSTR + h * 16;
#pragma unroll
          for (int kb = 0; kb < 2; ++kb)
#pragma unroll
            for (int sidx = 0; sidx < 2; ++sidx) {
              bf16x8 vf = *(const bf16x8*)(lv + kb * 64 + sidx * 32);
              o[db] = MFMA(vf, pf[kb][sidx], o[db]);
            }
        }
      }
      write_lds((t + 1 - t_lo) & 1);
      __syncthreads();
    }
    const float l_tot = l_run + __shfl_xor(l_run, 32);
    const float inv = 1.f / l_tot;
#pragma unroll
    for (int db = 0; db < 2; ++db)
#pragma unroll
      for (int g = 0; g < 4; ++g) {
        const int d = db * 32 + 8 * g + 4 * h;
        const size_t off = (size_t)tokq * 1024 + head * 64 + d;
        const uint2 zz = *(const uint2*)(zg + off);
        const float z0 = bf2f(zz.x & 0xffffu), z1 = bf2f(zz.x >> 16), z2 = bf2f(zz.y & 0xffffu), z3 = bf2f(zz.y >> 16);
        const float g0 = z0 / (1.f + __expf(-z0)), g1 = z1 / (1.f + __expf(-z1)), g2 = z2 / (1.f + __expf(-z2)),
                    g3 = z3 / (1.f + __expf(-z3));
        store4bf(og + off, o[db][4 * g] * inv * g0, o[db][4 * g + 1] * inv * g1, o[db][4 * g + 2] * inv * g2,
                 o[db][4 * g + 3] * inv * g3);
      }
  }
}

typedef __attribute__((ext_vector_type(8))) int i32x8;
#define MFMA8(a, b, c) __builtin_amdgcn_mfma_scale_f32_32x32x64_f8f6f4((a), (b), (c), 0, 0, 0, 0x7f7f7f7f, 0, 0x7f7f7f7f)
DI unsigned pack4_fp8(float a, float b, float c, float d) {
  int r = __builtin_amdgcn_cvt_pk_fp8_f32(a, b, 0, false);
  r = __builtin_amdgcn_cvt_pk_fp8_f32(c, d, r, true);
  return (unsigned)r;
}
DI float clamp8(float x) { return __builtin_amdgcn_fmed3f(x, -440.f, 440.f); }
DI unsigned pack4_fp8c(float a, float b, float c, float d) { return pack4_fp8(clamp8(a), clamp8(b), clamp8(c), clamp8(d)); }
DI int perm64(int s) {
  const int c = (s >> 2) & 15;
  const int pc = ((c & 1) << 3) | (c >> 1);
  return (s & ~63) | (pc << 2) | (s & 3);
}
DI i32x8 ld32(const char* p) {
  const uint4 a = *(const uint4*)p, b = *(const uint4*)(p + 16);
  i32x8 r = {(int)a.x, (int)a.y, (int)a.z, (int)a.w, (int)b.x, (int)b.y, (int)b.z, (int)b.w};
  return r;
}

DI void attn_mla8_phase(const Params& P, char* lds) {
  constexpr int KSTR = 144;
  constexpr int VSTR = 80;
  constexpr int KBYTES = 64 * KSTR;
  constexpr int ASTAGE = KBYTES + 64 * VSTR;
  constexpr float PBIAS = 6.f;
  const int tid = get_tid();
  const int lane = tid & 63, w = tid >> 6;
  const int r = lane & 31, h = lane >> 5;
  char* ws = uniform_ptr(P.ws);
  const unsigned char* qg = (const unsigned char*)(ws + OFF_Q);
  const unsigned char* kg = (const unsigned char*)(ws + OFF_K);
  const unsigned char* vtg = (const unsigned char*)(ws + OFF_VT);
  const unsigned char* krg = (const unsigned char*)(ws + OFF_KR);
  const bf16_t* zg = (const bf16_t*)(ws + OFF_Z);
  bf16_t* og = (bf16_t*)(ws + OFF_HB);

  __syncthreads();
  if (tid < 384) {
    const int zr = tid >> 1, zs = tid >> 7;
    *(uint4*)(lds + zs * ASTAGE + (zr & 63) * KSTR + 96 + (tid & 1) * 16) = make_uint4(0u, 0u, 0u, 0u);
  }
  for (int item = blockIdx.x; item < 2048; item += gridDim.x) {
    const int xcd = item & 7, slot = (item >> 3) & 31, grp = item >> 8;
    const int bh = grp * 8 + xcd;
    const int b = bh >> 4, head = bh & 15;
    const int q0 = slot * 256 + w * 32;
    const int tokq = b * S + q0 + r;
    const unsigned char* qrow = qg + (size_t)tokq * 1536 + head * 96;
    const i32x8 qn = ld32((const char*)qrow + 32 * h);
    i32x8 qr = ld32((const char*)qrow + 64);
    if (h) qr = i32x8{0, 0, 0, 0, 0, 0, 0, 0};

    float m_run = 0.f, l_run = 0.f;
    f32x16 o[2], negm;
#pragma unroll
    for (int i = 0; i < 16; ++i) { o[0][i] = 0.f; o[1][i] = 0.f; negm[i] = PBIAS; }

    const int lrow = (tid & 255) >> 2, lc = tid & 3;
    const bool isk = tid < 256;
    const unsigned char* gmain = isk ? (kg + (size_t)(b * S + lrow) * 1024 + head * 64 + lc * 16)
                                     : (vtg + ((size_t)(b * 16 + head) * 64 + lrow) * S + lc * 16);
    const int gstep = isk ? 65536 : 64;
    const int lmain = isk ? (lrow * KSTR + lc * 16) : (KBYTES + lrow * VSTR + lc * 16);
    const int rrow = (tid & 127) >> 1, rc = tid & 1;
    const unsigned char* grope = krg + (size_t)(b * S + rrow) * 32 + rc * 16;
    const int lrope = rrow * KSTR + 64 + rc * 16;
    uint4 areg, rreg;
#define MLA8_LOAD(t_)                                             \
  do {                                                            \
    areg = *(const uint4*)(gmain + (size_t)(t_) * gstep);         \
    rreg = *(const uint4*)(grope + (size_t)(t_) * 2048);          \
  } while (0)
#define MLA8_WRITE(st_)                                           \
  do {                                                            \
    char* wb_ = lds + (st_) * ASTAGE;                             \
    *(uint4*)(wb_ + lmain) = areg;                                \
    if (tid < 128) *(uint4*)(wb_ + lrope) = rreg;                 \
  } while (0)

    i32x8 kn[2], kr[2];
    __syncthreads();
    MLA8_LOAD(0);
    MLA8_WRITE(0);
    MLA8_LOAD(1);
    MLA8_WRITE(1);
    __syncthreads();
#pragma unroll
    for (int kb = 0; kb < 2; ++kb) {
      const char* lk = lds + (kb * 32 + r) * KSTR;
      kn[kb] = ld32(lk + 32 * h);
      kr[kb] = ld32(lk + 64 + 32 * h);
    }
    int st_cur = 0;
#pragma unroll 1
    for (int t = 0; t < S / 64; ++t) {
      MLA8_LOAD((t + 2 < S / 64) ? (t + 2) : (S / 64 - 1));
      const char* base = lds + st_cur * ASTAGE;
      const int st_nxt = (st_cur == 2) ? 0 : st_cur + 1;
      const int st_wr = (st_nxt == 2) ? 0 : st_nxt + 1;
      f32x16 sc[2];
      i32x8 vf[2];
      vf[0] = ld32(base + KBYTES + r * VSTR + 32 * h);
      vf[1] = ld32(base + KBYTES + (32 + r) * VSTR + 32 * h);
#pragma unroll
      for (int kb = 0; kb < 2; ++kb) {
        sc[kb] = MFMA8(kn[kb], qn, negm);
        sc[kb] = MFMA8(kr[kb], qr, sc[kb]);
      }
      int imx = max(__float_as_int(sc[0][0]), __float_as_int(sc[1][0]));
#pragma unroll
      for (int i = 1; i < 16; ++i) imx = max(imx, max(__float_as_int(sc[0][i]), __float_as_int(sc[1][i])));
      const bool slow = __any(imx > 0x41000000) || (t == 0);
      if (slow) {
        float mx = fmaxf(sc[0][0], sc[1][0]);
#pragma unroll
        for (int i = 1; i < 16; ++i) mx = fmaxf(mx, fmaxf(sc[0][i], sc[1][i]));
        mx = xhalf_max(mx);
        float delta = fmaxf(mx - PBIAS, 0.f);
        float alpha = __builtin_amdgcn_exp2f(-delta);
        if (t == 0) { delta = mx - PBIAS; alpha = 1.f; }
        m_run += delta;
        l_run *= alpha;
#pragma unroll
        for (int i = 0; i < 16; ++i) {
          o[0][i] *= alpha;
          o[1][i] *= alpha;
          sc[0][i] -= delta;
          sc[1][i] -= delta;
          negm[i] = PBIAS - m_run;
        }
      }
      f32x2_t ps2 = {0.f, 0.f};
      i32x8 pb;
#pragma unroll
      for (int kb = 0; kb < 2; ++kb) {
#pragma unroll
        for (int i = 0; i < 16; i += 2) {
          const f32x2_t tt = f32x2_t{sc[kb][i], sc[kb][i + 1]} * f32x2_t{8388608.f, 8388608.f} + f32x2_t{1065353216.f, 1065353216.f};
          const float p0 = __uint_as_float((unsigned)tt[0]);
          const float p1 = __uint_as_float((unsigned)tt[1]);
          sc[kb][i] = p0;
          sc[kb][i + 1] = p1;
          ps2 += f32x2_t{p0, p1};
        }
#pragma unroll
        for (int q4 = 0; q4 < 4; ++q4)
          pb[kb * 4 + q4] = (int)pack4_fp8(sc[kb][4 * q4], sc[kb][4 * q4 + 1], sc[kb][4 * q4 + 2], sc[kb][4 * q4 + 3]);
      }
      l_run += ps2[0] + ps2[1];
#pragma unroll
      for (int db = 0; db < 2; ++db) {
        o[db] = MFMA8(vf[db], pb, o[db]);
      }
      {
        const char* nb = lds + st_nxt * ASTAGE;
#pragma unroll
        for (int kb = 0; kb < 2; ++kb) {
          const char* lk = nb + (kb * 32 + r) * KSTR;
          kn[kb] = ld32(lk + 32 * h);
          kr[kb] = ld32(lk + 64 + 32 * h);
        }
      }
      MLA8_WRITE(st_wr);
      __syncthreads();
      st_cur = st_nxt;
    }
    const float l_tot = l_run + __shfl_xor(l_run, 32);
    const float inv = 1.f / l_tot;
#pragma unroll
    for (int db = 0; db < 2; ++db)
#pragma unroll
      for (int g = 0; g < 4; ++g) {
        const int d = db * 32 + 8 * g + 4 * h;
        const size_t off = (size_t)tokq * 1024 + head * 64 + d;
        const uint2 zz = *(const uint2*)(zg + off);
        const float z0 = bf2f(zz.x & 0xffffu), z1 = bf2f(zz.x >> 16), z2 = bf2f(zz.y & 0xffffu), z3 = bf2f(zz.y >> 16);
        const float g0 = z0 / (1.f + __expf(-z0)), g1 = z1 / (1.f + __expf(-z1)), g2 = z2 / (1.f + __expf(-z2)),
                    g3 = z3 / (1.f + __expf(-z3));
        const float i64 = inv * 16.f;
        *(unsigned*)((unsigned char*)og + off) = pack4_fp8c(o[db][4 * g] * i64 * g0, o[db][4 * g + 1] * i64 * g1, o[db][4 * g + 2] * i64 * g2,
                                                         o[db][4 * g + 3] * i64 * g3);
      }
  }
#undef MLA8_LOAD
#undef MLA8_WRITE
}

DI void final_phase(const Params& P) {
  const int tid = get_tid();
  const int w = tid >> 6, lane = tid & 63;
  for (int row = blockIdx.x * 8 + w; row < T; row += gridDim.x * 8) {
    float4* xr = (float4*)(P.out + (size_t)row * DM);
    float4 v[4];
    float s = 0.f;
#pragma unroll
    for (int i = 0; i < 4; ++i) {
      v[i] = xr[lane + 64 * i];
      s += v[i].x * v[i].x + v[i].y * v[i].y + v[i].z * v[i].z + v[i].w * v[i].w;
    }
#pragma unroll
    for (int o = 32; o >= 1; o >>= 1) s += __shfl_xor(s, o);
    const float rstd = rsqrtf(s * (1.f / 1024.f) + EPS);
#pragma unroll
    for (int i = 0; i < 4; ++i) {
      const float4 g = ((const float4*)P.final_g)[lane + 64 * i];
      xr[lane + 64 * i] = make_float4(v[i].x * rstd * g.x, v[i].y * rstd * g.y, v[i].z * rstd * g.z, v[i].w * rstd * g.w);
    }
  }
}

#define XB_TMO      128
#define XB_XCNT(j)  (256  + 64 * (j))
#define XB_XSUB(j)  (1280 + 64 * (j))
#define XB_XGEN(j)  (2304 + 64 * (j))
#define XB_TOP      3328
#define XB_TOPGEN   3392
#define XCD_BAR_WORDS 3456
#define XB_SPIN_CAP (1u << 22)
#define LAS __attribute__((address_space(3)))
DI unsigned xb_ld(unsigned* p) { return __hip_atomic_load(p, __ATOMIC_RELAXED, __HIP_MEMORY_SCOPE_AGENT); }
DI unsigned xb_add(unsigned* p, unsigned v) { return __hip_atomic_fetch_add(p, v, __ATOMIC_RELAXED, __HIP_MEMORY_SCOPE_AGENT); }
DI unsigned xb_xcc_id() { return (unsigned)__builtin_amdgcn_s_getreg((3 << 11) | 20) & 0xFu; }
#define XB_SPIN(cond, bar) do { unsigned _sp = 0; while (cond) { __builtin_amdgcn_s_sleep(1); \
    if ((++_sp & 255u) == 0u) { if (xb_ld(&(bar)[XB_TMO])) break; if (_sp > XB_SPIN_CAP) { atomicAdd(&(bar)[XB_TMO], 1u); break; } } } } while (0)
struct XcdBarrier {
  unsigned* bar;
  unsigned x;
  volatile LAS unsigned* st;
};
DI XcdBarrier xcd_barrier_post(unsigned* bar, volatile LAS unsigned* st) {
  XcdBarrier b;
  b.bar = bar;
  b.x = xb_xcc_id();
  b.st = st;
  if (threadIdx.x == 0) (void)xb_add(&bar[XB_XCNT(b.x)], 1u);
  return b;
}
DI void xcd_barrier_complete(unsigned* bar, unsigned x, unsigned& nloc, unsigned& nx) {
  const unsigned G = gridDim.x * gridDim.y * gridDim.z;
  unsigned sum, cnt, mine, sp = 0u;
  for (;;) {
    sum = 0u; cnt = 0u; mine = 0u;
#pragma unroll
    for (unsigned j = 0; j < 16; ++j) {
      const unsigned c = xb_ld(&bar[XB_XCNT(j)]);
      sum += c;
      cnt += (c > 0u) ? 1u : 0u;
      mine = (j == x) ? c : mine;
    }
    if (sum == G) break;
    __builtin_amdgcn_s_sleep(1);
    if ((++sp & 255u) == 0u) { if (xb_ld(&bar[XB_TMO])) break; if (sp > XB_SPIN_CAP) { atomicAdd(&bar[XB_TMO], 1u); break; } }
  }
  nloc = mine > 0u ? mine : 1u;
  nx = cnt > 0u ? cnt : 1u;
}
DI void xcd_barrier(const XcdBarrier& b) {
  asm volatile("s_waitcnt vmcnt(0)" ::: "memory");
  __syncthreads();
  if (threadIdx.x == 0) {
    unsigned* bar = b.bar;
    __builtin_amdgcn_s_waitcnt(0);
    unsigned nloc = b.st[0], nx = b.st[1];
    if (nloc == 0u) { xcd_barrier_complete(bar, b.x, nloc, nx); b.st[0] = nloc; b.st[1] = nx; }
    const unsigned old = xb_add(&bar[XB_XSUB(b.x)], 1u);
    const unsigned gen = old / nloc;
    if (old + 1u == (gen + 1u) * nloc) {
      __builtin_amdgcn_fence(__ATOMIC_RELEASE, "agent");
      asm volatile("s_waitcnt vmcnt(0)" ::: "memory");
      const unsigned og = xb_add(&bar[XB_TOP], 1u);
      const unsigned tg = og / nx;
      if (og + 1u == (tg + 1u) * nx) xb_add(&bar[XB_TOPGEN], 1u);
      else XB_SPIN(xb_ld(&bar[XB_TOPGEN]) == tg, bar);
      __builtin_amdgcn_fence(__ATOMIC_ACQUIRE, "agent");
      xb_add(&bar[XB_XGEN(b.x)], 1u);
      asm volatile("s_waitcnt vmcnt(0)" ::: "memory");
    } else {
      XB_SPIN(xb_ld(&bar[XB_XGEN(b.x)]) == gen, bar);
      __builtin_amdgcn_fence(__ATOMIC_ACQUIRE, "agent");
      asm volatile("s_waitcnt vmcnt(0)" ::: "memory");
    }
  }
  __syncthreads();
}

constexpr int NPHASE = 1 + 2 * (4 + 5) + 1;

DI void run_phase(const Params& P, int ph, char* lds) {
  if (ph == 0) { prep_phase(P, lds); return; }
  if (ph == NPHASE - 1) { final_phase(P); return; }
  const int q = (ph - 1) / 9, rr = (ph - 1) % 9;
  if (rr < 4) {
    const int layer = q * 2;
    if (rr == 0) gemm_phase<EPI_A_IN>(P, layer, lds);
    else if (rr == 1) attn_phase<false>(P, layer, lds);
    else if (rr == 2) gemm_phase<EPI_OUT>(P, layer, lds);
    else gemm_phase<EPI_PLE>(P, layer, lds);
  } else {
    const int layer = q * 2 + 1;
    if (rr == 4) gemm_phase<EPI_B_IN>(P, layer, lds);
    else if (rr == 5) gemm_phase<EPI_QKV_UP>(P, layer, lds);
    else if (rr == 6) attn_phase<true>(P, layer, lds);
    else if (rr == 7) gemm_phase<EPI_OUT>(P, layer, lds);
    else gemm_phase<EPI_PLE>(P, layer, lds);
  }
}

__global__ void __launch_bounds__(NTHREADS) fwd_kernel(Params P) {
  __shared__ __attribute__((aligned(1024))) char lds[LDS_BYTES + 16];
#if MULTI_LAUNCH
  run_phase(P, P.phase_lo, lds);
#else
  cg::grid_group grid = cg::this_grid();
  volatile LAS unsigned* xst = (volatile LAS unsigned*)(lds + LDS_BYTES);
  if (threadIdx.x == 0) { xst[0] = 0u; xst[1] = 0u; }
  __syncthreads();
  const XcdBarrier xb = xcd_barrier_post((unsigned*)(P.ws + OFF_BAR), xst);
  prep_phase(P, lds);
#if (PROBE_REPEAT >> 9) & 1
  prep_phase(P, lds);
#endif
  grid.sync();
#pragma unroll 1
  for (int q = 0; q < 2; ++q) {
    const int la = 2 * q, lb = 2 * q + 1;
    gemm_phase<EPI_A_IN>(P, la, lds);
#if (PROBE_REPEAT >> 0) & 1
    gemm_phase<EPI_A_IN>(P, la, lds);
#endif
    GSYNC();
    attn_phase<false>(P, la, lds);
#if (PROBE_REPEAT >> 1) & 1
    attn_phase<false>(P, la, lds);
#endif
    GSYNC();
    gemm_phase<EPI_OUT>(P, la, lds);
    GSYNC();
    gemm_phase<EPI_PLE>(P, la, lds);
    GSYNC();
    gemm_phase<EPI_B_IN>(P, lb, lds);
#if (PROBE_REPEAT >> 4) & 1
    gemm_phase<EPI_B_IN>(P, lb, lds);
#endif
    GSYNC();
    gemm_phase<EPI_QKV_UP>(P, lb, lds);
#if (PROBE_REPEAT >> 5) & 1
    gemm_phase<EPI_QKV_UP>(P, lb, lds);
#endif
    GSYNC();
    attn_mla8_phase(P, lds);
#if (PROBE_REPEAT >> 6) & 1
    attn_mla8_phase(P, lds);
#endif
    GSYNC();
    gemm_phase<EPI_OUT>(P, lb, lds);
    GSYNC();
    gemm_phase<EPI_PLE>(P, lb, lds);
    GSYNC();
  }
  final_phase(P);
#endif
}

static void add_seg(Params& p, int& tiles, const float* src, const float* gain, bf16_t* dst, int src_ld, int ncols, int K, int fp8 = 0) {
  Seg& s = p.seg[p.nseg++];
  s.src = src;
  s.gain = gain;
  s.dst = dst;
  s.src_ld = src_ld;
  s.ncols = ncols;
  s.K = K;
  s.fp8 = fp8;
  s.pad0 = 0;
  s.tile0 = tiles;
  tiles += (K / 64) * (ncols / 32);
}

extern "C" void kernel_launch(void* const* d_in, const int* in_sizes, int n_in, void* d_out, int out_size, void* d_ws,
                              size_t ws_size, hipStream_t stream) {
  (void)in_sizes; (void)n_in; (void)out_size;
  if (ws_size < WS_NEEDED) {
    fprintf(stderr, "workspace too small: %zu < %zu\n", ws_size, (size_t)WS_NEEDED);
    return;
  }
  const float* x = (const float*)d_in[0];
  const float* pp = (const float*)d_in[1];
  const float* norm_g = (const float*)d_in[2];
  const float* a_w_in = (const float*)d_in[3];
  const float* a_sink = (const float*)d_in[4];
  const float* a_w_out = (const float*)d_in[5];
  const float* b_w_in = (const float*)d_in[6];
  const float* b_q_norm = (const float*)d_in[7];
  const float* b_w_qb = (const float*)d_in[8];
  const float* b_kv_norm = (const float*)d_in[9];
  const float* b_w_kvb = (const float*)d_in[10];
  const float* b_w_out = (const float*)d_in[11];
  const float* ple_w = (const float*)d_in[12];
  const float* ple_norm_g = (const float*)d_in[13];
  const float* ple_w_gate = (const float*)d_in[14];
  const float* final_g = (const float*)d_in[15];

  Params p;
  memset(&p, 0, sizeof(p));
  p.x = x;
  p.p = pp;
  p.a_sink = a_sink;
  p.final_g = final_g;
  p.out = (float*)d_out;
  p.ws = (char*)d_ws;
  bf16_t* wb = (bf16_t*)((char*)d_ws + OFF_W);
  int tiles = 0;
  for (int j = 0; j < 2; ++j) {
    const int la = 2 * j, lb = 2 * j + 1;
    add_seg(p, tiles, a_w_in + (size_t)j * 1024 * 2560, norm_g + la * 1024, wb + W_A_IN + (size_t)j * 2560 * 1024, 2560, 2560, 1024);
    add_seg(p, tiles, a_w_out + (size_t)j * 1024 * 1024, nullptr, wb + W_A_OUT + (size_t)j * 1024 * 1024, 1024, 1024, 1024);
    const float* bsrc = b_w_in + (size_t)j * 1024 * 1696;
    unsigned char* bdst = (unsigned char*)(wb + W_B_IN + (size_t)j * 1792 * 1024);
    const float* gb = norm_g + lb * 1024;
    add_seg(p, tiles, bsrc + 672, gb, (bf16_t*)bdst, 1696, 1024, 1024, 1);
    add_seg(p, tiles, bsrc + 0, gb, (bf16_t*)(bdst + (size_t)1024 * 1024), 1696, 384, 1024, 1);
    add_seg(p, tiles, bsrc + 384, gb, (bf16_t*)(bdst + (size_t)1408 * 1024), 1696, 256, 1024, 1);
    add_seg(p, tiles, bsrc + 640, gb, (bf16_t*)(bdst + (size_t)1664 * 1024), 1696, 32, 1024, 1);
    add_seg(p, tiles, nullptr, nullptr, (bf16_t*)(bdst + (size_t)1696 * 1024), 1696, 96, 1024, 1);
    add_seg(p, tiles, b_w_qb + (size_t)j * 384 * 1536, b_q_norm + j * 384, wb + W_B_QB + (size_t)j * 1536 * 384, 1536, 1536, 384, 1);
    add_seg(p, tiles, b_w_kvb + (size_t)j * 256 * 2048, b_kv_norm + j * 256, wb + W_B_KVB + (size_t)j * 2048 * 256, 2048, 2048, 256, 1);
    add_seg(p, tiles, b_w_out + (size_t)j * 1024 * 1024, nullptr, wb + W_B_OUT + (size_t)j * 1024 * 1024, 1024, 1024, 1024, 1);
  }
  for (int i = 0; i < 4; ++i) {
    add_seg(p, tiles, ple_w + (size_t)i * 256 * 1024, nullptr, wb + W_PLE + (size_t)i * 1024 * 256, 1024, 1024, 256);
    add_seg(p, tiles, ple_w_gate + (size_t)i * 1024 * 1024, ple_norm_g + i * 1024, wb + W_GATE + (size_t)i * 1024 * 1024, 1024, 1024, 1024);
  }
  p.ntile_w = tiles;

#if MULTI_LAUNCH
  for (int ph = 0; ph < NPHASE; ++ph) {
    p.phase_lo = ph;
    p.phase_hi = ph + 1;
    hipLaunchKernelGGL(fwd_kernel, dim3(1024), dim3(NTHREADS), 0, stream, p);
  }
#else
  static int grid_blocks = 0;
  if (!grid_blocks) {
    int dev = 0, cus = 0, per_cu = 0;
    hipGetDevice(&dev);
    hipDeviceGetAttribute(&cus, hipDeviceAttributeMultiprocessorCount, dev);
    hipOccupancyMaxActiveBlocksPerMultiprocessor(&per_cu, fwd_kernel, NTHREADS, 0);
    if (per_cu < 1) per_cu = 1;
    if (per_cu > 1) per_cu = 1;
    grid_blocks = cus * per_cu;
  }
  p.phase_lo = 0;
  p.phase_hi = NPHASE;
  (void)hipMemsetAsync((char*)d_ws + OFF_BAR, 0, 16384, stream);
  void* args[] = {&p};
  hipError_t e = hipLaunchCooperativeKernel((void*)fwd_kernel, dim3(grid_blocks), dim3(NTHREADS), args, 0, stream);
  if (e != hipSuccess) fprintf(stderr, "cooperative launch failed: %s (grid %d)\n", hipGetErrorString(e), grid_blocks);
#endif
}
```

```cpp
#include <hip/hip_runtime.h>
#include <hip/hip_cooperative_groups.h>
#include <cstdio>
#include <cstring>
namespace cg = cooperative_groups;

#ifndef PROBE_REPEAT
#define PROBE_REPEAT 0
#endif
#ifndef PROBE_SYNC2
#define PROBE_SYNC2 0
#endif
#if PROBE_SYNC2
#define GSYNC() do { xcd_barrier(xb); xcd_barrier(xb); } while (0)
#else
#define GSYNC() xcd_barrier(xb)
#endif
#ifndef MULTI_LAUNCH
#define MULTI_LAUNCH 0
#endif

#define DI __device__ __forceinline__
typedef __attribute__((ext_vector_type(8))) short bf16x8;
typedef __attribute__((ext_vector_type(16))) float f32x16;
typedef unsigned short bf16_t;

constexpr int T = 32768, S = 8192, NB = 4, DM = 1024, PLE = 256;
constexpr int NTHREADS = 512;
constexpr float LOG2E = 1.4426950408889634f;
constexpr float EPS = 1e-6f;

constexpr size_t MiB = 1024ull * 1024ull;
constexpr size_t OFF_HB = 0;
constexpr size_t OFF_Z = 64 * MiB;
constexpr size_t OFF_Q = 128 * MiB;
constexpr size_t OFF_K = 224 * MiB;
constexpr size_t OFF_VT = 288 * MiB;
constexpr size_t OFF_CQ = 352 * MiB;
constexpr size_t OFF_CKV = 376 * MiB;
constexpr size_t OFF_KR = 392 * MiB;
constexpr size_t OFF_SSQH = 394 * MiB;
constexpr size_t OFF_SSQM = 395 * MiB;
constexpr size_t OFF_SSQC = 396 * MiB;
constexpr size_t OFF_ROPE = 397 * MiB;
constexpr size_t OFF_W = 398 * MiB;
constexpr size_t OFF_PB = 438 * MiB;
constexpr size_t OFF_BAR = 502 * MiB;
constexpr size_t W_A_IN = 0;
constexpr size_t W_A_OUT = W_A_IN + 2ull * 2560 * 1024;
constexpr size_t W_B_IN = W_A_OUT + 2ull * 1024 * 1024;
constexpr size_t W_B_QB = W_B_IN + 2ull * 1792 * 1024;
constexpr size_t W_B_KVB = W_B_QB + 2ull * 1536 * 384;
constexpr size_t W_B_OUT = W_B_KVB + 2ull * 2048 * 256;
constexpr size_t W_PLE = W_B_OUT + 2ull * 1024 * 1024;
constexpr size_t W_GATE = W_PLE + 4ull * 1024 * 256;
constexpr size_t W_END = W_GATE + 4ull * 1024 * 1024;
static_assert(OFF_W + W_END * 2 <= OFF_PB, "weights overflow");
constexpr size_t WS_NEEDED = OFF_BAR + 1 * MiB;

struct Seg {
  const float* src;
  const float* gain;
  bf16_t* dst;
  int src_ld, ncols, K, tile0;
  int fp8, pad0;
};
constexpr int MAXSEG = 32;

struct Params {
  const float *x, *p, *a_sink, *final_g;
  float* out;
  char* ws;
  Seg seg[MAXSEG];
  int nseg, ntile_w;
  int phase_lo, phase_hi;
};

typedef __attribute__((ext_vector_type(2))) float f32x2_t;
typedef __attribute__((ext_vector_type(2))) __bf16 bf16x2_t;
DI unsigned pack2(float a, float b) {
  f32x2_t v = {a, b};
  return __builtin_bit_cast(unsigned, __builtin_convertvector(v, bf16x2_t));
}
DI unsigned f2bf(float x) { return pack2(x, 0.f) & 0xffffu; }
DI float xhalf_max(float x) {
  return fmaxf(x, __shfl_xor(x, 32));
}
DI float bf2f(unsigned h) { return __uint_as_float(h << 16); }
DI int crow(int i, int h) { return (i & 3) + 8 * (i >> 2) + 4 * h; }
DI int perm16(int s) {
  int k = s & 15;
  int c = k >> 2;
  int pc = ((c & 1) << 1) | (c >> 1);
  return (s & ~15) | (pc << 2) | (k & 3);
}
#define MFMA(a, b, c) __builtin_amdgcn_mfma_f32_32x32x16_bf16((a), (b), (c), 0, 0, 0)
DI int get_tid() {
  int t = threadIdx.x;
  asm volatile("" : "+v"(t));
  return t;
}
template <typename TP>
DI TP* uniform_ptr(TP* p) {
  unsigned lo = (unsigned)(size_t)p, hi = (unsigned)((size_t)p >> 32);
  lo = __builtin_amdgcn_readfirstlane(lo);
  hi = __builtin_amdgcn_readfirstlane(hi);
  asm volatile("" : "+s"(lo), "+s"(hi));
  return (TP*)(((size_t)hi << 32) | (size_t)lo);
}
DI unsigned pack4_fp8(float a, float b, float c, float d);
DI unsigned pack4_fp8c(float a, float b, float c, float d);
DI float clamp8(float x);
DI float wave_xor_sum32(float v) { return v + __shfl_xor(v, 32); }

DI void prep_phase(const Params& P, char* lds) {
  const int tid = get_tid();
  float* tl = (float*)lds;
  for (int t = blockIdx.x; t < P.ntile_w; t += gridDim.x) {
    int si = 0;
    for (int i = 1; i < P.nseg; ++i)
      if (t >= P.seg[i].tile0) si = i;
    const Seg sg = P.seg[si];
    const int lt = t - sg.tile0;
    const int ncb = sg.ncols >> 5;
    const int kb = lt / ncb, nb = lt - kb * ncb;
    const int k0 = kb * 64, n0 = nb * 32;
    __syncthreads();
    {
      const int n = tid & 31;
#pragma unroll
      for (int i = 0; i < 4; ++i) {
        const int k = (tid >> 5) + 16 * i;
        float v = 0.f;
        if (sg.src) {
          v = sg.src[(size_t)(k0 + k) * sg.src_ld + n0 + n];
          if (sg.gain) v *= sg.gain[k0 + k];
        }
        tl[k * 33 + n] = v;
      }
    }
    __syncthreads();
    {
      const int kk4 = (tid & 15) * 4, n = tid >> 4;
      const float w0 = tl[(kk4 + 0) * 33 + n], w1 = tl[(kk4 + 1) * 33 + n], w2 = tl[(kk4 + 2) * 33 + n], w3 = tl[(kk4 + 3) * 33 + n];
      if (sg.fp8) {
        *(unsigned*)((unsigned char*)sg.dst + (size_t)(n0 + n) * sg.K + k0 + kk4) = pack4_fp8c(w0 * 64.f, w1 * 64.f, w2 * 64.f, w3 * 64.f);
      } else {
        uint2 o2;
        o2.x = pack2(w0, w1);
        o2.y = pack2(w2, w3);
        *(uint2*)(sg.dst + (size_t)(n0 + n) * sg.K + k0 + kk4) = o2;
      }
    }
  }
  {
    char* ws = uniform_ptr(P.ws);
    bf16_t* hb = (bf16_t*)(ws + OFF_HB);
    float* ssq = (float*)(ws + OFF_SSQH);
    const int w = tid >> 6, lane = tid & 63;
    for (int row = blockIdx.x * 8 + w; row < T; row += gridDim.x * 8) {
      const float4* xr = (const float4*)(P.x + (size_t)row * DM);
      float s = 0.f;
#pragma unroll
      for (int i = 0; i < 4; ++i) {
        float4 v = xr[lane + 64 * i];
        s += v.x * v.x + v.y * v.y + v.z * v.z + v.w * v.w;
        uint2 o;
        o.x = pack2(v.x, v.y);
        o.y = pack2(v.z, v.w);
        *(uint2*)(hb + (size_t)row * DM + (lane + 64 * i) * 4) = o;
      }
#pragma unroll
      for (int o = 32; o >= 1; o >>= 1) s += __shfl_xor(s, o);
      if (lane < 8) ssq[(size_t)row * 8 + lane] = (lane == 0) ? s : 0.f;
    }
  }
  {
    bf16_t* pb = (bf16_t*)(uniform_ptr(P.ws) + OFF_PB);
    const size_t n8 = (size_t)4 * T * PLE / 8;
    for (size_t e = (size_t)blockIdx.x * NTHREADS + tid; e < n8; e += (size_t)gridDim.x * NTHREADS) {
      const float4 v0 = ((const float4*)P.p)[2 * e], v1 = ((const float4*)P.p)[2 * e + 1];
      uint4 o;
      o.x = pack2(v0.x, v0.y);
      o.y = pack2(v0.z, v0.w);
      o.z = pack2(v1.x, v1.y);
      o.w = pack2(v1.z, v1.w);
      ((uint4*)pb)[e] = o;
    }
  }
  {
    float* rt = (float*)(uniform_ptr(P.ws) + OFF_ROPE);
    for (int e = blockIdx.x * NTHREADS + tid; e < S * 16; e += gridDim.x * NTHREADS) {
      const int s = e >> 4, i = e & 15;
      const double inv = exp2(-(double)i * (13.287712379549449 / 16.0));
      const double rev = (double)s * inv * 0.15915494309189535;
      const float fr = (float)(rev - floor(rev));
      rt[s * 32 + i] = __builtin_amdgcn_cosf(fr);
      rt[s * 32 + 16 + i] = __builtin_amdgcn_sinf(fr);
    }
  }
}

typedef __attribute__((ext_vector_type(4))) float f32x4;
constexpr int GBK = 64, GKS = 2;
constexpr int GTILE_B = 256 * GBK * 2;
constexpr int GSTAGE_B = 2 * GTILE_B;
constexpr int LDS_BYTES = 2 * GSTAGE_B;

DI int lds_byte(int r, int c) {
  int st = (r >> 4) * GKS + (c >> 5), ob = (r & 15) * 64 + (c & 31) * 2;
  return st * 1024 + (ob ^ (((ob >> 9) & 1) << 5));
}
DI void stage_rc(int b, int& R, int& C) {
  int st = b >> 10, sb = b & 1023, swz = sb ^ (((sb >> 9) & 1) << 5);
  R = (st / GKS) * 16 + swz / 64;
  C = (st % GKS) * 32 + (swz % 64) / 2;
}
#define WAIT_V0() asm volatile("s_waitcnt vmcnt(0)" ::: "memory")

DI void gemm_core(f32x4 (&acc)[8][4], const bf16_t* Wb, const bf16_t* Xb, int K, char* shm) {
  const int tid = get_tid();
  const int wid = tid >> 6, lane = tid & 63, wr = wid >> 2, wc = wid & 3, fr = lane & 15, fq = lane >> 4;
  int sR[4], sC[4];
#pragma unroll
  for (int i = 0; i < 4; ++i) stage_rc(wid * 1024 + i * 8192 + lane * 16, sR[i], sC[i]);
  const int nt = K / GBK;
#define GSRC(base, i, kt) ((base) + (size_t)sR[i] * K + (kt) * GBK + sC[i])
#define GLDS_STAGE(buf, kt)                                                                                           \
  do {                                                                                                                \
    _Pragma("unroll") for (int i = 0; i < 4; ++i) {                                                                   \
      __builtin_amdgcn_global_load_lds((const unsigned*)GSRC(Wb, i, kt),                                             \
                                       (unsigned*)(shm + (buf) * GSTAGE_B + wid * 1024 + i * 8192), 16, 0, 0);        \
      __builtin_amdgcn_global_load_lds((const unsigned*)GSRC(Xb, i, kt),                                             \
                                       (unsigned*)(shm + (buf) * GSTAGE_B + GTILE_B + wid * 1024 + i * 8192), 16, 0, 0); \
    }                                                                                                                 \
  } while (0)
  __syncthreads();
  GLDS_STAGE(0, 0);
  WAIT_V0();
  __syncthreads();
#pragma unroll 1
  for (int t = 0; t < nt; ++t) {
    const int cur = t & 1;
    if (t + 1 < nt) GLDS_STAGE(cur ^ 1, t + 1);
    const char* sa = shm + cur * GSTAGE_B;
    const char* sb = sa + GTILE_B;
#pragma unroll
    for (int ks = 0; ks < GKS; ++ks) {
      bf16x8 At[8], Bf[4];
#pragma unroll
      for (int m = 0; m < 8; ++m) At[m] = *(const bf16x8*)(sa + lds_byte(wr * 128 + m * 16 + fr, ks * 32 + fq * 8));
#pragma unroll
      for (int n = 0; n < 4; ++n) Bf[n] = *(const bf16x8*)(sb + lds_byte(wc * 64 + n * 16 + fr, ks * 32 + fq * 8));
#pragma unroll
      for (int m = 0; m < 8; ++m)
#pragma unroll
        for (int n = 0; n < 4; ++n) acc[m][n] = __builtin_amdgcn_mfma_f32_16x16x32_bf16(At[m], Bf[n], acc[m][n], 0, 0, 0);
      __builtin_amdgcn_sched_barrier(0);
    }
    WAIT_V0();
    __syncthreads();
  }
#undef GSRC
#undef GLDS_STAGE
}

typedef __attribute__((ext_vector_type(8))) int i32x8g;
DI i32x8g ld32g(const char* p0, const char* p1) {
  const uint4 a = *(const uint4*)p0, b = *(const uint4*)p1;
  i32x8g r = {(int)a.x, (int)a.y, (int)a.z, (int)a.w, (int)b.x, (int)b.y, (int)b.z, (int)b.w};
  return r;
}
DI void gemm_core8(f32x4 (&acc)[8][4], const unsigned char* Wb, const unsigned char* Xb, int K, char* shm, int sw, int sx) {
  const int tid = get_tid();
  const int wid = tid >> 6, lane = tid & 63, wr = wid >> 2, wc = wid & 3, fr = lane & 15, fq = lane >> 4;
  int sR[4], sC[4];
#pragma unroll
  for (int i = 0; i < 4; ++i) stage_rc(wid * 1024 + i * 8192 + lane * 16, sR[i], sC[i]);
  const int nt = K / 128;
#define GSRC8(base, i, kt) ((base) + (size_t)sR[i] * K + (kt) * 128 + sC[i] * 2)
#define GLDS_STAGE8(buf, kt)                                                                                          \
  do {                                                                                                                \
    _Pragma("unroll") for (int i = 0; i < 4; ++i) {                                                                   \
      __builtin_amdgcn_global_load_lds((const unsigned*)GSRC8(Wb, i, kt),                                            \
                                       (unsigned*)(shm + (buf) * GSTAGE_B + wid * 1024 + i * 8192), 16, 0, 0);        \
      __builtin_amdgcn_global_load_lds((const unsigned*)GSRC8(Xb, i, kt),                                            \
                                       (unsigned*)(shm + (buf) * GSTAGE_B + GTILE_B + wid * 1024 + i * 8192), 16, 0, 0); \
    }                                                                                                                 \
  } while (0)
  __syncthreads();
  GLDS_STAGE8(0, 0);
  WAIT_V0();
  __syncthreads();
#pragma unroll 1
  for (int t = 0; t < nt; ++t) {
    const int cur = t & 1;
    if (t + 1 < nt) GLDS_STAGE8(cur ^ 1, t + 1);
    const char* sa = shm + cur * GSTAGE_B;
    const char* sb = sa + GTILE_B;
    i32x8g Bf[4];
#pragma unroll
    for (int n = 0; n < 4; ++n)
      Bf[n] = ld32g(sb + lds_byte(wc * 64 + n * 16 + fr, fq * 8), sb + lds_byte(wc * 64 + n * 16 + fr, 32 + fq * 8));
#pragma unroll
    for (int mh = 0; mh < 2; ++mh) {
      i32x8g At[4];
#pragma unroll
      for (int m = 0; m < 4; ++m)
        At[m] = ld32g(sa + lds_byte(wr * 128 + (mh * 4 + m) * 16 + fr, fq * 8), sa + lds_byte(wr * 128 + (mh * 4 + m) * 16 + fr, 32 + fq * 8));
#pragma unroll
      for (int m = 0; m < 4; ++m)
#pragma unroll
        for (int n = 0; n < 4; ++n)
          acc[mh * 4 + m][n] = __builtin_amdgcn_mfma_scale_f32_16x16x128_f8f6f4(At[m], Bf[n], acc[mh * 4 + m][n], 0, 0, 0, sw, 0, sx);
    }
    __builtin_amdgcn_sched_barrier(0);
    WAIT_V0();
    __syncthreads();
  }
#undef GSRC8
#undef GLDS_STAGE8
}
constexpr int SC_ONE = 0x7f7f7f7f;
constexpr int SC_M6 = 0x79797979;
constexpr int SC_M4 = 0x7b7b7b7b;

DI float sum8(const float* p) {
  const float4* q = (const float4*)p;
  float4 a = q[0], b = q[1];
  return (a.x + a.y + a.z + a.w) + (b.x + b.y + b.z + b.w);
}
DI float quad_sum(float v) {
  v += __shfl_xor(v, 16);
  v += __shfl_xor(v, 32);
  return v;
}

DI unsigned pack4_fp8(float a, float b, float c, float d);
DI int perm64(int s);
enum { EPI_A_IN = 0, EPI_B_IN = 1, EPI_QKV_UP = 2, EPI_OUT = 3, EPI_PLE = 4 };

DI void store4bf(bf16_t* dst, float a, float b, float c, float d) {
  uint2 o;
  o.x = pack2(a, b);
  o.y = pack2(c, d);
  *(uint2*)dst = o;
}
DI void store_pair_bf(bf16_t* dst, int fq, float a0, float a1, float a2, float a3, float b0, float b1, float b2, float b3) {
  const unsigned ax = pack2(a0, a1), ay = pack2(a2, a3), bx = pack2(b0, b1), by = pack2(b2, b3);
  auto r0 = __builtin_amdgcn_permlane16_swap(ax, bx, false, false);
  auto r1 = __builtin_amdgcn_permlane16_swap(ay, by, false, false);
  *(uint4*)(dst + (fq & 1) * 16 + (fq >> 1) * 8) = make_uint4(r0[0], r1[0], r0[1], r1[1]);
}
DI void store_vt4(bf16_t* dst, float a, float b, float c, float d) {
  dst[0] = (bf16_t)f2bf(a);
  dst[S] = (bf16_t)f2bf(b);
  dst[2 * S] = (bf16_t)f2bf(c);
  dst[3 * S] = (bf16_t)f2bf(d);
}

template <int EPI>
DI void gemm_phase(const Params& P, int layer, char* lds) {
  const int tid = get_tid();
  const int wid = tid >> 6, lane = tid & 63, wr = wid >> 2, wc = wid & 3, fr = lane & 15, fq = lane >> 4;
  const int j = layer >> 1;
  char* ws = uniform_ptr(P.ws);
  bf16_t* wbase = (bf16_t*)(ws + OFF_W);
  bf16_t* hb = (bf16_t*)(ws + OFF_HB);
  bf16_t* og = (bf16_t*)(ws + OFF_HB);
  bf16_t* zb = (bf16_t*)(ws + OFF_Z);
  bf16_t* hmb = (bf16_t*)(ws + OFF_Z);
  bf16_t* qb = (bf16_t*)(ws + OFF_Q);
  bf16_t* eb = (bf16_t*)(ws + OFF_Q);
  bf16_t* kb = (bf16_t*)(ws + OFF_K);
  bf16_t* vt = (bf16_t*)(ws + OFF_VT);
  bf16_t* cqb = (bf16_t*)(ws + OFF_CQ);
  bf16_t* ckvb = (bf16_t*)(ws + OFF_CKV);
  bf16_t* krb = (bf16_t*)(ws + OFF_KR);
  const bf16_t* pbb = (const bf16_t*)(ws + OFF_PB);
  float* ssqh = (float*)(ws + OFF_SSQH);
  float* ssqm = (float*)(ws + OFF_SSQM);
  float* ssqc = (float*)(ws + OFF_SSQC);
  const float* rope = (const float*)(ws + OFF_ROPE);

  int NT, ntiles;
  if constexpr (EPI == EPI_A_IN) { NT = 10; ntiles = 128 * 10; }
  else if constexpr (EPI == EPI_B_IN) { NT = 7; ntiles = 128 * 7; }
  else if constexpr (EPI == EPI_QKV_UP) { NT = 14; ntiles = 128 * 14; }
  else if constexpr (EPI == EPI_OUT) { NT = 4; ntiles = 128 * 8; }
  else { NT = 4; ntiles = 128 * 4; }

  for (int tile = blockIdx.x; tile < ntiles; tile += gridDim.x) {
    int t2 = tile;
    bool second = false;
    if constexpr (EPI == EPI_OUT) {
      if (t2 >= 512) { second = true; t2 -= 512; }
    }
    int mt = t2 / NT, nt = t2 - mt * NT;
    if (gridDim.x == 256) {
      const int x = blockIdx.x & 7, s = blockIdx.x >> 3, k = t2 >> 8;
      const int idx = s + 32 * k;
      mt = (idx / NT) * 8 + x;
      nt = idx - (idx / NT) * NT;
    }
    const int m0 = mt * 256, n0 = nt * 256;
    f32x4 acc[8][4];
#pragma unroll
    for (int m = 0; m < 8; ++m)
#pragma unroll
      for (int n = 0; n < 4; ++n) acc[m][n] = f32x4{0.f, 0.f, 0.f, 0.f};

    if constexpr (EPI == EPI_A_IN) {
      gemm_core(acc, wbase + W_A_IN + (size_t)j * 2560 * 1024 + (size_t)n0 * 1024, hb + (size_t)m0 * 1024, 1024, lds);
      const float qs = 0.125f * LOG2E;
#pragma unroll
      for (int n = 0; n < 4; ++n) {
        const int tok = m0 + wc * 64 + n * 16 + fr;
        const float rstd = rsqrtf(sum8(ssqh + (size_t)tok * 8) * (1.f / 1024.f) + EPS);
        const int b = tok >> 13, s = tok & (S - 1);
        if (nt == 5) {
#pragma unroll
          for (int m = 0; m < 8; ++m) {
            const int f = n0 + wr * 128 + m * 16 + fq * 4;
            store_vt4(vt + ((size_t)(b * 4) * 64 + (f - 1280)) * S + perm16(s), acc[m][n][0] * rstd, acc[m][n][1] * rstd,
                      acc[m][n][2] * rstd, acc[m][n][3] * rstd);
          }
        } else {
          const float sc_ = (nt < 4) ? rstd * qs : rstd;
          const int fg = n0 + wr * 128;
          bf16_t* rowp = (nt < 4) ? (qb + (size_t)tok * 1024 + fg) : (nt == 4) ? (kb + (size_t)tok * 256 + (fg - 1024))
                                                                              : (zb + (size_t)tok * 1024 + (fg - 1536));
#pragma unroll
          for (int m = 0; m < 8; m += 2)
            store_pair_bf(rowp + m * 16, fq, acc[m][n][0] * sc_, acc[m][n][1] * sc_, acc[m][n][2] * sc_, acc[m][n][3] * sc_,
                          acc[m + 1][n][0] * sc_, acc[m + 1][n][1] * sc_, acc[m + 1][n][2] * sc_, acc[m + 1][n][3] * sc_);
        }
      }
    } else if constexpr (EPI == EPI_B_IN) {
      gemm_core8(acc, (const unsigned char*)(wbase + W_B_IN + (size_t)j * 1792 * 1024) + (size_t)n0 * 1024, (const unsigned char*)hb + (size_t)m0 * 1024, 1024, lds, SC_M6, SC_ONE);
      const int fbase = n0 + wr * 128;
#pragma unroll
      for (int n = 0; n < 4; ++n) {
        const int tok = m0 + wc * 64 + n * 16 + fr;
        const float rstd = rsqrtf(sum8(ssqh + (size_t)tok * 8) * (1.f / 1024.f) + EPS);
        const int s = tok & (S - 1);
        if (fbase < 1024) {
#pragma unroll
          for (int m = 0; m < 8; m += 2)
            store_pair_bf(zb + (size_t)tok * 1024 + fbase + m * 16, fq, acc[m][n][0] * rstd, acc[m][n][1] * rstd, acc[m][n][2] * rstd,
                          acc[m][n][3] * rstd, acc[m + 1][n][0] * rstd, acc[m + 1][n][1] * rstd, acc[m + 1][n][2] * rstd,
                          acc[m + 1][n][3] * rstd);
        } else if (fbase < 1664) {
          float sq = 0.f;
          const bool iscq = fbase < 1408;
#pragma unroll
          for (int m = 0; m < 8; ++m) {
            const float v0 = acc[m][n][0] * rstd, v1 = acc[m][n][1] * rstd, v2 = acc[m][n][2] * rstd, v3 = acc[m][n][3] * rstd;
            sq += v0 * v0 + v1 * v1 + v2 * v2 + v3 * v3;
            const int f = fbase + m * 16 + fq * 4;
            if (iscq) *(unsigned*)((unsigned char*)cqb + (size_t)tok * 384 + (f - 1024)) = pack4_fp8c(v0, v1, v2, v3);
            else *(unsigned*)((unsigned char*)ckvb + (size_t)tok * 256 + (f - 1408)) = pack4_fp8c(v0, v1, v2, v3);
          }
          sq = quad_sum(sq);
          if (fq == 0) {
            const int pi = iscq ? ((fbase - 1024) >> 7) : (4 + ((fbase - 1408) >> 7));
            ssqc[(size_t)tok * 8 + pi] = sq;
          }
        } else {
          const float4 cs = *(const float4*)(rope + s * 32 + fq * 4);
          const float4 sn = *(const float4*)(rope + s * 32 + 16 + fq * 4);
          const float x10 = acc[0][n][0] * rstd, x11 = acc[0][n][1] * rstd, x12 = acc[0][n][2] * rstd, x13 = acc[0][n][3] * rstd;
          const float x20 = acc[1][n][0] * rstd, x21 = acc[1][n][1] * rstd, x22 = acc[1][n][2] * rstd, x23 = acc[1][n][3] * rstd;
          unsigned char* kr8 = (unsigned char*)krb;
          *(unsigned*)(kr8 + (size_t)tok * 32 + fq * 4) =
              pack4_fp8c(x10 * cs.x - x20 * sn.x, x11 * cs.y - x21 * sn.y, x12 * cs.z - x22 * sn.z, x13 * cs.w - x23 * sn.w);
          *(unsigned*)(kr8 + (size_t)tok * 32 + 16 + fq * 4) =
              pack4_fp8c(x10 * sn.x + x20 * cs.x, x11 * sn.y + x21 * cs.y, x12 * sn.z + x22 * cs.z, x13 * sn.w + x23 * cs.w);
        }
      }
    } else if constexpr (EPI == EPI_QKV_UP) {
      if (nt < 6) {
        gemm_core8(acc, (const unsigned char*)(wbase + W_B_QB + (size_t)j * 1536 * 384) + (size_t)n0 * 384, (const unsigned char*)cqb + (size_t)m0 * 384, 384, lds, SC_M6, SC_ONE);
        const float qs = 0.10206207261596575f * LOG2E;
#pragma unroll
        for (int n = 0; n < 4; ++n) {
          const int tok = m0 + wc * 64 + n * 16 + fr;
          const float* pc = ssqc + (size_t)tok * 8;
          const float rstd = rsqrtf((pc[0] + pc[1] + pc[2]) * (1.f / 384.f) + EPS) * qs;
          const int s = tok & (S - 1);
          const float4 cs = *(const float4*)(rope + s * 32 + fq * 4);
          const float4 sn = *(const float4*)(rope + s * 32 + 16 + fq * 4);
#pragma unroll
          for (int mp = 0; mp < 4; ++mp) {
            const int fb = n0 + wr * 128 + mp * 32;
            const int cb = fb >> 5;
            unsigned char* dst = (unsigned char*)qb + (size_t)tok * 1536 + fb + fq * 4;
            const float x10 = acc[2 * mp][n][0] * rstd, x11 = acc[2 * mp][n][1] * rstd, x12 = acc[2 * mp][n][2] * rstd,
                        x13 = acc[2 * mp][n][3] * rstd;
            const float x20 = acc[2 * mp + 1][n][0] * rstd, x21 = acc[2 * mp + 1][n][1] * rstd, x22 = acc[2 * mp + 1][n][2] * rstd,
                        x23 = acc[2 * mp + 1][n][3] * rstd;
            if ((cb % 3) == 2) {
              *(unsigned*)dst = pack4_fp8c(x10 * cs.x - x20 * sn.x, x11 * cs.y - x21 * sn.y, x12 * cs.z - x22 * sn.z, x13 * cs.w - x23 * sn.w);
              *(unsigned*)(dst + 16) = pack4_fp8c(x10 * sn.x + x20 * cs.x, x11 * sn.y + x21 * cs.y, x12 * sn.z + x22 * cs.z, x13 * sn.w + x23 * cs.w);
            } else {
              *(unsigned*)dst = pack4_fp8c(x10, x11, x12, x13);
              *(unsigned*)(dst + 16) = pack4_fp8c(x20, x21, x22, x23);
            }
          }
        }
      } else {
        const int n0k = (nt - 6) * 256;
        gemm_core8(acc, (const unsigned char*)(wbase + W_B_KVB + (size_t)j * 2048 * 256) + (size_t)n0k * 256, (const unsigned char*)ckvb + (size_t)m0 * 256, 256, lds, SC_M6, SC_ONE);
        const int hd = (nt - 6) * 2 + wr;
#pragma unroll
        for (int n = 0; n < 4; ++n) {
          const int tok = m0 + wc * 64 + n * 16 + fr;
          const float* pc = ssqc + (size_t)tok * 8 + 4;
          const float rstd = rsqrtf((pc[0] + pc[1]) * (1.f / 256.f) + EPS);
          const int b = tok >> 13, s = tok & (S - 1);
#pragma unroll
          for (int m = 0; m < 8; ++m) {
            const float v0 = acc[m][n][0] * rstd, v1 = acc[m][n][1] * rstd, v2 = acc[m][n][2] * rstd, v3 = acc[m][n][3] * rstd;
            if (m < 4) {
              *(unsigned*)((unsigned char*)kb + (size_t)tok * 1024 + hd * 64 + m * 16 + fq * 4) = pack4_fp8c(v0, v1, v2, v3);
            } else {
              const float p0 = __shfl_xor(v0, 1), p1 = __shfl_xor(v1, 1), p2 = __shfl_xor(v2, 1), p3 = __shfl_xor(v3, 1);
              const bool odd = fr & 1;
              const float a0 = odd ? p2 : v0, b0 = odd ? v2 : p0;
              const float a1 = odd ? p3 : v1, b1 = odd ? v3 : p1;
              const int d = (m - 4) * 16 + fq * 4 + (odd ? 2 : 0);
              unsigned char* dst = (unsigned char*)vt + ((size_t)(b * 16 + hd) * 64 + d) * S + perm64(s & ~1);
              *(unsigned short*)dst = (unsigned short)(__builtin_amdgcn_cvt_pk_fp8_f32(clamp8(a0), clamp8(b0), 0, false) & 0xffff);
              *(unsigned short*)(dst + S) = (unsigned short)(__builtin_amdgcn_cvt_pk_fp8_f32(clamp8(a1), clamp8(b1), 0, false) & 0xffff);
            }
          }
        }
      }
    } else if constexpr (EPI == EPI_OUT) {
      if (!second) {
        if (layer & 1) {
          const unsigned char* wt = (const unsigned char*)(wbase + W_B_OUT + (size_t)j * 1024 * 1024);
          gemm_core8(acc, wt + (size_t)n0 * 1024, (const unsigned char*)og + (size_t)m0 * 1024, 1024, lds, SC_M6, SC_M4);
        } else {
          gemm_core(acc, wbase + W_A_OUT + (size_t)j * 1024 * 1024 + (size_t)n0 * 1024, og + (size_t)m0 * 1024, 1024, lds);
        }
        float* outp = uniform_ptr(P.out);
        const float* resid = (layer == 0) ? uniform_ptr(P.x) : outp;
#pragma unroll
        for (int n = 0; n < 4; ++n) {
          const int tok = m0 + wc * 64 + n * 16 + fr;
          float sq = 0.f;
#pragma unroll
          for (int m = 0; m < 8; m += 2) {
            const int f = n0 + wr * 128 + m * 16 + fq * 4;
            float4 rv = *(const float4*)(resid + (size_t)tok * DM + f);
            float4 rw = *(const float4*)(resid + (size_t)tok * DM + f + 16);
            rv.x += acc[m][n][0];
            rv.y += acc[m][n][1];
            rv.z += acc[m][n][2];
            rv.w += acc[m][n][3];
            rw.x += acc[m + 1][n][0];
            rw.y += acc[m + 1][n][1];
            rw.z += acc[m + 1][n][2];
            rw.w += acc[m + 1][n][3];
            sq += rv.x * rv.x + rv.y * rv.y + rv.z * rv.z + rv.w * rv.w;
            sq += rw.x * rw.x + rw.y * rw.y + rw.z * rw.z + rw.w * rw.w;
            *(float4*)(outp + (size_t)tok * DM + f) = rv;
            *(float4*)(outp + (size_t)tok * DM + f + 16) = rw;
            store_pair_bf(hmb + (size_t)tok * DM + n0 + wr * 128 + m * 16, fq, rv.x, rv.y, rv.z, rv.w, rw.x, rw.y, rw.z, rw.w);
          }
          sq = quad_sum(sq);
          if (fq == 0) ssqm[(size_t)tok * 8 + nt * 2 + wr] = sq;
        }
      } else {
        gemm_core(acc, wbase + W_PLE + (size_t)layer * 1024 * 256 + (size_t)n0 * 256, pbb + ((size_t)layer * T + m0) * 256, 256, lds);
#pragma unroll
        for (int n = 0; n < 4; ++n) {
          const int tok = m0 + wc * 64 + n * 16 + fr;
#pragma unroll
          for (int m = 0; m < 8; m += 2)
            store_pair_bf(eb + (size_t)tok * DM + n0 + wr * 128 + m * 16, fq, acc[m][n][0], acc[m][n][1], acc[m][n][2], acc[m][n][3],
                          acc[m + 1][n][0], acc[m + 1][n][1], acc[m + 1][n][2], acc[m + 1][n][3]);
        }
      }
    } else {
      gemm_core(acc, wbase + W_GATE + (size_t)layer * 1024 * 1024 + (size_t)n0 * 1024, hmb + (size_t)m0 * 1024, 1024, lds);
      float* outp = uniform_ptr(P.out);
#pragma unroll
      for (int n = 0; n < 4; ++n) {
        const int tok = m0 + wc * 64 + n * 16 + fr;
        const float rstd = rsqrtf(sum8(ssqm + (size_t)tok * 8) * (1.f / 1024.f) + EPS);
        float sq = 0.f;
#pragma unroll
        for (int m = 0; m < 8; ++m) {
          const int f = n0 + wr * 128 + m * 16 + fq * 4;
          float4 hv = *(const float4*)(outp + (size_t)tok * DM + f);
          const uint2 ee = *(const uint2*)(eb + (size_t)tok * DM + f);
          hv.x += bf2f(ee.x & 0xffffu) / (1.f + __expf(-acc[m][n][0] * rstd));
          hv.y += bf2f(ee.x >> 16) / (1.f + __expf(-acc[m][n][1] * rstd));
          hv.z += bf2f(ee.y & 0xffffu) / (1.f + __expf(-acc[m][n][2] * rstd));
          hv.w += bf2f(ee.y >> 16) / (1.f + __expf(-acc[m][n][3] * rstd));
          sq += hv.x * hv.x + hv.y * hv.y + hv.z * hv.z + hv.w * hv.w;
          *(float4*)(outp + (size_t)tok * DM + f) = hv;
          if ((layer & 1) == 0) *(unsigned*)((unsigned char*)hb + (size_t)tok * DM + f) = pack4_fp8c(hv.x, hv.y, hv.z, hv.w);
          else if (layer != 3) store4bf(hb + (size_t)tok * DM + f, hv.x, hv.y, hv.z, hv.w);
        }
        sq = quad_sum(sq);
        if (fq == 0) ssqh[(size_t)tok * 8 + nt * 2 + wr] = sq;
      }
    }
  }
}

template <bool MLA>
DI void attn_phase(const Params& P, int layer, char* lds) {
  constexpr int DQK = MLA ? 96 : 64;
  constexpr int KSTR = DQK * 2 + 16;
  constexpr int VSTR = 144;
  constexpr int KBYTES = 64 * KSTR;
  constexpr int ASTAGE = KBYTES + 64 * VSTR;
  constexpr int NKS = DQK / 16;
  const int tid = get_tid();
  const int lane = tid & 63, w = tid >> 6;
  const int r = lane & 31, h = lane >> 5;
  char* ws = uniform_ptr(P.ws);
  const bf16_t* qg = (const bf16_t*)(ws + OFF_Q);
  const bf16_t* kg = (const bf16_t*)(ws + OFF_K);
  const bf16_t* vtg = (const bf16_t*)(ws + OFF_VT);
  const bf16_t* krg = (const bf16_t*)(ws + OFF_KR);
  const bf16_t* zg = (const bf16_t*)(ws + OFF_Z);
  bf16_t* og = (bf16_t*)(ws + OFF_HB);
  const int j = layer >> 1;

  const int nitems = 2048;
  for (int item = blockIdx.x; item < nitems; item += gridDim.x) {
    int b, head, hkv, q0, t_lo, t_hi;
    int nheads_kv;
    if constexpr (MLA) {
      const int xcd = item & 7, slot = (item >> 3) & 31, grp = item >> 8;
      const int bh = grp * 8 + xcd;
      b = bh >> 4;
      head = bh & 15;
      hkv = head;
      nheads_kv = 16;
      q0 = slot * 256 + w * 32;
      t_lo = 0;
      t_hi = S / 64;
    } else {
      const int hp = item & 7, qblk = (item >> 3) & 63;
      b = item >> 9;
      head = hp * 2 + (w >> 2);
      hkv = hp >> 1;
      nheads_kv = 4;
      const int t0 = qblk * 128;
      q0 = t0 + (w & 3) * 32;
      const int lo = (t0 - 128 > 0) ? (t0 - 128) : 0;
      const int hi = (t0 + 256 < S) ? (t0 + 256) : S;
      t_lo = lo >> 6;
      t_hi = hi >> 6;
    }
    const int qld = MLA ? 1536 : 1024;
    const int tokq = b * S + q0 + r;
    bf16x8 qf[NKS];
#pragma unroll
    for (int ks = 0; ks < NKS; ++ks)
      qf[ks] = *(const bf16x8*)(qg + (size_t)tokq * qld + head * DQK + ks * 16 + 8 * h);

    float m_run, l_run;
    float slope2 = 0.f;
    if constexpr (MLA) {
      m_run = 0.f;
      l_run = 0.f;
    } else {
      m_run = P.a_sink[j * 16 + head] * LOG2E;
      l_run = (h == 0) ? 1.f : 0.f;
      slope2 = exp2f(-0.5f * (float)(head + 1)) * LOG2E;
    }
    f32x16 o[2], negm;
#pragma unroll
    for (int i = 0; i < 16; ++i) { o[0][i] = 0.f; o[1][i] = 0.f; negm[i] = -m_run; }

    const int lrow = tid >> 3, lc = tid & 7;
    uint4 kreg, vreg, rreg;
    auto load_regs = [&](int t) {
      const int kbase = t * 64;
      if constexpr (MLA) {
        kreg = *(const uint4*)(kg + (size_t)(b * S + kbase + lrow) * 1024 + head * 64 + lc * 8);
        if (tid < 256) rreg = *(const uint4*)(krg + (size_t)(b * S + kbase + (tid >> 2)) * 32 + (tid & 3) * 8);
      } else {
        kreg = *(const uint4*)(kg + (size_t)(b * S + kbase + lrow) * 256 + hkv * 64 + lc * 8);
      }
      vreg = *(const uint4*)(vtg + ((size_t)(b * nheads_kv + hkv) * 64 + lrow) * S + kbase + lc * 8);
    };
    auto write_lds = [&](int st) {
      char* base = lds + st * ASTAGE;
      *(uint4*)(base + lrow * KSTR + lc * 16) = kreg;
      if constexpr (MLA) {
        if (tid < 256) *(uint4*)(base + (tid >> 2) * KSTR + 128 + (tid & 3) * 16) = rreg;
      }
      *(uint4*)(base + KBYTES + lrow * VSTR + lc * 16) = vreg;
    };

    __syncthreads();
    load_regs(t_lo);
    write_lds(0);
    __syncthreads();
#pragma unroll 1
    for (int t = t_lo; t < t_hi; ++t) {
      load_regs((t + 1 < t_hi) ? (t + 1) : t);
      const char* base = lds + ((t - t_lo) & 1) * ASTAGE;
      const int kbase = t * 64;
      bool active = true;
      if constexpr (!MLA) active = (kbase + 63 >= q0 - 128) && (kbase <= q0 + 159);
      if (active) {
        f32x16 sc[2];
        {
          bf16x8 kf[2][NKS];
#pragma unroll
          for (int kb = 0; kb < 2; ++kb)
#pragma unroll
            for (int ks = 0; ks < NKS; ++ks) kf[kb][ks] = *(const bf16x8*)(base + (kb * 32 + r) * KSTR + h * 16 + ks * 32);
#pragma unroll
          for (int kb = 0; kb < 2; ++kb) {
            sc[kb] = MFMA(kf[kb][0], qf[0], negm);
#pragma unroll
            for (int ks = 1; ks < NKS; ++ks) sc[kb] = MFMA(kf[kb][ks], qf[ks], sc[kb]);
          }
        }
        if constexpr (!MLA) {
          const int tq = q0 + r;
#pragma unroll
          for (int kb = 0; kb < 2; ++kb)
#pragma unroll
            for (int i = 0; i < 16; ++i) {
              const int kp = kbase + kb * 32 + crow(i, h);
              int d = kp - tq;
              d = d < 0 ? -d : d;
              sc[kb][i] = (d <= 128) ? (sc[kb][i] - slope2 * (float)d) : -1e30f;
            }
        }
        int imx = max(__float_as_int(sc[0][0]), __float_as_int(sc[1][0]));
#pragma unroll
        for (int i = 1; i < 16; ++i) imx = max(imx, max(__float_as_int(sc[0][i]), __float_as_int(sc[1][i])));
        bool slow = __any(imx > 0x41000000);
        if constexpr (MLA) slow = slow || (t == t_lo);
        if (slow) {
          float mx = fmaxf(sc[0][0], sc[1][0]);
#pragma unroll
          for (int i = 1; i < 16; ++i) mx = fmaxf(mx, fmaxf(sc[0][i], sc[1][i]));
          mx = xhalf_max(mx);
          float delta = fmaxf(mx, 0.f);
          if constexpr (MLA) { if (t == t_lo) delta = mx; }
          float alpha = __builtin_amdgcn_exp2f(-delta);
          if constexpr (MLA) { if (t == t_lo) alpha = 1.f; }
          m_run += delta;
          l_run *= alpha;
#pragma unroll
          for (int i = 0; i < 16; ++i) {
            o[0][i] *= alpha;
            o[1][i] *= alpha;
            sc[0][i] -= delta;
            sc[1][i] -= delta;
            negm[i] = -m_run;
          }
        }
        f32x2_t ps2 = {0.f, 0.f};
        bf16x8 pf[2][2];
#pragma unroll
        for (int kb = 0; kb < 2; ++kb) {
#pragma unroll
          for (int i = 0; i < 16; i += 2) {
            const float p0 = __builtin_amdgcn_exp2f(sc[kb][i]);
            const float p1 = __builtin_amdgcn_exp2f(sc[kb][i + 1]);
            sc[kb][i] = p0;
            sc[kb][i + 1] = p1;
            ps2 += f32x2_t{p0, p1};
          }
#pragma unroll
          for (int sidx = 0; sidx < 2; ++sidx) {
            uint4 u;
            u.x = pack2(sc[kb][8 * sidx + 0], sc[kb][8 * sidx + 1]);
            u.y = pack2(sc[kb][8 * sidx + 2], sc[kb][8 * sidx + 3]);
            u.z = pack2(sc[kb][8 * sidx + 4], sc[kb][8 * sidx + 5]);
            u.w = pack2(sc[kb][8 * sidx + 6], sc[kb][8 * sidx + 7]);
            pf[kb][sidx] = __builtin_bit_cast(bf16x8, u);
          }
        }
        l_run += ps2[0] + ps2[1];
#pragma unroll
        for (int db = 0; db < 2; ++db) {
          const char* lv = base + KBYTES + (db * 32 + r) * VSTR + h * 16;
#pragma unroll
          for (int kb = 0; kb < 2; ++kb)
#pragma unroll
            for (int sidx = 0; sidx < 2; ++sidx) {
              bf16x8 vf = *(const bf16x8*)(lv + kb * 64 + sidx * 32);
              o[db] = MFMA(vf, pf[kb][sidx], o[db]);
            }
        }
      }
      write_lds((t + 1 - t_lo) & 1);
      __syncthreads();
    }
    const float l_tot = l_run + __shfl_xor(l_run, 32);
    const float inv = 1.f / l_tot;
#pragma unroll
    for (int db = 0; db < 2; ++db)
#pragma unroll
      for (int g = 0; g < 4; ++g) {
        const int d = db * 32 + 8 * g + 4 * h;
        const size_t off = (size_t)tokq * 1024 + head * 64 + d;
        const uint2 zz = *(const uint2*)(zg + off);
        const float z0 = bf2f(zz.x & 0xffffu), z1 = bf2f(zz.x >> 16), z2 = bf2f(zz.y & 0xffffu), z3 = bf2f(zz.y >> 16);
        const float g0 = z0 / (1.f + __expf(-z0)), g1 = z1 / (1.f + __expf(-z1)), g2 = z2 / (1.f + __expf(-z2)),
                    g3 = z3 / (1.f + __expf(-z3));
        store4bf(og + off, o[db][4 * g] * inv * g0, o[db][4 * g + 1] * inv * g1, o[db][4 * g + 2] * inv * g2,
                 o[db][4 * g + 3] * inv * g3);
      }
  }
}

typedef __attribute__((ext_vector_type(8))) int i32x8;
#define MFMA8(a, b, c) __builtin_amdgcn_mfma_scale_f32_32x32x64_f8f6f4((a), (b), (c), 0, 0, 0, 0x7f7f7f7f, 0, 0x7f7f7f7f)
DI unsigned pack4_fp8(float a, float b, float c, float d) {
  int r = __builtin_amdgcn_cvt_pk_fp8_f32(a, b, 0, false);
  r = __builtin_amdgcn_cvt_pk_fp8_f32(c, d, r, true);
  return (unsigned)r;
}
DI float clamp8(float x) { return __builtin_amdgcn_fmed3f(x, -440.f, 440.f); }
DI unsigned pack4_fp8c(float a, float b, float c, float d) { return pack4_fp8(clamp8(a), clamp8(b), clamp8(c), clamp8(d)); }
DI int perm64(int s) {
  const int c = (s >> 2) & 15;
  const int pc = ((c & 1) << 3) | (c >> 1);
  return (s & ~63) | (pc << 2) | (s & 3);
}
DI i32x8 ld32(const char* p) {
  const uint4 a = *(const uint4*)p, b = *(const uint4*)(p + 16);
  i32x8 r = {(int)a.x, (int)a.y, (int)a.z, (int)a.w, (int)b.x, (int)b.y, (int)b.z, (int)b.w};
  return r;
}

DI void attn_mla8_phase(const Params& P, char* lds) {
  constexpr int KSTR = 144;
  constexpr int VSTR = 80;
  constexpr int KBYTES = 64 * KSTR;
  constexpr int ASTAGE = KBYTES + 64 * VSTR;
  constexpr float PBIAS = 6.f;
  const int tid = get_tid();
  const int lane = tid & 63, w = tid >> 6;
  const int r = lane & 31, h = lane >> 5;
  char* ws = uniform_ptr(P.ws);
  const unsigned char* qg = (const unsigned char*)(ws + OFF_Q);
  const unsigned char* kg = (const unsigned char*)(ws + OFF_K);
  const unsigned char* vtg = (const unsigned char*)(ws + OFF_VT);
  const unsigned char* krg = (const unsigned char*)(ws + OFF_KR);
  const bf16_t* zg = (const bf16_t*)(ws + OFF_Z);
  bf16_t* og = (bf16_t*)(ws + OFF_HB);

  __syncthreads();
  if (tid < 384) {
    const int zr = tid >> 1, zs = tid >> 7;
    *(uint4*)(lds + zs * ASTAGE + (zr & 63) * KSTR + 96 + (tid & 1) * 16) = make_uint4(0u, 0u, 0u, 0u);
  }
  for (int item = blockIdx.x; item < 2048; item += gridDim.x) {
    const int xcd = item & 7, slot = (item >> 3) & 31, grp = item >> 8;
    const int bh = grp * 8 + xcd;
    const int b = bh >> 4, head = bh & 15;
    const int q0 = slot * 256 + w * 32;
    const int tokq = b * S + q0 + r;
    const unsigned char* qrow = qg + (size_t)tokq * 1536 + head * 96;
    const i32x8 qn = ld32((const char*)qrow + 32 * h);
    i32x8 qr = ld32((const char*)qrow + 64);
    if (h) qr = i32x8{0, 0, 0, 0, 0, 0, 0, 0};

    float m_run = 0.f, l_run = 0.f;
    f32x16 o[2], negm;
#pragma unroll
    for (int i = 0; i < 16; ++i) { o[0][i] = 0.f; o[1][i] = 0.f; negm[i] = PBIAS; }

    const int lrow = (tid & 255) >> 2, lc = tid & 3;
    const bool isk = tid < 256;
    const unsigned char* gmain = isk ? (kg + (size_t)(b * S + lrow) * 1024 + head * 64 + lc * 16)
                                     : (vtg + ((size_t)(b * 16 + head) * 64 + lrow) * S + lc * 16);
    const int gstep = isk ? 65536 : 64;
    const int lmain = isk ? (lrow * KSTR + lc * 16) : (KBYTES + lrow * VSTR + lc * 16);
    const int rrow = (tid & 127) >> 1, rc = tid & 1;
    const unsigned char* grope = krg + (size_t)(b * S + rrow) * 32 + rc * 16;
    const int lrope = rrow * KSTR + 64 + rc * 16;
    uint4 areg, rreg;
#define MLA8_LOAD(t_)                                             \
  do {                                                            \
    areg = *(const uint4*)(gmain + (size_t)(t_) * gstep);         \
    rreg = *(const uint4*)(grope + (size_t)(t_) * 2048);          \
  } while (0)
#define MLA8_WRITE(st_)                                           \
  do {                                                            \
    char* wb_ = lds + (st_) * ASTAGE;                             \
    *(uint4*)(wb_ + lmain) = areg;                                \
    if (tid < 128) *(uint4*)(wb_ + lrope) = rreg;                 \
  } while (0)

    i32x8 kn[2], kr[2];
    __syncthreads();
    MLA8_LOAD(0);
    MLA8_WRITE(0);
    MLA8_LOAD(1);
    MLA8_WRITE(1);
    __syncthreads();
#pragma unroll
    for (int kb = 0; kb < 2; ++kb) {
      const char* lk = lds + (kb * 32 + r) * KSTR;
      kn[kb] = ld32(lk + 32 * h);
      kr[kb] = ld32(lk + 64 + 32 * h);
    }
    int st_cur = 0;
#pragma unroll 1
    for (int t = 0; t < S / 64; ++t) {
      MLA8_LOAD((t + 2 < S / 64) ? (t + 2) : (S / 64 - 1));
      const char* base = lds + st_cur * ASTAGE;
      const int st_nxt = (st_cur == 2) ? 0 : st_cur + 1;
      const int st_wr = (st_nxt == 2) ? 0 : st_nxt + 1;
      f32x16 sc[2];
      i32x8 vf[2];
      vf[0] = ld32(base + KBYTES + r * VSTR + 32 * h);
      vf[1] = ld32(base + KBYTES + (32 + r) * VSTR + 32 * h);
#pragma unroll
      for (int kb = 0; kb < 2; ++kb) {
        sc[kb] = MFMA8(kn[kb], qn, negm);
        sc[kb] = MFMA8(kr[kb], qr, sc[kb]);
      }
      int imx = max(__float_as_int(sc[0][0]), __float_as_int(sc[1][0]));
#pragma unroll
      for (int i = 1; i < 16; ++i) imx = max(imx, max(__float_as_int(sc[0][i]), __float_as_int(sc[1][i])));
      const bool slow = __any(imx > 0x41000000) || (t == 0);
      if (slow) {
        float mx = fmaxf(sc[0][0], sc[1][0]);
#pragma unroll
        for (int i = 1; i < 16; ++i) mx = fmaxf(mx, fmaxf(sc[0][i], sc[1][i]));
        mx = xhalf_max(mx);
        float delta = fmaxf(mx - PBIAS, 0.f);
        float alpha = __builtin_amdgcn_exp2f(-delta);
        if (t == 0) { delta = mx - PBIAS; alpha = 1.f; }
        m_run += delta;
        l_run *= alpha;
#pragma unroll
        for (int i = 0; i < 16; ++i) {
          o[0][i] *= alpha;
          o[1][i] *= alpha;
          sc[0][i] -= delta;
          sc[1][i] -= delta;
          negm[i] = PBIAS - m_run;
        }
      }
      f32x2_t ps2 = {0.f, 0.f};
      i32x8 pb;
#pragma unroll
      for (int kb = 0; kb < 2; ++kb) {
#pragma unroll
        for (int i = 0; i < 16; i += 2) {
          const f32x2_t tt = f32x2_t{sc[kb][i], sc[kb][i + 1]} * f32x2_t{8388608.f, 8388608.f} + f32x2_t{1065353216.f, 1065353216.f};
          const float p0 = __uint_as_float((unsigned)tt[0]);
          const float p1 = __uint_as_float((unsigned)tt[1]);
          sc[kb][i] = p0;
          sc[kb][i + 1] = p1;
          ps2 += f32x2_t{p0, p1};
        }
#pragma unroll
        for (int q4 = 0; q4 < 4; ++q4)
          pb[kb * 4 + q4] = (int)pack4_fp8(sc[kb][4 * q4], sc[kb][4 * q4 + 1], sc[kb][4 * q4 + 2], sc[kb][4 * q4 + 3]);
      }
      l_run += ps2[0] + ps2[1];
#pragma unroll
      for (int db = 0; db < 2; ++db) {
        o[db] = MFMA8(vf[db], pb, o[db]);
      }
      {
        const char* nb = lds + st_nxt * ASTAGE;
#pragma unroll
        for (int kb = 0; kb < 2; ++kb) {
          const char* lk = nb + (kb * 32 + r) * KSTR;
          kn[kb] = ld32(lk + 32 * h);
          kr[kb] = ld32(lk + 64 + 32 * h);
        }
      }
      MLA8_WRITE(st_wr);
      __syncthreads();
      st_cur = st_nxt;
    }
    const float l_tot = l_run + __shfl_xor(l_run, 32);
    const float inv = 1.f / l_tot;
#pragma unroll
    for (int db = 0; db < 2; ++db)
#pragma unroll
      for (int g = 0; g < 4; ++g) {
        const int d = db * 32 + 8 * g + 4 * h;
        const size_t off = (size_t)tokq * 1024 + head * 64 + d;
        const uint2 zz = *(const uint2*)(zg + off);
        const float z0 = bf2f(zz.x & 0xffffu), z1 = bf2f(zz.x >> 16), z2 = bf2f(zz.y & 0xffffu), z3 = bf2f(zz.y >> 16);
        const float g0 = z0 / (1.f + __expf(-z0)), g1 = z1 / (1.f + __expf(-z1)), g2 = z2 / (1.f + __expf(-z2)),
                    g3 = z3 / (1.f + __expf(-z3));
        const float i64 = inv * 16.f;
        *(unsigned*)((unsigned char*)og + off) = pack4_fp8c(o[db][4 * g] * i64 * g0, o[db][4 * g + 1] * i64 * g1, o[db][4 * g + 2] * i64 * g2,
                                                         o[db][4 * g + 3] * i64 * g3);
      }
  }
#undef MLA8_LOAD
#undef MLA8_WRITE
}

DI void final_phase(const Params& P) {
  const int tid = get_tid();
  const int w = tid >> 6, lane = tid & 63;
  for (int row = blockIdx.x * 8 + w; row < T; row += gridDim.x * 8) {
    float4* xr = (float4*)(P.out + (size_t)row * DM);
    float4 v[4];
    float s = 0.f;
#pragma unroll
    for (int i = 0; i < 4; ++i) {
      v[i] = xr[lane + 64 * i];
      s += v[i].x * v[i].x + v[i].y * v[i].y + v[i].z * v[i].z + v[i].w * v[i].w;
    }
#pragma unroll
    for (int o = 32; o >= 1; o >>= 1) s += __shfl_xor(s, o);
    const float rstd = rsqrtf(s * (1.f / 1024.f) + EPS);
#pragma unroll
    for (int i = 0; i < 4; ++i) {
      const float4 g = ((const float4*)P.final_g)[lane + 64 * i];
      xr[lane + 64 * i] = make_float4(v[i].x * rstd * g.x, v[i].y * rstd * g.y, v[i].z * rstd * g.z, v[i].w * rstd * g.w);
    }
  }
}

#define XB_TMO      128
#define XB_XCNT(j)  (256  + 64 * (j))
#define XB_XSUB(j)  (1280 + 64 * (j))
#define XB_XGEN(j)  (2304 + 64 * (j))
#define XB_TOP      3328
#define XB_TOPGEN   3392
#define XCD_BAR_WORDS 3456
#define XB_SPIN_CAP (1u << 22)
#define LAS __attribute__((address_space(3)))
DI unsigned xb_ld(unsigned* p) { return __hip_atomic_load(p, __ATOMIC_RELAXED, __HIP_MEMORY_SCOPE_AGENT); }
DI unsigned xb_add(unsigned* p, unsigned v) { return __hip_atomic_fetch_add(p, v, __ATOMIC_RELAXED, __HIP_MEMORY_SCOPE_AGENT); }
DI unsigned xb_xcc_id() { return (unsigned)__builtin_amdgcn_s_getreg((3 << 11) | 20) & 0xFu; }
#define XB_SPIN(cond, bar) do { unsigned _sp = 0; while (cond) { __builtin_amdgcn_s_sleep(1); \
    if ((++_sp & 255u) == 0u) { if (xb_ld(&(bar)[XB_TMO])) break; if (_sp > XB_SPIN_CAP) { atomicAdd(&(bar)[XB_TMO], 1u); break; } } } } while (0)
struct XcdBarrier {
  unsigned* bar;
  unsigned x;
  volatile LAS unsigned* st;
};
DI XcdBarrier xcd_barrier_post(unsigned* bar, volatile LAS unsigned* st) {
  XcdBarrier b;
  b.bar = bar;
  b.x = xb_xcc_id();
  b.st = st;
  if (threadIdx.x == 0) (void)xb_add(&bar[XB_XCNT(b.x)], 1u);
  return b;
}
DI void xcd_barrier_complete(unsigned* bar, unsigned x, unsigned& nloc, unsigned& nx) {
  const unsigned G = gridDim.x * gridDim.y * gridDim.z;
  unsigned sum, cnt, mine, sp = 0u;
  for (;;) {
    sum = 0u; cnt = 0u; mine = 0u;
#pragma unroll
    for (unsigned j = 0; j < 16; ++j) {
      const unsigned c = xb_ld(&bar[XB_XCNT(j)]);
      sum += c;
      cnt += (c > 0u) ? 1u : 0u;
      mine = (j == x) ? c : mine;
    }
    if (sum == G) break;
    __builtin_amdgcn_s_sleep(1);
    if ((++sp & 255u) == 0u) { if (xb_ld(&bar[XB_TMO])) break; if (sp > XB_SPIN_CAP) { atomicAdd(&bar[XB_TMO], 1u); break; } }
  }
  nloc = mine > 0u ? mine : 1u;
  nx = cnt > 0u ? cnt : 1u;
}
DI void xcd_barrier(const XcdBarrier& b) {
  asm volatile("s_waitcnt vmcnt(0)" ::: "memory");
  __syncthreads();
  if (threadIdx.x == 0) {
    unsigned* bar = b.bar;
    __builtin_amdgcn_s_waitcnt(0);
    unsigned nloc = b.st[0], nx = b.st[1];
    if (nloc == 0u) { xcd_barrier_complete(bar, b.x, nloc, nx); b.st[0] = nloc; b.st[1] = nx; }
    const unsigned old = xb_add(&bar[XB_XSUB(b.x)], 1u);
    const unsigned gen = old / nloc;
    if (old + 1u == (gen + 1u) * nloc) {
      __builtin_amdgcn_fence(__ATOMIC_RELEASE, "agent");
      asm volatile("s_waitcnt vmcnt(0)" ::: "memory");
      const unsigned og = xb_add(&bar[XB_TOP], 1u);
      const unsigned tg = og / nx;
      if (og + 1u == (tg + 1u) * nx) xb_add(&bar[XB_TOPGEN], 1u);
      else XB_SPIN(xb_ld(&bar[XB_TOPGEN]) == tg, bar);
      __builtin_amdgcn_fence(__ATOMIC_ACQUIRE, "agent");
      xb_add(&bar[XB_XGEN(b.x)], 1u);
      asm volatile("s_waitcnt vmcnt(0)" ::: "memory");
    } else {
      XB_SPIN(xb_ld(&bar[XB_XGEN(b.x)]) == gen, bar);
      __builtin_amdgcn_fence(__ATOMIC_ACQUIRE, "agent");
      asm volatile("s_waitcnt vmcnt(0)" ::: "memory");
    }
  }
  __syncthreads();
}

constexpr int NPHASE = 1 + 2 * (4 + 5) + 1;

DI void run_phase(const Params& P, int ph, char* lds) {
  if (ph == 0) { prep_phase(P, lds); return; }
  if (ph == NPHASE - 1) { final_phase(P); return; }
  const int q = (ph - 1) / 9, rr = (ph - 1) % 9;
  if (rr < 4) {
    const int layer = q * 2;
    if (rr == 0) gemm_phase<EPI_A_IN>(P, layer, lds);
    else if (rr == 1) attn_phase<false>(P, layer, lds);
    else if (rr == 2) gemm_phase<EPI_OUT>(P, layer, lds);
    else gemm_phase<EPI_PLE>(P, layer, lds);
  } else {
    const int layer = q * 2 + 1;
    if (rr == 4) gemm_phase<EPI_B_IN>(P, layer, lds);
    else if (rr == 5) gemm_phase<EPI_QKV_UP>(P, layer, lds);
    else if (rr == 6) attn_phase<true>(P, layer, lds);
    else if (rr == 7) gemm_phase<EPI_OUT>(P, layer, lds);
    else gemm_phase<EPI_PLE>(P, layer, lds);
  }
}

__global__ void __launch_bounds__(NTHREADS) fwd_kernel(Params P) {
  __shared__ __attribute__((aligned(1024))) char lds[LDS_BYTES + 16];
#if MULTI_LAUNCH
  run_phase(P, P.phase_lo, lds);
#else
  cg::grid_group grid = cg::this_grid();
  volatile LAS unsigned* xst = (volatile LAS unsigned*)(lds + LDS_BYTES);
  if (threadIdx.x == 0) { xst[0] = 0u; xst[1] = 0u; }
  __syncthreads();
  const XcdBarrier xb = xcd_barrier_post((unsigned*)(P.ws + OFF_BAR), xst);
  prep_phase(P, lds);
#if (PROBE_REPEAT >> 9) & 1
  prep_phase(P, lds);
#endif
  grid.sync();
#pragma unroll 1
  for (int q = 0; q < 2; ++q) {
    const int la = 2 * q, lb = 2 * q + 1;
    gemm_phase<EPI_A_IN>(P, la, lds);
#if (PROBE_REPEAT >> 0) & 1
    gemm_phase<EPI_A_IN>(P, la, lds);
#endif
    GSYNC();
    attn_phase<false>(P, la, lds);
#if (PROBE_REPEAT >> 1) & 1
    attn_phase<false>(P, la, lds);
#endif
    GSYNC();
    gemm_phase<EPI_OUT>(P, la, lds);
    GSYNC();
    gemm_phase<EPI_PLE>(P, la, lds);
    GSYNC();
    gemm_phase<EPI_B_IN>(P, lb, lds);
#if (PROBE_REPEAT >> 4) & 1
    gemm_phase<EPI_B_IN>(P, lb, lds);
#endif
    GSYNC();
    gemm_phase<EPI_QKV_UP>(P, lb, lds);
#if (PROBE_REPEAT >> 5) & 1
    gemm_phase<EPI_QKV_UP>(P, lb, lds);
#endif
    GSYNC();
    attn_mla8_phase(P, lds);
#if (PROBE_REPEAT >> 6) & 1
    attn_mla8_phase(P, lds);
#endif
    GSYNC();
    gemm_phase<EPI_OUT>(P, lb, lds);
    GSYNC();
    gemm_phase<EPI_PLE>(P, lb, lds);
    GSYNC();
  }
  final_phase(P);
#endif
}

static void add_seg(Params& p, int& tiles, const float* src, const float* gain, bf16_t* dst, int src_ld, int ncols, int K, int fp8 = 0) {
  Seg& s = p.seg[p.nseg++];
  s.src = src;
  s.gain = gain;
  s.dst = dst;
  s.src_ld = src_ld;
  s.ncols = ncols;
  s.K = K;
  s.fp8 = fp8;
  s.pad0 = 0;
  s.tile0 = tiles;
  tiles += (K / 64) * (ncols / 32);
}

extern "C" void kernel_launch(void* const* d_in, const int* in_sizes, int n_in, void* d_out, int out_size, void* d_ws,
                              size_t ws_size, hipStream_t stream) {
  (void)in_sizes; (void)n_in; (void)out_size;
  if (ws_size < WS_NEEDED) {
    fprintf(stderr, "workspace too small: %zu < %zu\n", ws_size, (size_t)WS_NEEDED);
    return;
  }
  const float* x = (const float*)d_in[0];
  const float* pp = (const float*)d_in[1];
  const float* norm_g = (const float*)d_in[2];
  const float* a_w_in = (const float*)d_in[3];
  const float* a_sink = (const float*)d_in[4];
  const float* a_w_out = (const float*)d_in[5];
  const float* b_w_in = (const float*)d_in[6];
  const float* b_q_norm = (const float*)d_in[7];
  const float* b_w_qb = (const float*)d_in[8];
  const float* b_kv_norm = (const float*)d_in[9];
  const float* b_w_kvb = (const float*)d_in[10];
  const float* b_w_out = (const float*)d_in[11];
  const float* ple_w = (const float*)d_in[12];
  const float* ple_norm_g = (const float*)d_in[13];
  const float* ple_w_gate = (const float*)d_in[14];
  const float* final_g = (const float*)d_in[15];

  Params p;
  memset(&p, 0, sizeof(p));
  p.x = x;
  p.p = pp;
  p.a_sink = a_sink;
  p.final_g = final_g;
  p.out = (float*)d_out;
  p.ws = (char*)d_ws;
  bf16_t* wb = (bf16_t*)((char*)d_ws + OFF_W);
  int tiles = 0;
  for (int j = 0; j < 2; ++j) {
    const int la = 2 * j, lb = 2 * j + 1;
    add_seg(p, tiles, a_w_in + (size_t)j * 1024 * 2560, norm_g + la * 1024, wb + W_A_IN + (size_t)j * 2560 * 1024, 2560, 2560, 1024);
    add_seg(p, tiles, a_w_out + (size_t)j * 1024 * 1024, nullptr, wb + W_A_OUT + (size_t)j * 1024 * 1024, 1024, 1024, 1024);
    const float* bsrc = b_w_in + (size_t)j * 1024 * 1696;
    unsigned char* bdst = (unsigned char*)(wb + W_B_IN + (size_t)j * 1792 * 1024);
    const float* gb = norm_g + lb * 1024;
    add_seg(p, tiles, bsrc + 672, gb, (bf16_t*)bdst, 1696, 1024, 1024, 1);
    add_seg(p, tiles, bsrc + 0, gb, (bf16_t*)(bdst + (size_t)1024 * 1024), 1696, 384, 1024, 1);
    add_seg(p, tiles, bsrc + 384, gb, (bf16_t*)(bdst + (size_t)1408 * 1024), 1696, 256, 1024, 1);
    add_seg(p, tiles, bsrc + 640, gb, (bf16_t*)(bdst + (size_t)1664 * 1024), 1696, 32, 1024, 1);
    add_seg(p, tiles, nullptr, nullptr, (bf16_t*)(bdst + (size_t)1696 * 1024), 1696, 96, 1024, 1);
    add_seg(p, tiles, b_w_qb + (size_t)j * 384 * 1536, b_q_norm + j * 384, wb + W_B_QB + (size_t)j * 1536 * 384, 1536, 1536, 384, 1);
    add_seg(p, tiles, b_w_kvb + (size_t)j * 256 * 2048, b_kv_norm + j * 256, wb + W_B_KVB + (size_t)j * 2048 * 256, 2048, 2048, 256, 1);
    add_seg(p, tiles, b_w_out + (size_t)j * 1024 * 1024, nullptr, wb + W_B_OUT + (size_t)j * 1024 * 1024, 1024, 1024, 1024, 1);
  }
  for (int i = 0; i < 4; ++i) {
    add_seg(p, tiles, ple_w + (size_t)i * 256 * 1024, nullptr, wb + W_PLE + (size_t)i * 1024 * 256, 1024, 1024, 256);
    add_seg(p, tiles, ple_w_gate + (size_t)i * 1024 * 1024, ple_norm_g + i * 1024, wb + W_GATE + (size_t)i * 1024 * 1024, 1024, 1024, 1024);
  }
  p.ntile_w = tiles;

#if MULTI_LAUNCH
  for (int ph = 0; ph < NPHASE; ++ph) {
    p.phase_lo = ph;
    p.phase_hi = ph + 1;
    hipLaunchKernelGGL(fwd_kernel, dim3(1024), dim3(NTHREADS), 0, stream, p);
  }
#else
  static int grid_blocks = 0;
  if (!grid_blocks) {
    int dev = 0, cus = 0, per_cu = 0;
    hipGetDevice(&dev);
    hipDeviceGetAttribute(&cus, hipDeviceAttributeMultiprocessorCount, dev);
    hipOccupancyMaxActiveBlocksPerMultiprocessor(&per_cu, fwd_kernel, NTHREADS, 0);
    if (per_cu < 1) per_cu = 1;
    if (per_cu > 1) per_cu = 1;
    grid_blocks = cus * per_cu;
  }
  p.phase_lo = 0;
  p.phase_hi = NPHASE;
  (void)hipMemsetAsync((char*)d_ws + OFF_BAR, 0, 16384, stream);
  void* args[] = {&p};
  hipError_t e = hipLaunchCooperativeKernel((void*)fwd_kernel, dim3(grid_blocks), dim3(NTHREADS), args, 0, stream);
  if (e != hipSuccess) fprintf(stderr, "cooperative launch failed: %s (grid %d)\n", hipGetErrorString(e), grid_blocks);
#endif
}
```

```cpp
#include <hip/hip_runtime.h>
#include <hip/hip_cooperative_groups.h>
#include <cstdio>
#include <cstring>
namespace cg = cooperative_groups;

#ifndef PROBE_REPEAT
#define PROBE_REPEAT 0
#endif
#ifndef PROBE_SYNC2
#define PROBE_SYNC2 0
#endif
#if PROBE_SYNC2
#define GSYNC() do { xcd_barrier(xb); xcd_barrier(xb); } while (0)
#else
#define GSYNC() xcd_barrier(xb)
#endif
#ifndef MULTI_LAUNCH
#define MULTI_LAUNCH 0
#endif

#define DI __device__ __forceinline__
typedef __attribute__((ext_vector_type(8))) short bf16x8;
typedef __attribute__((ext_vector_type(16))) float f32x16;
typedef unsigned short bf16_t;

constexpr int T = 32768, S = 8192, NB = 4, DM = 1024, PLE = 256;
constexpr int NTHREADS = 512;
constexpr float LOG2E = 1.4426950408889634f;
constexpr float EPS = 1e-6f;

constexpr size_t MiB = 1024ull * 1024ull;
constexpr size_t OFF_HB = 0;
constexpr size_t OFF_Z = 64 * MiB;
constexpr size_t OFF_Q = 128 * MiB;
constexpr size_t OFF_K = 224 * MiB;
constexpr size_t OFF_VT = 288 * MiB;
constexpr size_t OFF_CQ = 352 * MiB;
constexpr size_t OFF_CKV = 376 * MiB;
constexpr size_t OFF_KR = 392 * MiB;
constexpr size_t OFF_SSQH = 394 * MiB;
constexpr size_t OFF_SSQM = 395 * MiB;
constexpr size_t OFF_SSQC = 396 * MiB;
constexpr size_t OFF_ROPE = 397 * MiB;
constexpr size_t OFF_W = 398 * MiB;
constexpr size_t OFF_PB = 438 * MiB;
constexpr size_t OFF_BAR = 502 * MiB;
constexpr size_t W_A_IN = 0;
constexpr size_t W_A_OUT = W_A_IN + 2ull * 2560 * 1024;
constexpr size_t W_B_IN = W_A_OUT + 2ull * 1024 * 1024;
constexpr size_t W_B_QB = W_B_IN + 2ull * 1792 * 1024;
constexpr size_t W_B_KVB = W_B_QB + 2ull * 1536 * 384;
constexpr size_t W_B_OUT = W_B_KVB + 2ull * 2048 * 256;
constexpr size_t W_PLE = W_B_OUT + 2ull * 1024 * 1024;
constexpr size_t W_GATE = W_PLE + 4ull * 1024 * 256;
constexpr size_t W_END = W_GATE + 4ull * 1024 * 1024;
static_assert(OFF_W + W_END * 2 <= OFF_PB, "weights overflow");
constexpr size_t WS_NEEDED = OFF_BAR + 1 * MiB;

struct Seg {
  const float* src;
  const float* gain;
  bf16_t* dst;
  int src_ld, ncols, K, tile0;
  int fp8, pad0;
};
constexpr int MAXSEG = 32;

struct Params {
  const float *x, *p, *a_sink, *final_g;
  float* out;
  char* ws;
  Seg seg[MAXSEG];
  int nseg, ntile_w;
  int phase_lo, phase_hi;
};

typedef __attribute__((ext_vector_type(2))) float f32x2_t;
typedef __attribute__((ext_vector_type(2))) __bf16 bf16x2_t;
DI unsigned pack2(float a, float b) {
  f32x2_t v = {a, b};
  return __builtin_bit_cast(unsigned, __builtin_convertvector(v, bf16x2_t));
}
DI unsigned f2bf(float x) { return pack2(x, 0.f) & 0xffffu; }
DI float xhalf_max(float x) {
  return fmaxf(x, __shfl_xor(x, 32));
}
DI float bf2f(unsigned h) { return __uint_as_float(h << 16); }
DI int crow(int i, int h) { return (i & 3) + 8 * (i >> 2) + 4 * h; }
DI int perm16(int s) {
  int k = s & 15;
  int c = k >> 2;
  int pc = ((c & 1) << 1) | (c >> 1);
  return (s & ~15) | (pc << 2) | (k & 3);
}
#define MFMA(a, b, c) __builtin_amdgcn_mfma_f32_32x32x16_bf16((a), (b), (c), 0, 0, 0)
DI int get_tid() {
  int t = threadIdx.x;
  asm volatile("" : "+v"(t));
  return t;
}
template <typename TP>
DI TP* uniform_ptr(TP* p) {
  unsigned lo = (unsigned)(size_t)p, hi = (unsigned)((size_t)p >> 32);
  lo = __builtin_amdgcn_readfirstlane(lo);
  hi = __builtin_amdgcn_readfirstlane(hi);
  asm volatile("" : "+s"(lo), "+s"(hi));
  return (TP*)(((size_t)hi << 32) | (size_t)lo);
}
DI unsigned pack4_fp8(float a, float b, float c, float d);
DI unsigned pack4_fp8c(float a, float b, float c, float d);
DI float clamp8(float x);
DI float wave_xor_sum32(float v) { return v + __shfl_xor(v, 32); }

DI void prep_phase(const Params& P, char* lds) {
  const int tid = get_tid();
  float* tl = (float*)lds;
  for (int t = blockIdx.x; t < P.ntile_w; t += gridDim.x) {
    int si = 0;
    for (int i = 1; i < P.nseg; ++i)
      if (t >= P.seg[i].tile0) si = i;
    const Seg sg = P.seg[si];
    const int lt = t - sg.tile0;
    const int ncb = sg.ncols >> 5;
    const int kb = lt / ncb, nb = lt - kb * ncb;
    const int k0 = kb * 64, n0 = nb * 32;
    __syncthreads();
    {
      const int n = tid & 31;
#pragma unroll
      for (int i = 0; i < 4; ++i) {
        const int k = (tid >> 5) + 16 * i;
        float v = 0.f;
        if (sg.src) {
          v = sg.src[(size_t)(k0 + k) * sg.src_ld + n0 + n];
          if (sg.gain) v *= sg.gain[k0 + k];
        }
        tl[k * 33 + n] = v;
      }
    }
    __syncthreads();
    {
      const int kk4 = (tid & 15) * 4, n = tid >> 4;
      const float w0 = tl[(kk4 + 0) * 33 + n], w1 = tl[(kk4 + 1) * 33 + n], w2 = tl[(kk4 + 2) * 33 + n], w3 = tl[(kk4 + 3) * 33 + n];
      if (sg.fp8) {
        *(unsigned*)((unsigned char*)sg.dst + (size_t)(n0 + n) * sg.K + k0 + kk4) = pack4_fp8c(w0 * 64.f, w1 * 64.f, w2 * 64.f, w3 * 64.f);
      } else {
        uint2 o2;
        o2.x = pack2(w0, w1);
        o2.y = pack2(w2, w3);
        *(uint2*)(sg.dst + (size_t)(n0 + n) * sg.K + k0 + kk4) = o2;
      }
    }
  }
  {
    char* ws = uniform_ptr(P.ws);
    bf16_t* hb = (bf16_t*)(ws + OFF_HB);
    float* ssq = (float*)(ws + OFF_SSQH);
    const int w = tid >> 6, lane = tid & 63;
    for (int row = blockIdx.x * 8 + w; row < T; row += gridDim.x * 8) {
      const float4* xr = (const float4*)(P.x + (size_t)row * DM);
      float s = 0.f;
#pragma unroll
      for (int i = 0; i < 4; ++i) {
        float4 v = xr[lane + 64 * i];
        s += v.x * v.x + v.y * v.y + v.z * v.z + v.w * v.w;
        uint2 o;
        o.x = pack2(v.x, v.y);
        o.y = pack2(v.z, v.w);
        *(uint2*)(hb + (size_t)row * DM + (lane + 64 * i) * 4) = o;
      }
#pragma unroll
      for (int o = 32; o >= 1; o >>= 1) s += __shfl_xor(s, o);
      if (lane < 8) ssq[(size_t)row * 8 + lane] = (lane == 0) ? s : 0.f;
    }
  }
  {
    bf16_t* pb = (bf16_t*)(uniform_ptr(P.ws) + OFF_PB);
    const size_t n8 = (size_t)4 * T * PLE / 8;
    for (size_t e = (size_t)blockIdx.x * NTHREADS + tid; e < n8; e += (size_t)gridDim.x * NTHREADS) {
      const float4 v0 = ((const float4*)P.p)[2 * e], v1 = ((const float4*)P.p)[2 * e + 1];
      uint4 o;
      o.x = pack2(v0.x, v0.y);
      o.y = pack2(v0.z, v0.w);
      o.z = pack2(v1.x, v1.y);
      o.w = pack2(v1.z, v1.w);
      ((uint4*)pb)[e] = o;
    }
  }
  {
    float* rt = (float*)(uniform_ptr(P.ws) + OFF_ROPE);
    for (int e = blockIdx.x * NTHREADS + tid; e < S * 16; e += gridDim.x * NTHREADS) {
      const int s = e >> 4, i = e & 15;
      const double inv = exp2(-(double)i * (13.287712379549449 / 16.0));
      const double rev = (double)s * inv * 0.15915494309189535;
      const float fr = (float)(rev - floor(rev));
      rt[s * 32 + i] = __builtin_amdgcn_cosf(fr);
      rt[s * 32 + 16 + i] = __builtin_amdgcn_sinf(fr);
    }
  }
}

typedef __attribute__((ext_vector_type(4))) float f32x4;
constexpr int GBK = 64, GKS = 2;
constexpr int GTILE_B = 256 * GBK * 2;
constexpr int GSTAGE_B = 2 * GTILE_B;
constexpr int LDS_BYTES = 2 * GSTAGE_B;

DI int lds_byte(int r, int c) {
  int st = (r >> 4) * GKS + (c >> 5), ob = (r & 15) * 64 + (c & 31) * 2;
  return st * 1024 + (ob ^ (((ob >> 9) & 1) << 5));
}
DI void stage_rc(int b, int& R, int& C) {
  int st = b >> 10, sb = b & 1023, swz = sb ^ (((sb >> 9) & 1) << 5);
  R = (st / GKS) * 16 + swz / 64;
  C = (st % GKS) * 32 + (swz % 64) / 2;
}
#define WAIT_V0() asm volatile("s_waitcnt vmcnt(0)" ::: "memory")

DI void gemm_core(f32x4 (&acc)[8][4], const bf16_t* Wb, const bf16_t* Xb, int K, char* shm) {
  const int tid = get_tid();
  const int wid = tid >> 6, lane = tid & 63, wr = wid >> 2, wc = wid & 3, fr = lane & 15, fq = lane >> 4;
  int sR[4], sC[4];
#pragma unroll
  for (int i = 0; i < 4; ++i) stage_rc(wid * 1024 + i * 8192 + lane * 16, sR[i], sC[i]);
  const int nt = K / GBK;
#define GSRC(base, i, kt) ((base) + (size_t)sR[i] * K + (kt) * GBK + sC[i])
#define GLDS_STAGE(buf, kt)                                                                                           \
  do {                                                                                                                \
    _Pragma("unroll") for (int i = 0; i < 4; ++i) {                                                                   \
      __builtin_amdgcn_global_load_lds((const unsigned*)GSRC(Wb, i, kt),                                             \
                                       (unsigned*)(shm + (buf) * GSTAGE_B + wid * 1024 + i * 8192), 16, 0, 0);        \
      __builtin_amdgcn_global_load_lds((const unsigned*)GSRC(Xb, i, kt),                                             \
                                       (unsigned*)(shm + (buf) * GSTAGE_B + GTILE_B + wid * 1024 + i * 8192), 16, 0, 0); \
    }                                                                                                                 \
  } while (0)
  __syncthreads();
  GLDS_STAGE(0, 0);
  WAIT_V0();
  __syncthreads();
#pragma unroll 1
  for (int t = 0; t < nt; ++t) {
    const int cur = t & 1;
    if (t + 1 < nt) GLDS_STAGE(cur ^ 1, t + 1);
    const char* sa = shm + cur * GSTAGE_B;
    const char* sb = sa + GTILE_B;
#pragma unroll
    for (int ks = 0; ks < GKS; ++ks) {
      bf16x8 At[8], Bf[4];
#pragma unroll
      for (int m = 0; m < 8; ++m) At[m] = *(const bf16x8*)(sa + lds_byte(wr * 128 + m * 16 + fr, ks * 32 + fq * 8));
#pragma unroll
      for (int n = 0; n < 4; ++n) Bf[n] = *(const bf16x8*)(sb + lds_byte(wc * 64 + n * 16 + fr, ks * 32 + fq * 8));
#pragma unroll
      for (int m = 0; m < 8; ++m)
#pragma unroll
        for (int n = 0; n < 4; ++n) acc[m][n] = __builtin_amdgcn_mfma_f32_16x16x32_bf16(At[m], Bf[n], acc[m][n], 0, 0, 0);
      __builtin_amdgcn_sched_barrier(0);
    }
    WAIT_V0();
    __syncthreads();
  }
#undef GSRC
#undef GLDS_STAGE
}

typedef __attribute__((ext_vector_type(8))) int i32x8g;
DI i32x8g ld32g(const char* p0, const char* p1) {
  const uint4 a = *(const uint4*)p0, b = *(const uint4*)p1;
  i32x8g r = {(int)a.x, (int)a.y, (int)a.z, (int)a.w, (int)b.x, (int)b.y, (int)b.z, (int)b.w};
  return r;
}
DI void gemm_core8(f32x4 (&acc)[8][4], const unsigned char* Wb, const unsigned char* Xb, int K, char* shm, int sw, int sx) {
  const int tid = get_tid();
  const int wid = tid >> 6, lane = tid & 63, wr = wid >> 2, wc = wid & 3, fr = lane & 15, fq = lane >> 4;
  int sR[4], sC[4];
#pragma unroll
  for (int i = 0; i < 4; ++i) stage_rc(wid * 1024 + i * 8192 + lane * 16, sR[i], sC[i]);
  const int nt = K / 128;
#define GSRC8(base, i, kt) ((base) + (size_t)sR[i] * K + (kt) * 128 + sC[i] * 2)
#define GLDS_STAGE8(buf, kt)                                                                                          \
  do {                                                                                                                \
    _Pragma("unroll") for (int i = 0; i < 4; ++i) {                                                                   \
      __builtin_amdgcn_global_load_lds((const unsigned*)GSRC8(Wb, i, kt),                                            \
                                       (unsigned*)(shm + (buf) * GSTAGE_B + wid * 1024 + i * 8192), 16, 0, 0);        \
      __builtin_amdgcn_global_load_lds((const unsigned*)GSRC8(Xb, i, kt),                                            \
                                       (unsigned*)(shm + (buf) * GSTAGE_B + GTILE_B + wid * 1024 + i * 8192), 16, 0, 0); \
    }                                                                                                                 \
  } while (0)
  __syncthreads();
  GLDS_STAGE8(0, 0);
  WAIT_V0();
  __syncthreads();
#pragma unroll 1
  for (int t = 0; t < nt; ++t) {
    const int cur = t & 1;
    if (t + 1 < nt) GLDS_STAGE8(cur ^ 1, t + 1);
    const char* sa = shm + cur * GSTAGE_B;
    const char* sb = sa + GTILE_B;
    i32x8g Bf[4];
#pragma unroll
    for (int n = 0; n < 4; ++n)
      Bf[n] = ld32g(sb + lds_byte(wc * 64 + n * 16 + fr, fq * 8), sb + lds_byte(wc * 64 + n * 16 + fr, 32 + fq * 8));
#pragma unroll
    for (int mh = 0; mh < 2; ++mh) {
      i32x8g At[4];
#pragma unroll
      for (int m = 0; m < 4; ++m)
        At[m] = ld32g(sa + lds_byte(wr * 128 + (mh * 4 + m) * 16 + fr, fq * 8), sa + lds_byte(wr * 128 + (mh * 4 + m) * 16 + fr, 32 + fq * 8));
#pragma unroll
      for (int m = 0; m < 4; ++m)
#pragma unroll
        for (int n = 0; n < 4; ++n)
          acc[mh * 4 + m][n] = __builtin_amdgcn_mfma_scale_f32_16x16x128_f8f6f4(At[m], Bf[n], acc[mh * 4 + m][n], 0, 0, 0, sw, 0, sx);
    }
    __builtin_amdgcn_sched_barrier(0);
    WAIT_V0();
    __syncthreads();
  }
#undef GSRC8
#undef GLDS_STAGE8
}
constexpr int SC_ONE = 0x7f7f7f7f;
constexpr int SC_M6 = 0x79797979;
constexpr int SC_M4 = 0x7b7b7b7b;

DI float sum8(const float* p) {
  const float4* q = (const float4*)p;
  float4 a = q[0], b = q[1];
  return (a.x + a.y + a.z + a.w) + (b.x + b.y + b.z + b.w);
}
DI float quad_sum(float v) {
  v += __shfl_xor(v, 16);
  v += __shfl_xor(v, 32);
  return v;
}

DI unsigned pack4_fp8(float a, float b, float c, float d);
DI int perm64(int s);
enum { EPI_A_IN = 0, EPI_B_IN = 1, EPI_QKV_UP = 2, EPI_OUT = 3, EPI_PLE = 4 };

DI void store4bf(bf16_t* dst, float a, float b, float c, float d) {
  uint2 o;
  o.x = pack2(a, b);
  o.y = pack2(c, d);
  *(uint2*)dst = o;
}
DI void store_pair_bf(bf16_t* dst, int fq, float a0, float a1, float a2, float a3, float b0, float b1, float b2, float b3) {
  const unsigned ax = pack2(a0, a1), ay = pack2(a2, a3), bx = pack2(b0, b1), by = pack2(b2, b3);
  auto r0 = __builtin_amdgcn_permlane16_swap(ax, bx, false, false);
  auto r1 = __builtin_amdgcn_permlane16_swap(ay, by, false, false);
  *(uint4*)(dst + (fq & 1) * 16 + (fq >> 1) * 8) = make_uint4(r0[0], r1[0], r0[1], r1[1]);
}
DI void store_vt4(bf16_t* dst, float a, float b, float c, float d) {
  dst[0] = (bf16_t)f2bf(a);
  dst[S] = (bf16_t)f2bf(b);
  dst[2 * S] = (bf16_t)f2bf(c);
  dst[3 * S] = (bf16_t)f2bf(d);
}

template <int EPI>
DI void gemm_phase(const Params& P, int layer, char* lds) {
  const int tid = get_tid();
  const int wid = tid >> 6, lane = tid & 63, wr = wid >> 2, wc = wid & 3, fr = lane & 15, fq = lane >> 4;
  const int j = layer >> 1;
  char* ws = uniform_ptr(P.ws);
  bf16_t* wbase = (bf16_t*)(ws + OFF_W);
  bf16_t* hb = (bf16_t*)(ws + OFF_HB);
  bf16_t* og = (bf16_t*)(ws + OFF_HB);
  bf16_t* zb = (bf16_t*)(ws + OFF_Z);
  bf16_t* hmb = (bf16_t*)(ws + OFF_Z);
  bf16_t* qb = (bf16_t*)(ws + OFF_Q);
  bf16_t* eb = (bf16_t*)(ws + OFF_Q);
  bf16_t* kb = (bf16_t*)(ws + OFF_K);
  bf16_t* vt = (bf16_t*)(ws + OFF_VT);
  bf16_t* cqb = (bf16_t*)(ws + OFF_CQ);
  bf16_t* ckvb = (bf16_t*)(ws + OFF_CKV);
  bf16_t* krb = (bf16_t*)(ws + OFF_KR);
  const bf16_t* pbb = (const bf16_t*)(ws + OFF_PB);
  float* ssqh = (float*)(ws + OFF_SSQH);
  float* ssqm = (float*)(ws + OFF_SSQM);
  float* ssqc = (float*)(ws + OFF_SSQC);
  const float* rope = (const float*)(ws + OFF_ROPE);

  int NT, ntiles;
  if constexpr (EPI == EPI_A_IN) { NT = 10; ntiles = 128 * 10; }
  else if constexpr (EPI == EPI_B_IN) { NT = 7; ntiles = 128 * 7; }
  else if constexpr (EPI == EPI_QKV_UP) { NT = 14; ntiles = 128 * 14; }
  else if constexpr (EPI == EPI_OUT) { NT = 4; ntiles = 128 * 8; }
  else { NT = 4; ntiles = 128 * 4; }

  for (int tile = blockIdx.x; tile < ntiles; tile += gridDim.x) {
    int t2 = tile;
    bool second = false;
    if constexpr (EPI == EPI_OUT) {
      if (t2 >= 512) { second = true; t2 -= 512; }
    }
    int mt = t2 / NT, nt = t2 - mt * NT;
    if (gridDim.x == 256) {
      const int x = blockIdx.x & 7, s = blockIdx.x >> 3, k = t2 >> 8;
      const int idx = s + 32 * k;
      mt = (idx / NT) * 8 + x;
      nt = idx - (idx / NT) * NT;
    }
    const int m0 = mt * 256, n0 = nt * 256;
    f32x4 acc[8][4];
#pragma unroll
    for (int m = 0; m < 8; ++m)
#pragma unroll
      for (int n = 0; n < 4; ++n) acc[m][n] = f32x4{0.f, 0.f, 0.f, 0.f};

    if constexpr (EPI == EPI_A_IN) {
      gemm_core(acc, wbase + W_A_IN + (size_t)j * 2560 * 1024 + (size_t)n0 * 1024, hb + (size_t)m0 * 1024, 1024, lds);
      const float qs = 0.125f * LOG2E;
#pragma unroll
      for (int n = 0; n < 4; ++n) {
        const int tok = m0 + wc * 64 + n * 16 + fr;
        const float rstd = rsqrtf(sum8(ssqh + (size_t)tok * 8) * (1.f / 1024.f) + EPS);
        const int b = tok >> 13, s = tok & (S - 1);
        if (nt == 5) {
#pragma unroll
          for (int m = 0; m < 8; ++m) {
            const int f = n0 + wr * 128 + m * 16 + fq * 4;
            store_vt4(vt + ((size_t)(b * 4) * 64 + (f - 1280)) * S + perm16(s), acc[m][n][0] * rstd, acc[m][n][1] * rstd,
                      acc[m][n][2] * rstd, acc[m][n][3] * rstd);
          }
        } else {
          const float sc_ = (nt < 4) ? rstd * qs : rstd;
          const int fg = n0 + wr * 128;
          bf16_t* rowp = (nt < 4) ? (qb + (size_t)tok * 1024 + fg) : (nt == 4) ? (kb + (size_t)tok * 256 + (fg - 1024))
                                                                              : (zb + (size_t)tok * 1024 + (fg - 1536));
#pragma unroll
          for (int m = 0; m < 8; m += 2)
            store_pair_bf(rowp + m * 16, fq, acc[m][n][0] * sc_, acc[m][n][1] * sc_, acc[m][n][2] * sc_, acc[m][n][3] * sc_,
                          acc[m + 1][n][0] * sc_, acc[m + 1][n][1] * sc_, acc[m + 1][n][2] * sc_, acc[m + 1][n][3] * sc_);
        }
      }
    } else if constexpr (EPI == EPI_B_IN) {
      gemm_core8(acc, (const unsigned char*)(wbase + W_B_IN + (size_t)j * 1792 * 1024) + (size_t)n0 * 1024, (const unsigned char*)hb + (size_t)m0 * 1024, 1024, lds, SC_M6, SC_ONE);
      const int fbase = n0 + wr * 128;
#pragma unroll
      for (int n = 0; n < 4; ++n) {
        const int tok = m0 + wc * 64 + n * 16 + fr;
        const float rstd = rsqrtf(sum8(ssqh + (size_t)tok * 8) * (1.f / 1024.f) + EPS);
        const int s = tok & (S - 1);
        if (fbase < 1024) {
#pragma unroll
          for (int m = 0; m < 8; m += 2)
            store_pair_bf(zb + (size_t)tok * 1024 + fbase + m * 16, fq, acc[m][n][0] * rstd, acc[m][n][1] * rstd, acc[m][n][2] * rstd,
                          acc[m][n][3] * rstd, acc[m + 1][n][0] * rstd, acc[m + 1][n][1] * rstd, acc[m + 1][n][2] * rstd,
                          acc[m + 1][n][3] * rstd);
        } else if (fbase < 1664) {
          float sq = 0.f;
          const bool iscq = fbase < 1408;
#pragma unroll
          for (int m = 0; m < 8; ++m) {
            const float v0 = acc[m][n][0] * rstd, v1 = acc[m][n][1] * rstd, v2 = acc[m][n][2] * rstd, v3 = acc[m][n][3] * rstd;
            sq += v0 * v0 + v1 * v1 + v2 * v2 + v3 * v3;
            const int f = fbase + m * 16 + fq * 4;
            if (iscq) *(unsigned*)((unsigned char*)cqb + (size_t)tok * 384 + (f - 1024)) = pack4_fp8c(v0, v1, v2, v3);
            else *(unsigned*)((unsigned char*)ckvb + (size_t)tok * 256 + (f - 1408)) = pack4_fp8c(v0, v1, v2, v3);
          }
          sq = quad_sum(sq);
          if (fq == 0) {
            const int pi = iscq ? ((fbase - 1024) >> 7) : (4 + ((fbase - 1408) >> 7));
            ssqc[(size_t)tok * 8 + pi] = sq;
          }
        } else {
          const float4 cs = *(const float4*)(rope + s * 32 + fq * 4);
          const float4 sn = *(const float4*)(rope + s * 32 + 16 + fq * 4);
          const float x10 = acc[0][n][0] * rstd, x11 = acc[0][n][1] * rstd, x12 = acc[0][n][2] * rstd, x13 = acc[0][n][3] * rstd;
          const float x20 = acc[1][n][0] * rstd, x21 = acc[1][n][1] * rstd, x22 = acc[1][n][2] * rstd, x23 = acc[1][n][3] * rstd;
          unsigned char* kr8 = (unsigned char*)krb;
          *(unsigned*)(kr8 + (size_t)tok * 32 + fq * 4) =
              pack4_fp8c(x10 * cs.x - x20 * sn.x, x11 * cs.y - x21 * sn.y, x12 * cs.z - x22 * sn.z, x13 * cs.w - x23 * sn.w);
          *(unsigned*)(kr8 + (size_t)tok * 32 + 16 + fq * 4) =
              pack4_fp8c(x10 * sn.x + x20 * cs.x, x11 * sn.y + x21 * cs.y, x12 * sn.z + x22 * cs.z, x13 * sn.w + x23 * cs.w);
        }
      }
    } else if constexpr (EPI == EPI_QKV_UP) {
      if (nt < 6) {
        gemm_core8(acc, (const unsigned char*)(wbase + W_B_QB + (size_t)j * 1536 * 384) + (size_t)n0 * 384, (const unsigned char*)cqb + (size_t)m0 * 384, 384, lds, SC_M6, SC_ONE);
        const float qs = 0.10206207261596575f * LOG2E;
#pragma unroll
        for (int n = 0; n < 4; ++n) {
          const int tok = m0 + wc * 64 + n * 16 + fr;
          const float* pc = ssqc + (size_t)tok * 8;
          const float rstd = rsqrtf((pc[0] + pc[1] + pc[2]) * (1.f / 384.f) + EPS) * qs;
          const int s = tok & (S - 1);
          const float4 cs = *(const float4*)(rope + s * 32 + fq * 4);
          const float4 sn = *(const float4*)(rope + s * 32 + 16 + fq * 4);
#pragma unroll
          for (int mp = 0; mp < 4; ++mp) {
            const int fb = n0 + wr * 128 + mp * 32;
            const int cb = fb >> 5;
            unsigned char* dst = (unsigned char*)qb + (size_t)tok * 1536 + fb + fq * 4;
            const float x10 = acc[2 * mp][n][0] * rstd, x11 = acc[2 * mp][n][1] * rstd, x12 = acc[2 * mp][n][2] * rstd,
                        x13 = acc[2 * mp][n][3] * rstd;
            const float x20 = acc[2 * mp + 1][n][0] * rstd, x21 = acc[2 * mp + 1][n][1] * rstd, x22 = acc[2 * mp + 1][n][2] * rstd,
                        x23 = acc[2 * mp + 1][n][3] * rstd;
            if ((cb % 3) == 2) {
              *(unsigned*)dst = pack4_fp8c(x10 * cs.x - x20 * sn.x, x11 * cs.y - x21 * sn.y, x12 * cs.z - x22 * sn.z, x13 * cs.w - x23 * sn.w);
              *(unsigned*)(dst + 16) = pack4_fp8c(x10 * sn.x + x20 * cs.x, x11 * sn.y + x21 * cs.y, x12 * sn.z + x22 * cs.z, x13 * sn.w + x23 * cs.w);
            } else {
              *(unsigned*)dst = pack4_fp8c(x10, x11, x12, x13);
              *(unsigned*)(dst + 16) = pack4_fp8c(x20, x21, x22, x23);
            }
          }
        }
      } else {
        const int n0k = (nt - 6) * 256;
        gemm_core8(acc, (const unsigned char*)(wbase + W_B_KVB + (size_t)j * 2048 * 256) + (size_t)n0k * 256, (const unsigned char*)ckvb + (size_t)m0 * 256, 256, lds, SC_M6, SC_ONE);
        const int hd = (nt - 6) * 2 + wr;
#pragma unroll
        for (int n = 0; n < 4; ++n) {
          const int tok = m0 + wc * 64 + n * 16 + fr;
          const float* pc = ssqc + (size_t)tok * 8 + 4;
          const float rstd = rsqrtf((pc[0] + pc[1]) * (1.f / 256.f) + EPS);
          const int b = tok >> 13, s = tok & (S - 1);
#pragma unroll
          for (int m = 0; m < 8; ++m) {
            const float v0 = acc[m][n][0] * rstd, v1 = acc[m][n][1] * rstd, v2 = acc[m][n][2] * rstd, v3 = acc[m][n][3] * rstd;
            if (m < 4) {
              *(unsigned*)((unsigned char*)kb + (size_t)tok * 1024 + hd * 64 + m * 16 + fq * 4) = pack4_fp8c(v0, v1, v2, v3);
            } else {
              const float p0 = __shfl_xor(v0, 1), p1 = __shfl_xor(v1, 1), p2 = __shfl_xor(v2, 1), p3 = __shfl_xor(v3, 1);
              const bool odd = fr & 1;
              const float a0 = odd ? p2 : v0, b0 = odd ? v2 : p0;
              const float a1 = odd ? p3 : v1, b1 = odd ? v3 : p1;
              const int d = (m - 4) * 16 + fq * 4 + (odd ? 2 : 0);
              unsigned char* dst = (unsigned char*)vt + ((size_t)(b * 16 + hd) * 64 + d) * S + perm64(s & ~1);
              *(unsigned short*)dst = (unsigned short)(__builtin_amdgcn_cvt_pk_fp8_f32(clamp8(a0), clamp8(b0), 0, false) & 0xffff);
              *(unsigned short*)(dst + S) = (unsigned short)(__builtin_amdgcn_cvt_pk_fp8_f32(clamp8(a1), clamp8(b1), 0, false) & 0xffff);
            }
          }
        }
      }
    } else if constexpr (EPI == EPI_OUT) {
      if (!second) {
        if (layer & 1) {
          const unsigned char* wt = (const unsigned char*)(wbase + W_B_OUT + (size_t)j * 1024 * 1024);
          gemm_core8(acc, wt + (size_t)n0 * 1024, (const unsigned char*)og + (size_t)m0 * 1024, 1024, lds, SC_M6, SC_M4);
        } else {
          gemm_core(acc, wbase + W_A_OUT + (size_t)j * 1024 * 1024 + (size_t)n0 * 1024, og + (size_t)m0 * 1024, 1024, lds);
        }
        float* outp = uniform_ptr(P.out);
        const float* resid = (layer == 0) ? uniform_ptr(P.x) : outp;
#pragma unroll
        for (int n = 0; n < 4; ++n) {
          const int tok = m0 + wc * 64 + n * 16 + fr;
          float sq = 0.f;
#pragma unroll
          for (int m = 0; m < 8; m += 2) {
            const int f = n0 + wr * 128 + m * 16 + fq * 4;
            float4 rv = *(const float4*)(resid + (size_t)tok * DM + f);
            float4 rw = *(const float4*)(resid + (size_t)tok * DM + f + 16);
            rv.x += acc[m][n][0];
            rv.y += acc[m][n][1];
            rv.z += acc[m][n][2];
            rv.w += acc[m][n][3];
            rw.x += acc[m + 1][n][0];
            rw.y += acc[m + 1][n][1];
            rw.z += acc[m + 1][n][2];
            rw.w += acc[m + 1][n][3];
            sq += rv.x * rv.x + rv.y * rv.y + rv.z * rv.z + rv.w * rv.w;
            sq += rw.x * rw.x + rw.y * rw.y + rw.z * rw.z + rw.w * rw.w;
            *(float4*)(outp + (size_t)tok * DM + f) = rv;
            *(float4*)(outp + (size_t)tok * DM + f + 16) = rw;
            store_pair_bf(hmb + (size_t)tok * DM + n0 + wr * 128 + m * 16, fq, rv.x, rv.y, rv.z, rv.w, rw.x, rw.y, rw.z, rw.w);
          }
          sq = quad_sum(sq);
          if (fq == 0) ssqm[(size_t)tok * 8 + nt * 2 + wr] = sq;
        }
      } else {
        gemm_core(acc, wbase + W_PLE + (size_t)layer * 1024 * 256 + (size_t)n0 * 256, pbb + ((size_t)layer * T + m0) * 256, 256, lds);
#pragma unroll
        for (int n = 0; n < 4; ++n) {
          const int tok = m0 + wc * 64 + n * 16 + fr;
#pragma unroll
          for (int m = 0; m < 8; m += 2)
            store_pair_bf(eb + (size_t)tok * DM + n0 + wr * 128 + m * 16, fq, acc[m][n][0], acc[m][n][1], acc[m][n][2], acc[m][n][3],
                          acc[m + 1][n][0], acc[m + 1][n][1], acc[m + 1][n][2], acc[m + 1][n][3]);
        }
      }
    } else {
      gemm_core(acc, wbase + W_GATE + (size_t)layer * 1024 * 1024 + (size_t)n0 * 1024, hmb + (size_t)m0 * 1024, 1024, lds);
      float* outp = uniform_ptr(P.out);
#pragma unroll
      for (int n = 0; n < 4; ++n) {
        const int tok = m0 + wc * 64 + n * 16 + fr;
        const float rstd = rsqrtf(sum8(ssqm + (size_t)tok * 8) * (1.f / 1024.f) + EPS);
        float sq = 0.f;
#pragma unroll
        for (int m = 0; m < 8; ++m) {
          const int f = n0 + wr * 128 + m * 16 + fq * 4;
          float4 hv = *(const float4*)(outp + (size_t)tok * DM + f);
          const uint2 ee = *(const uint2*)(eb + (size_t)tok * DM + f);
          hv.x += bf2f(ee.x & 0xffffu) / (1.f + __expf(-acc[m][n][0] * rstd));
          hv.y += bf2f(ee.x >> 16) / (1.f + __expf(-acc[m][n][1] * rstd));
          hv.z += bf2f(ee.y & 0xffffu) / (1.f + __expf(-acc[m][n][2] * rstd));
          hv.w += bf2f(ee.y >> 16) / (1.f + __expf(-acc[m][n][3] * rstd));
          sq += hv.x * hv.x + hv.y * hv.y + hv.z * hv.z + hv.w * hv.w;
          *(float4*)(outp + (size_t)tok * DM + f) = hv;
          if ((layer & 1) == 0) *(unsigned*)((unsigned char*)hb + (size_t)tok * DM + f) = pack4_fp8c(hv.x, hv.y, hv.z, hv.w);
          else if (layer != 3) store4bf(hb + (size_t)tok * DM + f, hv.x, hv.y, hv.z, hv.w);
        }
        sq = quad_sum(sq);
        if (fq == 0) ssqh[(size_t)tok * 8 + nt * 2 + wr] = sq;
      }
    }
  }
}

template <bool MLA>
DI void attn_phase(const Params& P, int layer, char* lds) {
  constexpr int DQK = MLA ? 96 : 64;
  constexpr int KSTR = DQK * 2 + 16;
  constexpr int VSTR = 144;
  constexpr int KBYTES = 64 * KSTR;
  constexpr int ASTAGE = KBYTES + 64 * VSTR;
  constexpr int NKS = DQK / 16;
  const int tid = get_tid();
  const int lane = tid & 63, w = tid >> 6;
  const int r = lane & 31, h = lane >> 5;
  char* ws = uniform_ptr(P.ws);
  const bf16_t* qg = (const bf16_t*)(ws + OFF_Q);
  const bf16_t* kg = (const bf16_t*)(ws + OFF_K);
  const bf16_t* vtg = (const bf16_t*)(ws + OFF_VT);
  const bf16_t* krg = (const bf16_t*)(ws + OFF_KR);
  const bf16_t* zg = (const bf16_t*)(ws + OFF_Z);
  bf16_t* og = (bf16_t*)(ws + OFF_HB);
  const int j = layer >> 1;

  const int nitems = 2048;
  for (int item = blockIdx.x; item < nitems; item += gridDim.x) {
    int b, head, hkv, q0, t_lo, t_hi;
    int nheads_kv;
    if constexpr (MLA) {
      const int xcd = item & 7, slot = (item >> 3) & 31, grp = item >> 8;
      const int bh = grp * 8 + xcd;
      b = bh >> 4;
      head = bh & 15;
      hkv = head;
      nheads_kv = 16;
      q0 = slot * 256 + w * 32;
      t_lo = 0;
      t_hi = S / 64;
    } else {
      const int hp = item & 7, qblk = (item >> 3) & 63;
      b = item >> 9;
      head = hp * 2 + (w >> 2);
      hkv = hp >> 1;
      nheads_kv = 4;
      const int t0 = qblk * 128;
      q0 = t0 + (w & 3) * 32;
      const int lo = (t0 - 128 > 0) ? (t0 - 128) : 0;
      const int hi = (t0 + 256 < S) ? (t0 + 256) : S;
      t_lo = lo >> 6;
      t_hi = hi >> 6;
    }
    const int qld = MLA ? 1536 : 1024;
    const int tokq = b * S + q0 + r;
    bf16x8 qf[NKS];
#pragma unroll
    for (int ks = 0; ks < NKS; ++ks)
      qf[ks] = *(const bf16x8*)(qg + (size_t)tokq * qld + head * DQK + ks * 16 + 8 * h);

    float m_run, l_run;
    float slope2 = 0.f;
    if constexpr (MLA) {
      m_run = 0.f;
      l_run = 0.f;
    } else {
      m_run = P.a_sink[j * 16 + head] * LOG2E;
      l_run = (h == 0) ? 1.f : 0.f;
      slope2 = exp2f(-0.5f * (float)(head + 1)) * LOG2E;
    }
    f32x16 o[2], negm;
#pragma unroll
    for (int i = 0; i < 16; ++i) { o[0][i] = 0.f; o[1][i] = 0.f; negm[i] = -m_run; }

    const int lrow = tid >> 3, lc = tid & 7;
    uint4 kreg, vreg, rreg;
    auto load_regs = [&](int t) {
      const int kbase = t * 64;
      if constexpr (MLA) {
        kreg = *(const uint4*)(kg + (size_t)(b * S + kbase + lrow) * 1024 + head * 64 + lc * 8);
        if (tid < 256) rreg = *(const uint4*)(krg + (size_t)(b * S + kbase + (tid >> 2)) * 32 + (tid & 3) * 8);
      } else {
        kreg = *(const uint4*)(kg + (size_t)(b * S + kbase + lrow) * 256 + hkv * 64 + lc * 8);
      }
      vreg = *(const uint4*)(vtg + ((size_t)(b * nheads_kv + hkv) * 64 + lrow) * S + kbase + lc * 8);
    };
    auto write_lds = [&](int st) {
      char* base = lds + st * ASTAGE;
      *(uint4*)(base + lrow * KSTR + lc * 16) = kreg;
      if constexpr (MLA) {
        if (tid < 256) *(uint4*)(base + (tid >> 2) * KSTR + 128 + (tid & 3) * 16) = rreg;
      }
      *(uint4*)(base + KBYTES + lrow * VSTR + lc * 16) = vreg;
    };

    __syncthreads();
    load_regs(t_lo);
    write_lds(0);
    __syncthreads();
#pragma unroll 1
    for (int t = t_lo; t < t_hi; ++t) {
      load_regs((t + 1 < t_hi) ? (t + 1) : t);
      const char* base = lds + ((t - t_lo) & 1) * ASTAGE;
      const int kbase = t * 64;
      bool active = true;
      if constexpr (!MLA) active = (kbase + 63 >= q0 - 128) && (kbase <= q0 + 159);
      if (active) {
        f32x16 sc[2];
        {
          bf16x8 kf[2][NKS];
#pragma unroll
          for (int kb = 0; kb < 2; ++kb)
#pragma unroll
            for (int ks = 0; ks < NKS; ++ks) kf[kb][ks] = *(const bf16x8*)(base + (kb * 32 + r) * KSTR + h * 16 + ks * 32);
#pragma unroll
          for (int kb = 0; kb < 2; ++kb) {
            sc[kb] = MFMA(kf[kb][0], qf[0], negm);
#pragma unroll
            for (int ks = 1; ks < NKS; ++ks) sc[kb] = MFMA(kf[kb][ks], qf[ks], sc[kb]);
          }
        }
        if constexpr (!MLA) {
          const int tq = q0 + r;
#pragma unroll
          for (int kb = 0; kb < 2; ++kb)
#pragma unroll
            for (int i = 0; i < 16; ++i) {
              const int kp = kbase + kb * 32 + crow(i, h);
              int d = kp - tq;
              d = d < 0 ? -d : d;
              sc[kb][i] = (d <= 128) ? (sc[kb][i] - slope2 * (float)d) : -1e30f;
            }
        }
        int imx = max(__float_as_int(sc[0][0]), __float_as_int(sc[1][0]));
#pragma unroll
        for (int i = 1; i < 16; ++i) imx = max(imx, max(__float_as_int(sc[0][i]), __float_as_int(sc[1][i])));
        bool slow = __any(imx > 0x41000000);
        if constexpr (MLA) slow = slow || (t == t_lo);
        if (slow) {
          float mx = fmaxf(sc[0][0], sc[1][0]);
#pragma unroll
          for (int i = 1; i < 16; ++i) mx = fmaxf(mx, fmaxf(sc[0][i], sc[1][i]));
          mx = xhalf_max(mx);
          float delta = fmaxf(mx, 0.f);
          if constexpr (MLA) { if (t == t_lo) delta = mx; }
          float alpha = __builtin_amdgcn_exp2f(-delta);
          if constexpr (MLA) { if (t == t_lo) alpha = 1.f; }
          m_run += delta;
          l_run *= alpha;
#pragma unroll
          for (int i = 0; i < 16; ++i) {
            o[0][i] *= alpha;
            o[1][i] *= alpha;
            sc[0][i] -= delta;
            sc[1][i] -= delta;
            negm[i] = -m_run;
          }
        }
        f32x2_t ps2 = {0.f, 0.f};
        bf16x8 pf[2][2];
#pragma unroll
        for (int kb = 0; kb < 2; ++kb) {
#pragma unroll
          for (int i = 0; i < 16; i += 2) {
            const float p0 = __builtin_amdgcn_exp2f(sc[kb][i]);
            const float p1 = __builtin_amdgcn_exp2f(sc[kb][i + 1]);
            sc[kb][i] = p0;
            sc[kb][i + 1] = p1;
            ps2 += f32x2_t{p0, p1};
          }
#pragma unroll
          for (int sidx = 0; sidx < 2; ++sidx) {
            uint4 u;
            u.x = pack2(sc[kb][8 * sidx + 0], sc[kb][8 * sidx + 1]);
            u.y = pack2(sc[kb][8 * sidx + 2], sc[kb][8 * sidx + 3]);
            u.z = pack2(sc[kb][8 * sidx + 4], sc[kb][8 * sidx + 5]);
            u.w = pack2(sc[kb][8 * sidx + 6], sc[kb][8 * sidx + 7]);
            pf[kb][sidx] = __builtin_bit_cast(bf16x8, u);
          }
        }
        l_run += ps2[0] + ps2[1];
#pragma unroll
        for (int db = 0; db < 2; ++db) {
          const char* lv = base + KBYTES + (db * 32 + r) * VSTR + h * 16;
#pragma unroll
          for (int kb = 0; kb < 2; ++kb)
#pragma unroll
            for (int sidx = 0; sidx < 2; ++sidx) {
              bf16x8 vf = *(const bf16x8*)(lv + kb * 64 + sidx * 32);
              o[db] = MFMA(vf, pf[kb][sidx], o[db]);
            }
        }
      }
      write_lds((t + 1 - t_lo) & 1);
      __syncthreads();
    }
    const float l_tot = l_run + __shfl_xor(l_run, 32);
    const float inv = 1.f / l_tot;
#pragma unroll
    for (int db = 0; db < 2; ++db)
#pragma unroll
      for (int g = 0; g < 4; ++g) {
        const int d = db * 32 + 8 * g + 4 * h;
        const size_t off = (size_t)tokq * 1024 + head * 64 + d;
        const uint2 zz = *(const uint2*)(zg + off);
        const float z0 = bf2f(zz.x & 0xffffu), z1 = bf2f(zz.x >> 16), z2 = bf2f(zz.y & 0xffffu), z3 = bf2f(zz.y >> 16);
        const float g0 = z0 / (1.f + __expf(-z0)), g1 = z1 / (1.f + __expf(-z1)), g2 = z2 / (1.f + __expf(-z2)),
                    g3 = z3 / (1.f + __expf(-z3));
        store4bf(og + off, o[db][4 * g] * inv * g0, o[db][4 * g + 1] * inv * g1, o[db][4 * g + 2] * inv * g2,
                 o[db][4 * g + 3] * inv * g3);
      }
  }
}

typedef __attribute__((ext_vector_type(8))) int i32x8;
#define MFMA8(a, b, c) __builtin_amdgcn_mfma_scale_f32_32x32x64_f8f6f4((a), (b), (c), 0, 0, 0, 0x7f7f7f7f, 0, 0x7f7f7f7f)
DI unsigned pack4_fp8(float a, float b, float c, float d) {
  int r = __builtin_amdgcn_cvt_pk_fp8_f32(a, b, 0, false);
  r = __builtin_amdgcn_cvt_pk_fp8_f32(c, d, r, true);
  return (unsigned)r;
}
DI float clamp8(float x) { return __builtin_amdgcn_fmed3f(x, -440.f, 440.f); }
DI unsigned pack4_fp8c(float a, float b, float c, float d) { return pack4_fp8(clamp8(a), clamp8(b), clamp8(c), clamp8(d)); }
DI int perm64(int s) {
  const int c = (s >> 2) & 15;
  const int pc = ((c & 1) << 3) | (c >> 1);
  return (s & ~63) | (pc << 2) | (s & 3);
}
DI i32x8 ld32(const char* p) {
  const uint4 a = *(const uint4*)p, b = *(const uint4*)(p + 16);
  i32x8 r = {(int)a.x, (int)a.y, (int)a.z, (int)a.w, (int)b.x, (int)b.y, (int)b.z, (int)b.w};
  return r;
}

DI void attn_mla8_phase(const Params& P, char* lds) {
  constexpr int KSTR = 144;
  constexpr int VSTR = 80;
  constexpr int KBYTES = 64 * KSTR;
  constexpr int ASTAGE = KBYTES + 64 * VSTR;
  constexpr float PBIAS = 6.f;
  const int tid = get_tid();
  const int lane = tid & 63, w = tid >> 6;
  const int r = lane & 31, h = lane >> 5;
  char* ws = uniform_ptr(P.ws);
  const unsigned char* qg = (const unsigned char*)(ws + OFF_Q);
  const unsigned char* kg = (const unsigned char*)(ws + OFF_K);
  const unsigned char* vtg = (const unsigned char*)(ws + OFF_VT);
  const unsigned char* krg = (const unsigned char*)(ws + OFF_KR);
  const bf16_t* zg = (const bf16_t*)(ws + OFF_Z);
  bf16_t* og = (bf16_t*)(ws + OFF_HB);

  __syncthreads();
  if (tid < 384) {
    const int zr = tid >> 1, zs = tid >> 7;
    *(uint4*)(lds + zs * ASTAGE + (zr & 63) * KSTR + 96 + (tid & 1) * 16) = make_uint4(0u, 0u, 0u, 0u);
  }
  for (int item = blockIdx.x; item < 2048; item += gridDim.x) {
    const int xcd = item & 7, slot = (item >> 3) & 31, grp = item >> 8;
    const int bh = grp * 8 + xcd;
    const int b = bh >> 4, head = bh & 15;
    const int q0 = slot * 256 + w * 32;
    const int tokq = b * S + q0 + r;
    const unsigned char* qrow = qg + (size_t)tokq * 1536 + head * 96;
    const i32x8 qn = ld32((const char*)qrow + 32 * h);
    i32x8 qr = ld32((const char*)qrow + 64);
    if (h) qr = i32x8{0, 0, 0, 0, 0, 0, 0, 0};

    float m_run = 0.f, l_run = 0.f;
    f32x16 o[2], negm;
#pragma unroll
    for (int i = 0; i < 16; ++i) { o[0][i] = 0.f; o[1][i] = 0.f; negm[i] = PBIAS; }

    const int lrow = (tid & 255) >> 2, lc = tid & 3;
    const bool isk = tid < 256;
    const unsigned char* gmain = isk ? (kg + (size_t)(b * S + lrow) * 1024 + head * 64 + lc * 16)
                                     : (vtg + ((size_t)(b * 16 + head) * 64 + lrow) * S + lc * 16);
    const int gstep = isk ? 65536 : 64;
    const int lmain = isk ? (lrow * KSTR + lc * 16) : (KBYTES + lrow * VSTR + lc * 16);
    const int rrow = (tid & 127) >> 1, rc = tid & 1;
    const unsigned char* grope = krg + (size_t)(b * S + rrow) * 32 + rc * 16;
    const int lrope = rrow * KSTR + 64 + rc * 16;
    uint4 areg, rreg;
    const int trot = (slot * 4) & (S / 64 - 1);
#define MLA8_LOAD(t_)                                             \
  do {                                                            \
    const int tp_ = ((t_) + trot) & (S / 64 - 1);                 \
    areg = *(const uint4*)(gmain + (size_t)tp_ * gstep);          \
    rreg = *(const uint4*)(grope + (size_t)tp_ * 2048);           \
  } while (0)
#define MLA8_WRITE(st_)                                           \
  do {                                                            \
    char* wb_ = lds + (st_) * ASTAGE;                             \
    *(uint4*)(wb_ + lmain) = areg;                                \
    if (tid < 128) *(uint4*)(wb_ + lrope) = rreg;                 \
  } while (0)

    i32x8 kn[2], kr[2];
    __syncthreads();
    MLA8_LOAD(0);
    MLA8_WRITE(0);
    MLA8_LOAD(1);
    MLA8_WRITE(1);
    __syncthreads();
#pragma unroll
    for (int kb = 0; kb < 2; ++kb) {
      const char* lk = lds + (kb * 32 + r) * KSTR;
      kn[kb] = ld32(lk + 32 * h);
      kr[kb] = ld32(lk + 64 + 32 * h);
    }
    int st_cur = 0;
#pragma unroll 1
    for (int t = 0; t < S / 64; ++t) {
      MLA8_LOAD((t + 2 < S / 64) ? (t + 2) : (S / 64 - 1));
      const char* base = lds + st_cur * ASTAGE;
      const int st_nxt = (st_cur == 2) ? 0 : st_cur + 1;
      const int st_wr = (st_nxt == 2) ? 0 : st_nxt + 1;
      f32x16 sc[2];
      i32x8 vf[2];
      vf[0] = ld32(base + KBYTES + r * VSTR + 32 * h);
      vf[1] = ld32(base + KBYTES + (32 + r) * VSTR + 32 * h);
#pragma unroll
      for (int kb = 0; kb < 2; ++kb) {
        sc[kb] = MFMA8(kn[kb], qn, negm);
        sc[kb] = MFMA8(kr[kb], qr, sc[kb]);
      }
      int imx = max(__float_as_int(sc[0][0]), __float_as_int(sc[1][0]));
#pragma unroll
      for (int i = 1; i < 16; ++i) imx = max(imx, max(__float_as_int(sc[0][i]), __float_as_int(sc[1][i])));
      const bool slow = __any(imx > 0x41000000) || (t == 0);
      if (slow) {
        float mx = fmaxf(sc[0][0], sc[1][0]);
#pragma unroll
        for (int i = 1; i < 16; ++i) mx = fmaxf(mx, fmaxf(sc[0][i], sc[1][i]));
        mx = xhalf_max(mx);
        float delta = fmaxf(mx - PBIAS, 0.f);
        float alpha = __builtin_amdgcn_exp2f(-delta);
        if (t == 0) { delta = mx - PBIAS; alpha = 1.f; }
        m_run += delta;
        l_run *= alpha;
#pragma unroll
        for (int i = 0; i < 16; ++i) {
          o[0][i] *= alpha;
          o[1][i] *= alpha;
          sc[0][i] -= delta;
          sc[1][i] -= delta;
          negm[i] = PBIAS - m_run;
        }
      }
      f32x2_t ps2 = {0.f, 0.f};
      i32x8 pb;
#pragma unroll
      for (int kb = 0; kb < 2; ++kb) {
#pragma unroll
        for (int i = 0; i < 16; i += 2) {
          const f32x2_t tt = f32x2_t{sc[kb][i], sc[kb][i + 1]} * f32x2_t{8388608.f, 8388608.f} + f32x2_t{1065353216.f, 1065353216.f};
          const float p0 = __uint_as_float((unsigned)tt[0]);
          const float p1 = __uint_as_float((unsigned)tt[1]);
          sc[kb][i] = p0;
          sc[kb][i + 1] = p1;
          ps2 += f32x2_t{p0, p1};
        }
#pragma unroll
        for (int q4 = 0; q4 < 4; ++q4)
          pb[kb * 4 + q4] = (int)pack4_fp8(sc[kb][4 * q4], sc[kb][4 * q4 + 1], sc[kb][4 * q4 + 2], sc[kb][4 * q4 + 3]);
      }
      l_run += ps2[0] + ps2[1];
#pragma unroll
      for (int db = 0; db < 2; ++db) {
        o[db] = MFMA8(vf[db], pb, o[db]);
      }
      {
        const char* nb = lds + st_nxt * ASTAGE;
#pragma unroll
        for (int kb = 0; kb < 2; ++kb) {
          const char* lk = nb + (kb * 32 + r) * KSTR;
          kn[kb] = ld32(lk + 32 * h);
          kr[kb] = ld32(lk + 64 + 32 * h);
        }
      }
      MLA8_WRITE(st_wr);
      __syncthreads();
      st_cur = st_nxt;
    }
    const float l_tot = l_run + __shfl_xor(l_run, 32);
    const float inv = 1.f / l_tot;
#pragma unroll
    for (int db = 0; db < 2; ++db)
#pragma unroll
      for (int g = 0; g < 4; ++g) {
        const int d = db * 32 + 8 * g + 4 * h;
        const size_t off = (size_t)tokq * 1024 + head * 64 + d;
        const uint2 zz = *(const uint2*)(zg + off);
        const float z0 = bf2f(zz.x & 0xffffu), z1 = bf2f(zz.x >> 16), z2 = bf2f(zz.y & 0xffffu), z3 = bf2f(zz.y >> 16);
        const float g0 = z0 / (1.f + __expf(-z0)), g1 = z1 / (1.f + __expf(-z1)), g2 = z2 / (1.f + __expf(-z2)),
                    g3 = z3 / (1.f + __expf(-z3));
        const float i64 = inv * 16.f;
        *(unsigned*)((unsigned char*)og + off) = pack4_fp8c(o[db][4 * g] * i64 * g0, o[db][4 * g + 1] * i64 * g1, o[db][4 * g + 2] * i64 * g2,
                                                         o[db][4 * g + 3] * i64 * g3);
      }
  }
#undef MLA8_LOAD
#undef MLA8_WRITE
}

DI void final_phase(const Params& P) {
  const int tid = get_tid();
  const int w = tid >> 6, lane = tid & 63;
  for (int row = blockIdx.x * 8 + w; row < T; row += gridDim.x * 8) {
    float4* xr = (float4*)(P.out + (size_t)row * DM);
    float4 v[4];
    float s = 0.f;
#pragma unroll
    for (int i = 0; i < 4; ++i) {
      v[i] = xr[lane + 64 * i];
      s += v[i].x * v[i].x + v[i].y * v[i].y + v[i].z * v[i].z + v[i].w * v[i].w;
    }
#pragma unroll
    for (int o = 32; o >= 1; o >>= 1) s += __shfl_xor(s, o);
    const float rstd = rsqrtf(s * (1.f / 1024.f) + EPS);
#pragma unroll
    for (int i = 0; i < 4; ++i) {
      const float4 g = ((const float4*)P.final_g)[lane + 64 * i];
      xr[lane + 64 * i] = make_float4(v[i].x * rstd * g.x, v[i].y * rstd * g.y, v[i].z * rstd * g.z, v[i].w * rstd * g.w);
    }
  }
}

#define XB_TMO      128
#define XB_XCNT(j)  (256  + 64 * (j))
#define XB_XSUB(j)  (1280 + 64 * (j))
#define XB_XGEN(j)  (2304 + 64 * (j))
#define XB_TOP      3328
#define XB_TOPGEN   3392
#define XCD_BAR_WORDS 3456
#define XB_SPIN_CAP (1u << 22)
#define LAS __attribute__((address_space(3)))
DI unsigned xb_ld(unsigned* p) { return __hip_atomic_load(p, __ATOMIC_RELAXED, __HIP_MEMORY_SCOPE_AGENT); }
DI unsigned xb_add(unsigned* p, unsigned v) { return __hip_atomic_fetch_add(p, v, __ATOMIC_RELAXED, __HIP_MEMORY_SCOPE_AGENT); }
DI unsigned xb_xcc_id() { return (unsigned)__builtin_amdgcn_s_getreg((3 << 11) | 20) & 0xFu; }
#define XB_SPIN(cond, bar) do { unsigned _sp = 0; while (cond) { __builtin_amdgcn_s_sleep(1); \
    if ((++_sp & 255u) == 0u) { if (xb_ld(&(bar)[XB_TMO])) break; if (_sp > XB_SPIN_CAP) { atomicAdd(&(bar)[XB_TMO], 1u); break; } } } } while (0)
struct XcdBarrier {
  unsigned* bar;
  unsigned x;
  volatile LAS unsigned* st;
};
DI XcdBarrier xcd_barrier_post(unsigned* bar, volatile LAS unsigned* st) {
  XcdBarrier b;
  b.bar = bar;
  b.x = xb_xcc_id();
  b.st = st;
  if (threadIdx.x == 0) (void)xb_add(&bar[XB_XCNT(b.x)], 1u);
  return b;
}
DI void xcd_barrier_complete(unsigned* bar, unsigned x, unsigned& nloc, unsigned& nx) {
  const unsigned G = gridDim.x * gridDim.y * gridDim.z;
  unsigned sum, cnt, mine, sp = 0u;
  for (;;) {
    sum = 0u; cnt = 0u; mine = 0u;
#pragma unroll
    for (unsigned j = 0; j < 16; ++j) {
      const unsigned c = xb_ld(&bar[XB_XCNT(j)]);
      sum += c;
      cnt += (c > 0u) ? 1u : 0u;
      mine = (j == x) ? c : mine;
    }
    if (sum == G) break;
    __builtin_amdgcn_s_sleep(1);
    if ((++sp & 255u) == 0u) { if (xb_ld(&bar[XB_TMO])) break; if (sp > XB_SPIN_CAP) { atomicAdd(&bar[XB_TMO], 1u); break; } }
  }
  nloc = mine > 0u ? mine : 1u;
  nx = cnt > 0u ? cnt : 1u;
}
DI void xcd_barrier(const XcdBarrier& b) {
  asm volatile("s_waitcnt vmcnt(0)" ::: "memory");
  __syncthreads();
  if (threadIdx.x == 0) {
    unsigned* bar = b.bar;
    __builtin_amdgcn_s_waitcnt(0);
    unsigned nloc = b.st[0], nx = b.st[1];
    if (nloc == 0u) { xcd_barrier_complete(bar, b.x, nloc, nx); b.st[0] = nloc; b.st[1] = nx; }
    const unsigned old = xb_add(&bar[XB_XSUB(b.x)], 1u);
    const unsigned gen = old / nloc;
    if (old + 1u == (gen + 1u) * nloc) {
      __builtin_amdgcn_fence(__ATOMIC_RELEASE, "agent");
      asm volatile("s_waitcnt vmcnt(0)" ::: "memory");
      const unsigned og = xb_add(&bar[XB_TOP], 1u);
      const unsigned tg = og / nx;
      if (og + 1u == (tg + 1u) * nx) xb_add(&bar[XB_TOPGEN], 1u);
      else XB_SPIN(xb_ld(&bar[XB_TOPGEN]) == tg, bar);
      __builtin_amdgcn_fence(__ATOMIC_ACQUIRE, "agent");
      xb_add(&bar[XB_XGEN(b.x)], 1u);
      asm volatile("s_waitcnt vmcnt(0)" ::: "memory");
    } else {
      XB_SPIN(xb_ld(&bar[XB_XGEN(b.x)]) == gen, bar);
      __builtin_amdgcn_fence(__ATOMIC_ACQUIRE, "agent");
      asm volatile("s_waitcnt vmcnt(0)" ::: "memory");
    }
  }
  __syncthreads();
}

constexpr int NPHASE = 1 + 2 * (4 + 5) + 1;

DI void run_phase(const Params& P, int ph, char* lds) {
  if (ph == 0) { prep_phase(P, lds); return; }
  if (ph == NPHASE - 1) { final_phase(P); return; }
  const int q = (ph - 1) / 9, rr = (ph - 1) % 9;
  if (rr < 4) {
    const int layer = q * 2;
    if (rr == 0) gemm_phase<EPI_A_IN>(P, layer, lds);
    else if (rr == 1) attn_phase<false>(P, layer, lds);
    else if (rr == 2) gemm_phase<EPI_OUT>(P, layer, lds);
    else gemm_phase<EPI_PLE>(P, layer, lds);
  } else {
    const int layer = q * 2 + 1;
    if (rr == 4) gemm_phase<EPI_B_IN>(P, layer, lds);
    else if (rr == 5) gemm_phase<EPI_QKV_UP>(P, layer, lds);
    else if (rr == 6) attn_phase<true>(P, layer, lds);
    else if (rr == 7) gemm_phase<EPI_OUT>(P, layer, lds);
    else gemm_phase<EPI_PLE>(P, layer, lds);
  }
}

__global__ void __launch_bounds__(NTHREADS) fwd_kernel(Params P) {
  __shared__ __attribute__((aligned(1024))) char lds[LDS_BYTES + 16];
#if MULTI_LAUNCH
  run_phase(P, P.phase_lo, lds);
#else
  cg::grid_group grid = cg::this_grid();
  volatile LAS unsigned* xst = (volatile LAS unsigned*)(lds + LDS_BYTES);
  if (threadIdx.x == 0) { xst[0] = 0u; xst[1] = 0u; }
  __syncthreads();
  const XcdBarrier xb = xcd_barrier_post((unsigned*)(P.ws + OFF_BAR), xst);
  prep_phase(P, lds);
#if (PROBE_REPEAT >> 9) & 1
  prep_phase(P, lds);
#endif
  grid.sync();
#pragma unroll 1
  for (int q = 0; q < 2; ++q) {
    const int la = 2 * q, lb = 2 * q + 1;
    gemm_phase<EPI_A_IN>(P, la, lds);
#if (PROBE_REPEAT >> 0) & 1
    gemm_phase<EPI_A_IN>(P, la, lds);
#endif
    GSYNC();
    attn_phase<false>(P, la, lds);
#if (PROBE_REPEAT >> 1) & 1
    attn_phase<false>(P, la, lds);
#endif
    GSYNC();
    gemm_phase<EPI_OUT>(P, la, lds);
    GSYNC();
    gemm_phase<EPI_PLE>(P, la, lds);
    GSYNC();
    gemm_phase<EPI_B_IN>(P, lb, lds);
#if (PROBE_REPEAT >> 4) & 1
    gemm_phase<EPI_B_IN>(P, lb, lds);
#endif
    GSYNC();
    gemm_phase<EPI_QKV_UP>(P, lb, lds);
#if (PROBE_REPEAT >> 5) & 1
    gemm_phase<EPI_QKV_UP>(P, lb, lds);
#endif
    GSYNC();
    attn_mla8_phase(P, lds);
#if (PROBE_REPEAT >> 6) & 1
    attn_mla8_phase(P, lds);
#endif
    GSYNC();
    gemm_phase<EPI_OUT>(P, lb, lds);
    GSYNC();
    gemm_phase<EPI_PLE>(P, lb, lds);
    GSYNC();
  }
  final_phase(P);
#endif
}

static void add_seg(Params& p, int& tiles, const float* src, const float* gain, bf16_t* dst, int src_ld, int ncols, int K, int fp8 = 0) {
  Seg& s = p.seg[p.nseg++];
  s.src = src;
  s.gain = gain;
  s.dst = dst;
  s.src_ld = src_ld;
  s.ncols = ncols;
  s.K = K;
  s.fp8 = fp8;
  s.pad0 = 0;
  s.tile0 = tiles;
  tiles += (K / 64) * (ncols / 32);
}

extern "C" void kernel_launch(void* const* d_in, const int* in_sizes, int n_in, void* d_out, int out_size, void* d_ws,
                              size_t ws_size, hipStream_t stream) {
  (void)in_sizes; (void)n_in; (void)out_size;
  if (ws_size < WS_NEEDED) {
    fprintf(stderr, "workspace too small: %zu < %zu\n", ws_size, (size_t)WS_NEEDED);
    return;
  }
  const float* x = (const float*)d_in[0];
  const float* pp = (const float*)d_in[1];
  const float* norm_g = (const float*)d_in[2];
  const float* a_w_in = (const float*)d_in[3];
  const float* a_sink = (const float*)d_in[4];
  const float* a_w_out = (const float*)d_in[5];
  const float* b_w_in = (const float*)d_in[6];
  const float* b_q_norm = (const float*)d_in[7];
  const float* b_w_qb = (const float*)d_in[8];
  const float* b_kv_norm = (const float*)d_in[9];
  const float* b_w_kvb = (const float*)d_in[10];
  const float* b_w_out = (const float*)d_in[11];
  const float* ple_w = (const float*)d_in[12];
  const float* ple_norm_g = (const float*)d_in[13];
  const float* ple_w_gate = (const float*)d_in[14];
  const float* final_g = (const float*)d_in[15];

  Params p;
  memset(&p, 0, sizeof(p));
  p.x = x;
  p.p = pp;
  p.a_sink = a_sink;
  p.final_g = final_g;
  p.out = (float*)d_out;
  p.ws = (char*)d_ws;
  bf16_t* wb = (bf16_t*)((char*)d_ws + OFF_W);
  int tiles = 0;
  for (int j = 0; j < 2; ++j) {
    const int la = 2 * j, lb = 2 * j + 1;
    add_seg(p, tiles, a_w_in + (size_t)j * 1024 * 2560, norm_g + la * 1024, wb + W_A_IN + (size_t)j * 2560 * 1024, 2560, 2560, 1024);
    add_seg(p, tiles, a_w_out + (size_t)j * 1024 * 1024, nullptr, wb + W_A_OUT + (size_t)j * 1024 * 1024, 1024, 1024, 1024);
    const float* bsrc = b_w_in + (size_t)j * 1024 * 1696;
    unsigned char* bdst = (unsigned char*)(wb + W_B_IN + (size_t)j * 1792 * 1024);
    const float* gb = norm_g + lb * 1024;
    add_seg(p, tiles, bsrc + 672, gb, (bf16_t*)bdst, 1696, 1024, 1024, 1);
    add_seg(p, tiles, bsrc + 0, gb, (bf16_t*)(bdst + (size_t)1024 * 1024), 1696, 384, 1024, 1);
    add_seg(p, tiles, bsrc + 384, gb, (bf16_t*)(bdst + (size_t)1408 * 1024), 1696, 256, 1024, 1);
    add_seg(p, tiles, bsrc + 640, gb, (bf16_t*)(bdst + (size_t)1664 * 1024), 1696, 32, 1024, 1);
    add_seg(p, tiles, nullptr, nullptr, (bf16_t*)(bdst + (size_t)1696 * 1024), 1696, 96, 1024, 1);
    add_seg(p, tiles, b_w_qb + (size_t)j * 384 * 1536, b_q_norm + j * 384, wb + W_B_QB + (size_t)j * 1536 * 384, 1536, 1536, 384, 1);
    add_seg(p, tiles, b_w_kvb + (size_t)j * 256 * 2048, b_kv_norm + j * 256, wb + W_B_KVB + (size_t)j * 2048 * 256, 2048, 2048, 256, 1);
    add_seg(p, tiles, b_w_out + (size_t)j * 1024 * 1024, nullptr, wb + W_B_OUT + (size_t)j * 1024 * 1024, 1024, 1024, 1024, 1);
  }
  for (int i = 0; i < 4; ++i) {
    add_seg(p, tiles, ple_w + (size_t)i * 256 * 1024, nullptr, wb + W_PLE + (size_t)i * 1024 * 256, 1024, 1024, 256);
    add_seg(p, tiles, ple_w_gate + (size_t)i * 1024 * 1024, ple_norm_g + i * 1024, wb + W_GATE + (size_t)i * 1024 * 1024, 1024, 1024, 1024);
  }
  p.ntile_w = tiles;

#if MULTI_LAUNCH
  for (int ph = 0; ph < NPHASE; ++ph) {
    p.phase_lo = ph;
    p.phase_hi = ph + 1;
    hipLaunchKernelGGL(fwd_kernel, dim3(1024), dim3(NTHREADS), 0, stream, p);
  }
#else
  static int grid_blocks = 0;
  if (!grid_blocks) {
    int dev = 0, cus = 0, per_cu = 0;
    hipGetDevice(&dev);
    hipDeviceGetAttribute(&cus, hipDeviceAttributeMultiprocessorCount, dev);
    hipOccupancyMaxActiveBlocksPerMultiprocessor(&per_cu, fwd_kernel, NTHREADS, 0);
    if (per_cu < 1) per_cu = 1;
    if (per_cu > 1) per_cu = 1;
    grid_blocks = cus * per_cu;
  }
  p.phase_lo = 0;
  p.phase_hi = NPHASE;
  (void)hipMemsetAsync((char*)d_ws + OFF_BAR, 0, 16384, stream);
  void* args[] = {&p};
  hipError_t e = hipLaunchCooperativeKernel((void*)fwd_kernel, dim3(grid_blocks), dim3(NTHREADS), args, 0, stream);
  if (e != hipSuccess) fprintf(stderr, "cooperative launch failed: %s (grid %d)\n", hipGetErrorString(e), grid_blocks);
#endif
}
```

```cpp
#include <hip/hip_runtime.h>
#include <hip/hip_cooperative_groups.h>
#include <cstdio>
#include <cstring>
namespace cg = cooperative_groups;

#ifndef PROBE_REPEAT
#define PROBE_REPEAT 0
#endif
#ifndef PROBE_SYNC2
#define PROBE_SYNC2 0
#endif
#if PROBE_SYNC2
#define GSYNC() do { xcd_barrier(xb); xcd_barrier(xb); } while (0)
#else
#define GSYNC() xcd_barrier(xb)
#endif
#ifndef MULTI_LAUNCH
#define MULTI_LAUNCH 0
#endif

#define DI __device__ __forceinline__
typedef __attribute__((ext_vector_type(8))) short bf16x8;
typedef __attribute__((ext_vector_type(16))) float f32x16;
typedef unsigned short bf16_t;

constexpr int T = 32768, S = 8192, NB = 4, DM = 1024, PLE = 256;
constexpr int NTHREADS = 512;
constexpr float LOG2E = 1.4426950408889634f;
constexpr float EPS = 1e-6f;

constexpr size_t MiB = 1024ull * 1024ull;
constexpr size_t OFF_HB = 0;
constexpr size_t OFF_Z = 64 * MiB;
constexpr size_t OFF_Q = 128 * MiB;
constexpr size_t OFF_K = 224 * MiB;
constexpr size_t OFF_VT = 288 * MiB;
constexpr size_t OFF_CQ = 352 * MiB;
constexpr size_t OFF_CKV = 376 * MiB;
constexpr size_t OFF_KR = 392 * MiB;
constexpr size_t OFF_SSQH = 394 * MiB;
constexpr size_t OFF_SSQM = 395 * MiB;
constexpr size_t OFF_SSQC = 396 * MiB;
constexpr size_t OFF_ROPE = 397 * MiB;
constexpr size_t OFF_W = 398 * MiB;
constexpr size_t OFF_PB = 438 * MiB;
constexpr size_t OFF_BAR = 502 * MiB;
constexpr size_t W_A_IN = 0;
constexpr size_t W_A_OUT = W_A_IN + 2ull * 2560 * 1024;
constexpr size_t W_B_IN = W_A_OUT + 2ull * 1024 * 1024;
constexpr size_t W_B_QB = W_B_IN + 2ull * 1792 * 1024;
constexpr size_t W_B_KVB = W_B_QB + 2ull * 1536 * 384;
constexpr size_t W_B_OUT = W_B_KVB + 2ull * 2048 * 256;
constexpr size_t W_PLE = W_B_OUT + 2ull * 1024 * 1024;
constexpr size_t W_GATE = W_PLE + 4ull * 1024 * 256;
constexpr size_t W_END = W_GATE + 4ull * 1024 * 1024;
static_assert(OFF_W + W_END * 2 <= OFF_PB, "weights overflow");
constexpr size_t WS_NEEDED = OFF_BAR + 1 * MiB;

struct Seg {
  const float* src;
  const float* gain;
  bf16_t* dst;
  int src_ld, ncols, K, tile0;
  int fp8, pad0;
};
constexpr int MAXSEG = 32;

struct Params {
  const float *x, *p, *a_sink, *final_g;
  float* out;
  char* ws;
  Seg seg[MAXSEG];
  int nseg, ntile_w;
  int phase_lo, phase_hi;
};

typedef __attribute__((ext_vector_type(2))) float f32x2_t;
typedef __attribute__((ext_vector_type(2))) __bf16 bf16x2_t;
DI unsigned pack2(float a, float b) {
  f32x2_t v = {a, b};
  return __builtin_bit_cast(unsigned, __builtin_convertvector(v, bf16x2_t));
}
DI unsigned f2bf(float x) { return pack2(x, 0.f) & 0xffffu; }
DI float xhalf_max(float x) {
  return fmaxf(x, __shfl_xor(x, 32));
}
DI float bf2f(unsigned h) { return __uint_as_float(h << 16); }
DI int crow(int i, int h) { return (i & 3) + 8 * (i >> 2) + 4 * h; }
DI int perm16(int s) {
  int k = s & 15;
  int c = k >> 2;
  int pc = ((c & 1) << 1) | (c >> 1);
  return (s & ~15) | (pc << 2) | (k & 3);
}
#define MFMA(a, b, c) __builtin_amdgcn_mfma_f32_32x32x16_bf16((a), (b), (c), 0, 0, 0)
DI int get_tid() {
  int t = threadIdx.x;
  asm volatile("" : "+v"(t));
  return t;
}
template <typename TP>
DI TP* uniform_ptr(TP* p) {
  unsigned lo = (unsigned)(size_t)p, hi = (unsigned)((size_t)p >> 32);
  lo = __builtin_amdgcn_readfirstlane(lo);
  hi = __builtin_amdgcn_readfirstlane(hi);
  asm volatile("" : "+s"(lo), "+s"(hi));
  return (TP*)(((size_t)hi << 32) | (size_t)lo);
}
DI unsigned pack4_fp8(float a, float b, float c, float d);
DI unsigned pack4_fp8c(float a, float b, float c, float d);
DI float clamp8(float x);
DI float wave_xor_sum32(float v) { return v + __shfl_xor(v, 32); }

DI void prep_phase(const Params& P, char* lds) {
  const int tid = get_tid();
  float* tl = (float*)lds;
  for (int t = blockIdx.x; t < P.ntile_w; t += gridDim.x) {
    int si = 0;
    for (int i = 1; i < P.nseg; ++i)
      if (t >= P.seg[i].tile0) si = i;
    const Seg sg = P.seg[si];
    const int lt = t - sg.tile0;
    const int ncb = sg.ncols >> 5;
    const int kb = lt / ncb, nb = lt - kb * ncb;
    const int k0 = kb * 64, n0 = nb * 32;
    __syncthreads();
    {
      const int n = tid & 31;
#pragma unroll
      for (int i = 0; i < 4; ++i) {
        const int k = (tid >> 5) + 16 * i;
        float v = 0.f;
        if (sg.src) {
          v = sg.src[(size_t)(k0 + k) * sg.src_ld + n0 + n];
          if (sg.gain) v *= sg.gain[k0 + k];
        }
        tl[k * 33 + n] = v;
      }
    }
    __syncthreads();
    {
      const int kk4 = (tid & 15) * 4, n = tid >> 4;
      const float w0 = tl[(kk4 + 0) * 33 + n], w1 = tl[(kk4 + 1) * 33 + n], w2 = tl[(kk4 + 2) * 33 + n], w3 = tl[(kk4 + 3) * 33 + n];
      if (sg.fp8) {
        *(unsigned*)((unsigned char*)sg.dst + (size_t)(n0 + n) * sg.K + k0 + kk4) = pack4_fp8c(w0 * 64.f, w1 * 64.f, w2 * 64.f, w3 * 64.f);
      } else {
        uint2 o2;
        o2.x = pack2(w0, w1);
        o2.y = pack2(w2, w3);
        *(uint2*)(sg.dst + (size_t)(n0 + n) * sg.K + k0 + kk4) = o2;
      }
    }
  }
  {
    char* ws = uniform_ptr(P.ws);
    bf16_t* hb = (bf16_t*)(ws + OFF_HB);
    float* ssq = (float*)(ws + OFF_SSQH);
    const int w = tid >> 6, lane = tid & 63;
    for (int row = blockIdx.x * 8 + w; row < T; row += gridDim.x * 8) {
      const float4* xr = (const float4*)(P.x + (size_t)row * DM);
      float s = 0.f;
#pragma unroll
      for (int i = 0; i < 4; ++i) {
        float4 v = xr[lane + 64 * i];
        s += v.x * v.x + v.y * v.y + v.z * v.z + v.w * v.w;
        uint2 o;
        o.x = pack2(v.x, v.y);
        o.y = pack2(v.z, v.w);
        *(uint2*)(hb + (size_t)row * DM + (lane + 64 * i) * 4) = o;
      }
#pragma unroll
      for (int o = 32; o >= 1; o >>= 1) s += __shfl_xor(s, o);
      if (lane < 8) ssq[(size_t)row * 8 + lane] = (lane == 0) ? s : 0.f;
    }
  }
  {
    bf16_t* pb = (bf16_t*)(uniform_ptr(P.ws) + OFF_PB);
    const size_t n8 = (size_t)4 * T * PLE / 8;
    for (size_t e = (size_t)blockIdx.x * NTHREADS + tid; e < n8; e += (size_t)gridDim.x * NTHREADS) {
      const float4 v0 = ((const float4*)P.p)[2 * e], v1 = ((const float4*)P.p)[2 * e + 1];
      uint4 o;
      o.x = pack2(v0.x, v0.y);
      o.y = pack2(v0.z, v0.w);
      o.z = pack2(v1.x, v1.y);
      o.w = pack2(v1.z, v1.w);
      ((uint4*)pb)[e] = o;
    }
  }
  {
    float* rt = (float*)(uniform_ptr(P.ws) + OFF_ROPE);
    for (int e = blockIdx.x * NTHREADS + tid; e < S * 16; e += gridDim.x * NTHREADS) {
      const int s = e >> 4, i = e & 15;
      const double inv = exp2(-(double)i * (13.287712379549449 / 16.0));
      const double rev = (double)s * inv * 0.15915494309189535;
      const float fr = (float)(rev - floor(rev));
      rt[s * 32 + i] = __builtin_amdgcn_cosf(fr);
      rt[s * 32 + 16 + i] = __builtin_amdgcn_sinf(fr);
    }
  }
}

typedef __attribute__((ext_vector_type(4))) float f32x4;
constexpr int GBK = 64, GKS = 2;
constexpr int GTILE_B = 256 * GBK * 2;
constexpr int GSTAGE_B = 2 * GTILE_B;
constexpr int LDS_BYTES = 2 * GSTAGE_B;

DI int lds_byte(int r, int c) {
  int st = (r >> 4) * GKS + (c >> 5), ob = (r & 15) * 64 + (c & 31) * 2;
  return st * 1024 + (ob ^ (((ob >> 9) & 1) << 5));
}
DI void stage_rc(int b, int& R, int& C) {
  int st = b >> 10, sb = b & 1023, swz = sb ^ (((sb >> 9) & 1) << 5);
  R = (st / GKS) * 16 + swz / 64;
  C = (st % GKS) * 32 + (swz % 64) / 2;
}
#define WAIT_V0() asm volatile("s_waitcnt vmcnt(0)" ::: "memory")

DI void gemm_core(f32x4 (&acc)[8][4], const bf16_t* Wb, const bf16_t* Xb, int K, char* shm) {
  const int tid = get_tid();
  const int wid = tid >> 6, lane = tid & 63, wr = wid >> 2, wc = wid & 3, fr = lane & 15, fq = lane >> 4;
  int sR[4], sC[4];
#pragma unroll
  for (int i = 0; i < 4; ++i) stage_rc(wid * 1024 + i * 8192 + lane * 16, sR[i], sC[i]);
  const int nt = K / GBK;
#define GSRC(base, i, kt) ((base) + (size_t)sR[i] * K + (kt) * GBK + sC[i])
#define GLDS_STAGE(buf, kt)                                                                                           \
  do {                                                                                                                \
    _Pragma("unroll") for (int i = 0; i < 4; ++i) {                                                                   \
      __builtin_amdgcn_global_load_lds((const unsigned*)GSRC(Wb, i, kt),                                             \
                                       (unsigned*)(shm + (buf) * GSTAGE_B + wid * 1024 + i * 8192), 16, 0, 0);        \
      __builtin_amdgcn_global_load_lds((const unsigned*)GSRC(Xb, i, kt),                                             \
                                       (unsigned*)(shm + (buf) * GSTAGE_B + GTILE_B + wid * 1024 + i * 8192), 16, 0, 0); \
    }                                                                                                                 \
  } while (0)
  __syncthreads();
  GLDS_STAGE(0, 0);
  WAIT_V0();
  __syncthreads();
#pragma unroll 1
  for (int t = 0; t < nt; ++t) {
    const int cur = t & 1;
    if (t + 1 < nt) GLDS_STAGE(cur ^ 1, t + 1);
    const char* sa = shm + cur * GSTAGE_B;
    const char* sb = sa + GTILE_B;
#pragma unroll
    for (int ks = 0; ks < GKS; ++ks) {
      bf16x8 At[8], Bf[4];
#pragma unroll
      for (int m = 0; m < 8; ++m) At[m] = *(const bf16x8*)(sa + lds_byte(wr * 128 + m * 16 + fr, ks * 32 + fq * 8));
#pragma unroll
      for (int n = 0; n < 4; ++n) Bf[n] = *(const bf16x8*)(sb + lds_byte(wc * 64 + n * 16 + fr, ks * 32 + fq * 8));
#pragma unroll
      for (int m = 0; m < 8; ++m)
#pragma unroll
        for (int n = 0; n < 4; ++n) acc[m][n] = __builtin_amdgcn_mfma_f32_16x16x32_bf16(At[m], Bf[n], acc[m][n], 0, 0, 0);
      __builtin_amdgcn_sched_barrier(0);
    }
    WAIT_V0();
    __syncthreads();
  }
#undef GSRC
#undef GLDS_STAGE
}

typedef __attribute__((ext_vector_type(8))) int i32x8g;
DI i32x8g ld32g(const char* p0, const char* p1) {
  const uint4 a = *(const uint4*)p0, b = *(const uint4*)p1;
  i32x8g r = {(int)a.x, (int)a.y, (int)a.z, (int)a.w, (int)b.x, (int)b.y, (int)b.z, (int)b.w};
  return r;
}
DI void gemm_core8(f32x4 (&acc)[8][4], const unsigned char* Wb, const unsigned char* Xb, int K, char* shm, int sw, int sx) {
  const int tid = get_tid();
  const int wid = tid >> 6, lane = tid & 63, wr = wid >> 2, wc = wid & 3, fr = lane & 15, fq = lane >> 4;
  int sR[4], sC[4];
#pragma unroll
  for (int i = 0; i < 4; ++i) stage_rc(wid * 1024 + i * 8192 + lane * 16, sR[i], sC[i]);
  const int nt = K / 128;
#define GSRC8(base, i, kt) ((base) + (size_t)sR[i] * K + (kt) * 128 + sC[i] * 2)
#define GLDS_STAGE8(buf, kt)                                                                                          \
  do {                                                                                                                \
    _Pragma("unroll") for (int i = 0; i < 4; ++i) {                                                                   \
      __builtin_amdgcn_global_load_lds((const unsigned*)GSRC8(Wb, i, kt),                                            \
                                       (unsigned*)(shm + (buf) * GSTAGE_B + wid * 1024 + i * 8192), 16, 0, 0);        \
      __builtin_amdgcn_global_load_lds((const unsigned*)GSRC8(Xb, i, kt),                                            \
                                       (unsigned*)(shm + (buf) * GSTAGE_B + GTILE_B + wid * 1024 + i * 8192), 16, 0, 0); \
    }                                                                                                                 \
  } while (0)
  __syncthreads();
  GLDS_STAGE8(0, 0);
  WAIT_V0();
  __syncthreads();
#pragma unroll 1
  for (int t = 0; t < nt; ++t) {
    const int cur = t & 1;
    if (t + 1 < nt) GLDS_STAGE8(cur ^ 1, t + 1);
    const char* sa = shm + cur * GSTAGE_B;
    const char* sb = sa + GTILE_B;
    i32x8g Bf[4];
#pragma unroll
    for (int n = 0; n < 4; ++n)
      Bf[n] = ld32g(sb + lds_byte(wc * 64 + n * 16 + fr, fq * 8), sb + lds_byte(wc * 64 + n * 16 + fr, 32 + fq * 8));
#pragma unroll
    for (int mh = 0; mh < 2; ++mh) {
      i32x8g At[4];
#pragma unroll
      for (int m = 0; m < 4; ++m)
        At[m] = ld32g(sa + lds_byte(wr * 128 + (mh * 4 + m) * 16 + fr, fq * 8), sa + lds_byte(wr * 128 + (mh * 4 + m) * 16 + fr, 32 + fq * 8));
#pragma unroll
      for (int m = 0; m < 4; ++m)
#pragma unroll
        for (int n = 0; n < 4; ++n)
          acc[mh * 4 + m][n] = __builtin_amdgcn_mfma_scale_f32_16x16x128_f8f6f4(At[m], Bf[n], acc[mh * 4 + m][n], 0, 0, 0, sw, 0, sx);
    }
    __builtin_amdgcn_sched_barrier(0);
    WAIT_V0();
    __syncthreads();
  }
#undef GSRC8
#undef GLDS_STAGE8
}
constexpr int SC_ONE = 0x7f7f7f7f;
constexpr int SC_M6 = 0x79797979;
constexpr int SC_M4 = 0x7b7b7b7b;

DI float sum8(const float* p) {
  const float4* q = (const float4*)p;
  float4 a = q[0], b = q[1];
  return (a.x + a.y + a.z + a.w) + (b.x + b.y + b.z + b.w);
}
DI float quad_sum(float v) {
  v += __shfl_xor(v, 16);
  v += __shfl_xor(v, 32);
  return v;
}

DI unsigned pack4_fp8(float a, float b, float c, float d);
DI int perm64(int s);
enum { EPI_A_IN = 0, EPI_B_IN = 1, EPI_QKV_UP = 2, EPI_OUT = 3, EPI_PLE = 4 };

DI void store4bf(bf16_t* dst, float a, float b, float c, float d) {
  uint2 o;
  o.x = pack2(a, b);
  o.y = pack2(c, d);
  *(uint2*)dst = o;
}
DI void store_pair_bf(bf16_t* dst, int fq, float a0, float a1, float a2, float a3, float b0, float b1, float b2, float b3) {
  const unsigned ax = pack2(a0, a1), ay = pack2(a2, a3), bx = pack2(b0, b1), by = pack2(b2, b3);
  auto r0 = __builtin_amdgcn_permlane16_swap(ax, bx, false, false);
  auto r1 = __builtin_amdgcn_permlane16_swap(ay, by, false, false);
  *(uint4*)(dst + (fq & 1) * 16 + (fq >> 1) * 8) = make_uint4(r0[0], r1[0], r0[1], r1[1]);
}
DI void store_vt4(bf16_t* dst, float a, float b, float c, float d) {
  dst[0] = (bf16_t)f2bf(a);
  dst[S] = (bf16_t)f2bf(b);
  dst[2 * S] = (bf16_t)f2bf(c);
  dst[3 * S] = (bf16_t)f2bf(d);
}

template <int EPI>
DI void gemm_phase(const Params& P, int layer, char* lds) {
  const int tid = get_tid();
  const int wid = tid >> 6, lane = tid & 63, wr = wid >> 2, wc = wid & 3, fr = lane & 15, fq = lane >> 4;
  const int j = layer >> 1;
  char* ws = uniform_ptr(P.ws);
  bf16_t* wbase = (bf16_t*)(ws + OFF_W);
  bf16_t* hb = (bf16_t*)(ws + OFF_HB);
  bf16_t* og = (bf16_t*)(ws + OFF_HB);
  bf16_t* zb = (bf16_t*)(ws + OFF_Z);
  bf16_t* hmb = (bf16_t*)(ws + OFF_Z);
  bf16_t* qb = (bf16_t*)(ws + OFF_Q);
  bf16_t* eb = (bf16_t*)(ws + OFF_Q);
  bf16_t* kb = (bf16_t*)(ws + OFF_K);
  bf16_t* vt = (bf16_t*)(ws + OFF_VT);
  bf16_t* cqb = (bf16_t*)(ws + OFF_CQ);
  bf16_t* ckvb = (bf16_t*)(ws + OFF_CKV);
  bf16_t* krb = (bf16_t*)(ws + OFF_KR);
  const bf16_t* pbb = (const bf16_t*)(ws + OFF_PB);
  float* ssqh = (float*)(ws + OFF_SSQH);
  float* ssqm = (float*)(ws + OFF_SSQM);
  float* ssqc = (float*)(ws + OFF_SSQC);
  const float* rope = (const float*)(ws + OFF_ROPE);

  int NT, ntiles;
  if constexpr (EPI == EPI_A_IN) { NT = 10; ntiles = 128 * 10; }
  else if constexpr (EPI == EPI_B_IN) { NT = 7; ntiles = 128 * 7; }
  else if constexpr (EPI == EPI_QKV_UP) { NT = 14; ntiles = 128 * 14; }
  else if constexpr (EPI == EPI_OUT) { NT = 4; ntiles = 128 * 8; }
  else { NT = 4; ntiles = 128 * 4; }

  for (int tile = blockIdx.x; tile < ntiles; tile += gridDim.x) {
    int t2 = tile;
    bool second = false;
    if constexpr (EPI == EPI_OUT) {
      if (t2 >= 512) { second = true; t2 -= 512; }
    }
    int mt = t2 / NT, nt = t2 - mt * NT;
    if (gridDim.x == 256) {
      const int x = blockIdx.x & 7, s = blockIdx.x >> 3, k = t2 >> 8;
      const int idx = s + 32 * k;
      mt = (idx / NT) * 8 + x;
      nt = idx - (idx / NT) * NT;
    }
    const int m0 = mt * 256, n0 = nt * 256;
    f32x4 acc[8][4];
#pragma unroll
    for (int m = 0; m < 8; ++m)
#pragma unroll
      for (int n = 0; n < 4; ++n) acc[m][n] = f32x4{0.f, 0.f, 0.f, 0.f};

    if constexpr (EPI == EPI_A_IN) {
      gemm_core(acc, wbase + W_A_IN + (size_t)j * 2560 * 1024 + (size_t)n0 * 1024, hb + (size_t)m0 * 1024, 1024, lds);
      const float qs = 0.125f * LOG2E;
#pragma unroll
      for (int n = 0; n < 4; ++n) {
        const int tok = m0 + wc * 64 + n * 16 + fr;
        const float rstd = rsqrtf(sum8(ssqh + (size_t)tok * 8) * (1.f / 1024.f) + EPS);
        const int b = tok >> 13, s = tok & (S - 1);
        if (nt == 5) {
#pragma unroll
          for (int m = 0; m < 8; ++m) {
            const int f = n0 + wr * 128 + m * 16 + fq * 4;
            store_vt4(vt + ((size_t)(b * 4) * 64 + (f - 1280)) * S + perm16(s), acc[m][n][0] * rstd, acc[m][n][1] * rstd,
                      acc[m][n][2] * rstd, acc[m][n][3] * rstd);
          }
        } else {
          const float sc_ = (nt < 4) ? rstd * qs : rstd;
          const int fg = n0 + wr * 128;
          bf16_t* rowp = (nt < 4) ? (qb + (size_t)tok * 1024 + fg) : (nt == 4) ? (kb + (size_t)tok * 256 + (fg - 1024))
                                                                              : (zb + (size_t)tok * 1024 + (fg - 1536));
#pragma unroll
          for (int m = 0; m < 8; m += 2)
            store_pair_bf(rowp + m * 16, fq, acc[m][n][0] * sc_, acc[m][n][1] * sc_, acc[m][n][2] * sc_, acc[m][n][3] * sc_,
                          acc[m + 1][n][0] * sc_, acc[m + 1][n][1] * sc_, acc[m + 1][n][2] * sc_, acc[m + 1][n][3] * sc_);
        }
      }
    } else if constexpr (EPI == EPI_B_IN) {
      gemm_core8(acc, (const unsigned char*)(wbase + W_B_IN + (size_t)j * 1792 * 1024) + (size_t)n0 * 1024, (const unsigned char*)hb + (size_t)m0 * 1024, 1024, lds, SC_M6, SC_ONE);
      const int fbase = n0 + wr * 128;
#pragma unroll
      for (int n = 0; n < 4; ++n) {
        const int tok = m0 + wc * 64 + n * 16 + fr;
        const float rstd = rsqrtf(sum8(ssqh + (size_t)tok * 8) * (1.f / 1024.f) + EPS);
        const int s = tok & (S - 1);
        if (fbase < 1024) {
#pragma unroll
          for (int m = 0; m < 8; m += 2)
            store_pair_bf(zb + (size_t)tok * 1024 + fbase + m * 16, fq, acc[m][n][0] * rstd, acc[m][n][1] * rstd, acc[m][n][2] * rstd,
                          acc[m][n][3] * rstd, acc[m + 1][n][0] * rstd, acc[m + 1][n][1] * rstd, acc[m + 1][n][2] * rstd,
                          acc[m + 1][n][3] * rstd);
        } else if (fbase < 1664) {
          float sq = 0.f;
          const bool iscq = fbase < 1408;
#pragma unroll
          for (int m = 0; m < 8; ++m) {
            const float v0 = acc[m][n][0] * rstd, v1 = acc[m][n][1] * rstd, v2 = acc[m][n][2] * rstd, v3 = acc[m][n][3] * rstd;
            sq += v0 * v0 + v1 * v1 + v2 * v2 + v3 * v3;
            const int f = fbase + m * 16 + fq * 4;
            if (iscq) *(unsigned*)((unsigned char*)cqb + (size_t)tok * 384 + (f - 1024)) = pack4_fp8c(v0, v1, v2, v3);
            else *(unsigned*)((unsigned char*)ckvb + (size_t)tok * 256 + (f - 1408)) = pack4_fp8c(v0, v1, v2, v3);
          }
          sq = quad_sum(sq);
          if (fq == 0) {
            const int pi = iscq ? ((fbase - 1024) >> 7) : (4 + ((fbase - 1408) >> 7));
            ssqc[(size_t)tok * 8 + pi] = sq;
          }
        } else {
          const float4 cs = *(const float4*)(rope + s * 32 + fq * 4);
          const float4 sn = *(const float4*)(rope + s * 32 + 16 + fq * 4);
          const float x10 = acc[0][n][0] * rstd, x11 = acc[0][n][1] * rstd, x12 = acc[0][n][2] * rstd, x13 = acc[0][n][3] * rstd;
          const float x20 = acc[1][n][0] * rstd, x21 = acc[1][n][1] * rstd, x22 = acc[1][n][2] * rstd, x23 = acc[1][n][3] * rstd;
          unsigned char* kr8 = (unsigned char*)krb;
          *(unsigned*)(kr8 + (size_t)tok * 32 + fq * 4) =
              pack4_fp8c(x10 * cs.x - x20 * sn.x, x11 * cs.y - x21 * sn.y, x12 * cs.z - x22 * sn.z, x13 * cs.w - x23 * sn.w);
          *(unsigned*)(kr8 + (size_t)tok * 32 + 16 + fq * 4) =
              pack4_fp8c(x10 * sn.x + x20 * cs.x, x11 * sn.y + x21 * cs.y, x12 * sn.z + x22 * cs.z, x13 * sn.w + x23 * cs.w);
        }
      }
    } else if constexpr (EPI == EPI_QKV_UP) {
      if (nt < 6) {
        gemm_core8(acc, (const unsigned char*)(wbase + W_B_QB + (size_t)j * 1536 * 384) + (size_t)n0 * 384, (const unsigned char*)cqb + (size_t)m0 * 384, 384, lds, SC_M6, SC_ONE);
        const float qs = 0.10206207261596575f * LOG2E;
#pragma unroll
        for (int n = 0; n < 4; ++n) {
          const int tok = m0 + wc * 64 + n * 16 + fr;
          const float* pc = ssqc + (size_t)tok * 8;
          const float rstd = rsqrtf((pc[0] + pc[1] + pc[2]) * (1.f / 384.f) + EPS) * qs;
          const int s = tok & (S - 1);
          const float4 cs = *(const float4*)(rope + s * 32 + fq * 4);
          const float4 sn = *(const float4*)(rope + s * 32 + 16 + fq * 4);
#pragma unroll
          for (int mp = 0; mp < 4; ++mp) {
            const int fb = n0 + wr * 128 + mp * 32;
            const int cb = fb >> 5;
            unsigned char* dst = (unsigned char*)qb + (size_t)tok * 1536 + fb + fq * 4;
            const float x10 = acc[2 * mp][n][0] * rstd, x11 = acc[2 * mp][n][1] * rstd, x12 = acc[2 * mp][n][2] * rstd,
                        x13 = acc[2 * mp][n][3] * rstd;
            const float x20 = acc[2 * mp + 1][n][0] * rstd, x21 = acc[2 * mp + 1][n][1] * rstd, x22 = acc[2 * mp + 1][n][2] * rstd,
                        x23 = acc[2 * mp + 1][n][3] * rstd;
            if ((cb % 3) == 2) {
              *(unsigned*)dst = pack4_fp8c(x10 * cs.x - x20 * sn.x, x11 * cs.y - x21 * sn.y, x12 * cs.z - x22 * sn.z, x13 * cs.w - x23 * sn.w);
              *(unsigned*)(dst + 16) = pack4_fp8c(x10 * sn.x + x20 * cs.x, x11 * sn.y + x21 * cs.y, x12 * sn.z + x22 * cs.z, x13 * sn.w + x23 * cs.w);
            } else {
              *(unsigned*)dst = pack4_fp8c(x10, x11, x12, x13);
              *(unsigned*)(dst + 16) = pack4_fp8c(x20, x21, x22, x23);
            }
          }
        }
      } else {
        const int n0k = (nt - 6) * 256;
        gemm_core8(acc, (const unsigned char*)(wbase + W_B_KVB + (size_t)j * 2048 * 256) + (size_t)n0k * 256, (const unsigned char*)ckvb + (size_t)m0 * 256, 256, lds, SC_M6, SC_ONE);
        const int hd = (nt - 6) * 2 + wr;
#pragma unroll
        for (int n = 0; n < 4; ++n) {
          const int tok = m0 + wc * 64 + n * 16 + fr;
          const float* pc = ssqc + (size_t)tok * 8 + 4;
          const float rstd = rsqrtf((pc[0] + pc[1]) * (1.f / 256.f) + EPS);
          const int b = tok >> 13, s = tok & (S - 1);
#pragma unroll
          for (int m = 0; m < 8; ++m) {
            const float v0 = acc[m][n][0] * rstd, v1 = acc[m][n][1] * rstd, v2 = acc[m][n][2] * rstd, v3 = acc[m][n][3] * rstd;
            if (m < 4) {
              *(unsigned*)((unsigned char*)kb + (size_t)tok * 1024 + hd * 64 + m * 16 + fq * 4) = pack4_fp8c(v0, v1, v2, v3);
            } else {
              const float p0 = __shfl_xor(v0, 1), p1 = __shfl_xor(v1, 1), p2 = __shfl_xor(v2, 1), p3 = __shfl_xor(v3, 1);
              const bool odd = fr & 1;
              const float a0 = odd ? p2 : v0, b0 = odd ? v2 : p0;
              const float a1 = odd ? p3 : v1, b1 = odd ? v3 : p1;
              const int d = (m - 4) * 16 + fq * 4 + (odd ? 2 : 0);
              unsigned char* dst = (unsigned char*)vt + ((size_t)(b * 16 + hd) * 64 + d) * S + perm64(s & ~1);
              *(unsigned short*)dst = (unsigned short)(__builtin_amdgcn_cvt_pk_fp8_f32(clamp8(a0), clamp8(b0), 0, false) & 0xffff);
              *(unsigned short*)(dst + S) = (unsigned short)(__builtin_amdgcn_cvt_pk_fp8_f32(clamp8(a1), clamp8(b1), 0, false) & 0xffff);
            }
          }
        }
      }
    } else if constexpr (EPI == EPI_OUT) {
      if (!second) {
        if (layer & 1) {
          const unsigned char* wt = (const unsigned char*)(wbase + W_B_OUT + (size_t)j * 1024 * 1024);
          gemm_core8(acc, wt + (size_t)n0 * 1024, (const unsigned char*)og + (size_t)m0 * 1024, 1024, lds, SC_M6, SC_M4);
        } else {
          gemm_core(acc, wbase + W_A_OUT + (size_t)j * 1024 * 1024 + (size_t)n0 * 1024, og + (size_t)m0 * 1024, 1024, lds);
        }
        float* outp = uniform_ptr(P.out);
        const float* resid = (layer == 0) ? uniform_ptr(P.x) : outp;
#pragma unroll
        for (int n = 0; n < 4; ++n) {
          const int tok = m0 + wc * 64 + n * 16 + fr;
          float sq = 0.f;
#pragma unroll
          for (int m = 0; m < 8; m += 2) {
            const int f = n0 + wr * 128 + m * 16 + fq * 4;
            float4 rv = *(const float4*)(resid + (size_t)tok * DM + f);
            float4 rw = *(const float4*)(resid + (size_t)tok * DM + f + 16);
            rv.x += acc[m][n][0];
            rv.y += acc[m][n][1];
            rv.z += acc[m][n][2];
            rv.w += acc[m][n][3];
            rw.x += acc[m + 1][n][0];
            rw.y += acc[m + 1][n][1];
            rw.z += acc[m + 1][n][2];
            rw.w += acc[m + 1][n][3];
            sq += rv.x * rv.x + rv.y * rv.y + rv.z * rv.z + rv.w * rv.w;
            sq += rw.x * rw.x + rw.y * rw.y + rw.z * rw.z + rw.w * rw.w;
            *(float4*)(outp + (size_t)tok * DM + f) = rv;
            *(float4*)(outp + (size_t)tok * DM + f + 16) = rw;
            store_pair_bf(hmb + (size_t)tok * DM + n0 + wr * 128 + m * 16, fq, rv.x, rv.y, rv.z, rv.w, rw.x, rw.y, rw.z, rw.w);
          }
          sq = quad_sum(sq);
          if (fq == 0) ssqm[(size_t)tok * 8 + nt * 2 + wr] = sq;
        }
      } else {
        gemm_core(acc, wbase + W_PLE + (size_t)layer * 1024 * 256 + (size_t)n0 * 256, pbb + ((size_t)layer * T + m0) * 256, 256, lds);
#pragma unroll
        for (int n = 0; n < 4; ++n) {
          const int tok = m0 + wc * 64 + n * 16 + fr;
#pragma unroll
          for (int m = 0; m < 8; m += 2)
            store_pair_bf(eb + (size_t)tok * DM + n0 + wr * 128 + m * 16, fq, acc[m][n][0], acc[m][n][1], acc[m][n][2], acc[m][n][3],
                          acc[m + 1][n][0], acc[m + 1][n][1], acc[m + 1][n][2], acc[m + 1][n][3]);
        }
      }
    } else {
      gemm_core(acc, wbase + W_GATE + (size_t)layer * 1024 * 1024 + (size_t)n0 * 1024, hmb + (size_t)m0 * 1024, 1024, lds);
      float* outp = uniform_ptr(P.out);
#pragma unroll
      for (int n = 0; n < 4; ++n) {
        const int tok = m0 + wc * 64 + n * 16 + fr;
        const float rstd = rsqrtf(sum8(ssqm + (size_t)tok * 8) * (1.f / 1024.f) + EPS);
        float sq = 0.f;
#pragma unroll
        for (int m = 0; m < 8; ++m) {
          const int f = n0 + wr * 128 + m * 16 + fq * 4;
          float4 hv = *(const float4*)(outp + (size_t)tok * DM + f);
          const uint2 ee = *(const uint2*)(eb + (size_t)tok * DM + f);
          hv.x += bf2f(ee.x & 0xffffu) / (1.f + __expf(-acc[m][n][0] * rstd));
          hv.y += bf2f(ee.x >> 16) / (1.f + __expf(-acc[m][n][1] * rstd));
          hv.z += bf2f(ee.y & 0xffffu) / (1.f + __expf(-acc[m][n][2] * rstd));
          hv.w += bf2f(ee.y >> 16) / (1.f + __expf(-acc[m][n][3] * rstd));
          sq += hv.x * hv.x + hv.y * hv.y + hv.z * hv.z + hv.w * hv.w;
          *(float4*)(outp + (size_t)tok * DM + f) = hv;
          if ((layer & 1) == 0) *(unsigned*)((unsigned char*)hb + (size_t)tok * DM + f) = pack4_fp8c(hv.x, hv.y, hv.z, hv.w);
          else if (layer != 3) store4bf(hb + (size_t)tok * DM + f, hv.x, hv.y, hv.z, hv.w);
        }
        sq = quad_sum(sq);
        if (fq == 0) ssqh[(size_t)tok * 8 + nt * 2 + wr] = sq;
      }
    }
  }
}

template <bool MLA>
DI void attn_phase(const Params& P, int layer, char* lds) {
  constexpr int DQK = MLA ? 96 : 64;
  constexpr int KSTR = DQK * 2 + 16;
  constexpr int VSTR = 144;
  constexpr int KBYTES = 64 * KSTR;
  constexpr int ASTAGE = KBYTES + 64 * VSTR;
  constexpr int NKS = DQK / 16;
  const int tid = get_tid();
  const int lane = tid & 63, w = tid >> 6;
  const int r = lane & 31, h = lane >> 5;
  char* ws = uniform_ptr(P.ws);
  const bf16_t* qg = (const bf16_t*)(ws + OFF_Q);
  const bf16_t* kg = (const bf16_t*)(ws + OFF_K);
  const bf16_t* vtg = (const bf16_t*)(ws + OFF_VT);
  const bf16_t* krg = (const bf16_t*)(ws + OFF_KR);
  const bf16_t* zg = (const bf16_t*)(ws + OFF_Z);
  bf16_t* og = (bf16_t*)(ws + OFF_HB);
  const int j = layer >> 1;

  const int nitems = 2048;
  for (int item = blockIdx.x; item < nitems; item += gridDim.x) {
    int b, head, hkv, q0, t_lo, t_hi;
    int nheads_kv;
    if constexpr (MLA) {
      const int xcd = item & 7, slot = (item >> 3) & 31, grp = item >> 8;
      const int bh = grp * 8 + xcd;
      b = bh >> 4;
      head = bh & 15;
      hkv = head;
      nheads_kv = 16;
      q0 = slot * 256 + w * 32;
      t_lo = 0;
      t_hi = S / 64;
    } else {
      const int hp = item & 7, qblk = (item >> 3) & 63;
      b = item >> 9;
      head = hp * 2 + (w >> 2);
      hkv = hp >> 1;
      nheads_kv = 4;
      const int t0 = qblk * 128;
      q0 = t0 + (w & 3) * 32;
      const int lo = (t0 - 128 > 0) ? (t0 - 128) : 0;
      const int hi = (t0 + 256 < S) ? (t0 + 256) : S;
      t_lo = lo >> 6;
      t_hi = hi >> 6;
    }
    const int qld = MLA ? 1536 : 1024;
    const int tokq = b * S + q0 + r;
    bf16x8 qf[NKS];
#pragma unroll
    for (int ks = 0; ks < NKS; ++ks)
      qf[ks] = *(const bf16x8*)(qg + (size_t)tokq * qld + head * DQK + ks * 16 + 8 * h);

    float m_run, l_run;
    float slope2 = 0.f;
    if constexpr (MLA) {
      m_run = 0.f;
      l_run = 0.f;
    } else {
      m_run = P.a_sink[j * 16 + head] * LOG2E;
      l_run = (h == 0) ? 1.f : 0.f;
      slope2 = exp2f(-0.5f * (float)(head + 1)) * LOG2E;
    }
    f32x16 o[2], negm;
#pragma unroll
    for (int i = 0; i < 16; ++i) { o[0][i] = 0.f; o[1][i] = 0.f; negm[i] = -m_run; }

    const int lrow = tid >> 3, lc = tid & 7;
    uint4 kreg, vreg, rreg;
    auto load_regs = [&](int t) {
      const int kbase = t * 64;
      if constexpr (MLA) {
        kreg = *(const uint4*)(kg + (size_t)(b * S + kbase + lrow) * 1024 + head * 64 + lc * 8);
        if (tid < 256) rreg = *(const uint4*)(krg + (size_t)(b * S + kbase + (tid >> 2)) * 32 + (tid & 3) * 8);
      } else {
        kreg = *(const uint4*)(kg + (size_t)(b * S + kbase + lrow) * 256 + hkv * 64 + lc * 8);
      }
      vreg = *(const uint4*)(vtg + ((size_t)(b * nheads_kv + hkv) * 64 + lrow) * S + kbase + lc * 8);
    };
    auto write_lds = [&](int st) {
      char* base = lds + st * ASTAGE;
      *(uint4*)(base + lrow * KSTR + lc * 16) = kreg;
      if constexpr (MLA) {
        if (tid < 256) *(uint4*)(base + (tid >> 2) * KSTR + 128 + (tid & 3) * 16) = rreg;
      }
      *(uint4*)(base + KBYTES + lrow * VSTR + lc * 16) = vreg;
    };

    __syncthreads();
    load_regs(t_lo);
    write_lds(0);
    __syncthreads();
#pragma unroll 1
    for (int t = t_lo; t < t_hi; ++t) {
      load_regs((t + 1 < t_hi) ? (t + 1) : t);
      const char* base = lds + ((t - t_lo) & 1) * ASTAGE;
      const int kbase = t * 64;
      bool active = true;
      if constexpr (!MLA) active = (kbase + 63 >= q0 - 128) && (kbase <= q0 + 159);
      if (active) {
        f32x16 sc[2];
        {
          bf16x8 kf[2][NKS];
#pragma unroll
          for (int kb = 0; kb < 2; ++kb)
#pragma unroll
            for (int ks = 0; ks < NKS; ++ks) kf[kb][ks] = *(const bf16x8*)(base + (kb * 32 + r) * KSTR + h * 16 + ks * 32);
#pragma unroll
          for (int kb = 0; kb < 2; ++kb) {
            sc[kb] = MFMA(kf[kb][0], qf[0], negm);
#pragma unroll
            for (int ks = 1; ks < NKS; ++ks) sc[kb] = MFMA(kf[kb][ks], qf[ks], sc[kb]);
          }
        }
        if constexpr (!MLA) {
          const int tq = q0 + r;
#pragma unroll
          for (int kb = 0; kb < 2; ++kb)
#pragma unroll
            for (int i = 0; i < 16; ++i) {
              const int kp = kbase + kb * 32 + crow(i, h);
              int d = kp - tq;
              d = d < 0 ? -d : d;
              sc[kb][i] = (d <= 128) ? (sc[kb][i] - slope2 * (float)d) : -1e30f;
            }
        }
        int imx = max(__float_as_int(sc[0][0]), __float_as_int(sc[1][0]));
#pragma unroll
        for (int i = 1; i < 16; ++i) imx = max(imx, max(__float_as_int(sc[0][i]), __float_as_int(sc[1][i])));
        bool slow = __any(imx > 0x41000000);
        if constexpr (MLA) slow = slow || (t == t_lo);
        if (slow) {
          float mx = fmaxf(sc[0][0], sc[1][0]);
#pragma unroll
          for (int i = 1; i < 16; ++i) mx = fmaxf(mx, fmaxf(sc[0][i], sc[1][i]));
          mx = xhalf_max(mx);
          float delta = fmaxf(mx, 0.f);
          if constexpr (MLA) { if (t == t_lo) delta = mx; }
          float alpha = __builtin_amdgcn_exp2f(-delta);
          if constexpr (MLA) { if (t == t_lo) alpha = 1.f; }
          m_run += delta;
          l_run *= alpha;
#pragma unroll
          for (int i = 0; i < 16; ++i) {
            o[0][i] *= alpha;
            o[1][i] *= alpha;
            sc[0][i] -= delta;
            sc[1][i] -= delta;
            negm[i] = -m_run;
          }
        }
        f32x2_t ps2 = {0.f, 0.f};
        bf16x8 pf[2][2];
#pragma unroll
        for (int kb = 0; kb < 2; ++kb) {
#pragma unroll
          for (int i = 0; i < 16; i += 2) {
            const float p0 = __builtin_amdgcn_exp2f(sc[kb][i]);
            const float p1 = __builtin_amdgcn_exp2f(sc[kb][i + 1]);
            sc[kb][i] = p0;
            sc[kb][i + 1] = p1;
            ps2 += f32x2_t{p0, p1};
          }
#pragma unroll
          for (int sidx = 0; sidx < 2; ++sidx) {
            uint4 u;
            u.x = pack2(sc[kb][8 * sidx + 0], sc[kb][8 * sidx + 1]);
            u.y = pack2(sc[kb][8 * sidx + 2], sc[kb][8 * sidx + 3]);
            u.z = pack2(sc[kb][8 * sidx + 4], sc[kb][8 * sidx + 5]);
            u.w = pack2(sc[kb][8 * sidx + 6], sc[kb][8 * sidx + 7]);
            pf[kb][sidx] = __builtin_bit_cast(bf16x8, u);
          }
        }
        l_run += ps2[0] + ps2[1];
#pragma unroll
        for (int db = 0; db < 2; ++db) {
          const char* lv = base + KBYTES + (db * 32 + r) * VSTR + h * 16;
#pragma unroll
          for (int kb = 0; kb < 2; ++kb)
#pragma unroll
            for (int sidx = 0; sidx < 2; ++sidx) {
              bf16x8 vf = *(const bf16x8*)(lv + kb * 64 + sidx * 32);
              o[db] = MFMA(vf, pf[kb][sidx], o[db]);
            }
        }
      }
      write_lds((t + 1 - t_lo) & 1);
      __syncthreads();
    }
    const float l_tot = l_run + __shfl_xor(l_run, 32);
    const float inv = 1.f / l_tot;
#pragma unroll
    for (int db = 0; db < 2; ++db)
#pragma unroll
      for (int g = 0; g < 4; ++g) {
        const int d = db * 32 + 8 * g + 4 * h;
        const size_t off = (size_t)tokq * 1024 + head * 64 + d;
        const uint2 zz = *(const uint2*)(zg + off);
        const float z0 = bf2f(zz.x & 0xffffu), z1 = bf2f(zz.x >> 16), z2 = bf2f(zz.y & 0xffffu), z3 = bf2f(zz.y >> 16);
        const float g0 = z0 / (1.f + __expf(-z0)), g1 = z1 / (1.f + __expf(-z1)), g2 = z2 / (1.f + __expf(-z2)),
                    g3 = z3 / (1.f + __expf(-z3));
        store4bf(og + off, o[db][4 * g] * inv * g0, o[db][4 * g + 1] * inv * g1, o[db][4 * g + 2] * inv * g2,
                 o[db][4 * g + 3] * inv * g3);
      }
  }
}

typedef __attribute__((ext_vector_type(8))) int i32x8;
#define MFMA8(a, b, c) __builtin_amdgcn_mfma_scale_f32_32x32x64_f8f6f4((a), (b), (c), 0, 0, 0, 0x7f7f7f7f, 0, 0x7f7f7f7f)
DI unsigned pack4_fp8(float a, float b, float c, float d) {
  int r = __builtin_amdgcn_cvt_pk_fp8_f32(a, b, 0, false);
  r = __builtin_amdgcn_cvt_pk_fp8_f32(c, d, r, true);
  return (unsigned)r;
}
DI float clamp8(float x) { return __builtin_amdgcn_fmed3f(x, -440.f, 440.f); }
DI unsigned pack4_fp8c(float a, float b, float c, float d) { return pack4_fp8(clamp8(a), clamp8(b), clamp8(c), clamp8(d)); }
DI int perm64(int s) {
  const int c = (s >> 2) & 15;
  const int pc = ((c & 1) << 3) | (c >> 1);
  return (s & ~63) | (pc << 2) | (s & 3);
}
DI i32x8 ld32(const char* p) {
  const uint4 a = *(const uint4*)p, b = *(const uint4*)(p + 16);
  i32x8 r = {(int)a.x, (int)a.y, (int)a.z, (int)a.w, (int)b.x, (int)b.y, (int)b.z, (int)b.w};
  return r;
}

DI void attn_mla8_phase(const Params& P, char* lds) {
  constexpr int KSTR = 144;
  constexpr int VSTR = 80;
  constexpr int KBYTES = 64 * KSTR;
  constexpr int ASTAGE = KBYTES + 64 * VSTR;
  constexpr float PBIAS = 4.f;
  const int tid = get_tid();
  const int lane = tid & 63, w = tid >> 6;
  const int r = lane & 31, h = lane >> 5;
  char* ws = uniform_ptr(P.ws);
  const unsigned char* qg = (const unsigned char*)(ws + OFF_Q);
  const unsigned char* kg = (const unsigned char*)(ws + OFF_K);
  const unsigned char* vtg = (const unsigned char*)(ws + OFF_VT);
  const unsigned char* krg = (const unsigned char*)(ws + OFF_KR);
  const bf16_t* zg = (const bf16_t*)(ws + OFF_Z);
  bf16_t* og = (bf16_t*)(ws + OFF_HB);

  __syncthreads();
  if (tid < 384) {
    const int zr = tid >> 1, zs = tid >> 7;
    *(uint4*)(lds + zs * ASTAGE + (zr & 63) * KSTR + 96 + (tid & 1) * 16) = make_uint4(0u, 0u, 0u, 0u);
  }
  for (int item = blockIdx.x; item < 2048; item += gridDim.x) {
    const int xcd = item & 7, slot = (item >> 3) & 31, grp = item >> 8;
    const int bh = grp * 8 + xcd;
    const int b = bh >> 4, head = bh & 15;
    const int q0 = slot * 256 + w * 32;
    const int tokq = b * S + q0 + r;
    const unsigned char* qrow = qg + (size_t)tokq * 1536 + head * 96;
    const i32x8 qn = ld32((const char*)qrow + 32 * h);
    i32x8 qr = ld32((const char*)qrow + 64);
    if (h) qr = i32x8{0, 0, 0, 0, 0, 0, 0, 0};

    float m_run = 0.f, l_run = 0.f;
    f32x16 o[2], negm;
#pragma unroll
    for (int i = 0; i < 16; ++i) { o[0][i] = 0.f; o[1][i] = 0.f; negm[i] = PBIAS; }

    const int lrow = (tid & 255) >> 2, lc = tid & 3;
    const bool isk = tid < 256;
    const unsigned char* gmain = isk ? (kg + (size_t)(b * S + lrow) * 1024 + head * 64 + lc * 16)
                                     : (vtg + ((size_t)(b * 16 + head) * 64 + lrow) * S + lc * 16);
    const int gstep = isk ? 65536 : 64;
    const int lmain = isk ? (lrow * KSTR + lc * 16) : (KBYTES + lrow * VSTR + lc * 16);
    const int rrow = (tid & 127) >> 1, rc = tid & 1;
    const unsigned char* grope = krg + (size_t)(b * S + rrow) * 32 + rc * 16;
    const int lrope = rrow * KSTR + 64 + rc * 16;
    uint4 areg, rreg;
    const int trot = (slot * 4) & (S / 64 - 1);
#define MLA8_LOAD(t_)                                             \
  do {                                                            \
    const int tp_ = ((t_) + trot) & (S / 64 - 1);                 \
    areg = *(const uint4*)(gmain + (size_t)tp_ * gstep);          \
    rreg = *(const uint4*)(grope + (size_t)tp_ * 2048);           \
  } while (0)
#define MLA8_WRITE(st_)                                           \
  do {                                                            \
    char* wb_ = lds + (st_) * ASTAGE;                             \
    *(uint4*)(wb_ + lmain) = areg;                                \
    if (tid < 128) *(uint4*)(wb_ + lrope) = rreg;                 \
  } while (0)

    i32x8 kn[2], kr[2];
    __syncthreads();
    MLA8_LOAD(0);
    MLA8_WRITE(0);
    MLA8_LOAD(1);
    MLA8_WRITE(1);
    __syncthreads();
#pragma unroll
    for (int kb = 0; kb < 2; ++kb) {
      const char* lk = lds + (kb * 32 + r) * KSTR;
      kn[kb] = ld32(lk + 32 * h);
      kr[kb] = ld32(lk + 64 + 32 * h);
    }
    int st_cur = 0;
#pragma unroll 1
    for (int t = 0; t < S / 64; ++t) {
      MLA8_LOAD((t + 2 < S / 64) ? (t + 2) : (S / 64 - 1));
      const char* base = lds + st_cur * ASTAGE;
      const int st_nxt = (st_cur == 2) ? 0 : st_cur + 1;
      const int st_wr = (st_nxt == 2) ? 0 : st_nxt + 1;
      f32x16 sc[2];
      i32x8 vf[2];
      vf[0] = ld32(base + KBYTES + r * VSTR + 32 * h);
      vf[1] = ld32(base + KBYTES + (32 + r) * VSTR + 32 * h);
#pragma unroll
      for (int kb = 0; kb < 2; ++kb) {
        sc[kb] = MFMA8(kn[kb], qn, negm);
        sc[kb] = MFMA8(kr[kb], qr, sc[kb]);
      }
      int imx = max(__float_as_int(sc[0][0]), __float_as_int(sc[1][0]));
#pragma unroll
      for (int i = 1; i < 16; ++i) imx = max(imx, max(__float_as_int(sc[0][i]), __float_as_int(sc[1][i])));
      const bool slow = __any(imx > 0x41000000) || (t == 0);
      if (slow) {
        float mx = fmaxf(sc[0][0], sc[1][0]);
#pragma unroll
        for (int i = 1; i < 16; ++i) mx = fmaxf(mx, fmaxf(sc[0][i], sc[1][i]));
        mx = xhalf_max(mx);
        float delta = fmaxf(mx - PBIAS, 0.f);
        float alpha = __builtin_amdgcn_exp2f(-delta);
        if (t == 0) { delta = mx - PBIAS; alpha = 1.f; }
        m_run += delta;
        l_run *= alpha;
#pragma unroll
        for (int i = 0; i < 16; ++i) {
          o[0][i] *= alpha;
          o[1][i] *= alpha;
          sc[0][i] -= delta;
          sc[1][i] -= delta;
          negm[i] = PBIAS - m_run;
        }
      }
      f32x2_t ps2 = {0.f, 0.f};
      i32x8 pb;
#pragma unroll
      for (int kb = 0; kb < 2; ++kb) {
#pragma unroll
        for (int i = 0; i < 16; i += 2) {
          const f32x2_t tt = f32x2_t{sc[kb][i], sc[kb][i + 1]} * f32x2_t{8388608.f, 8388608.f} + f32x2_t{1065353216.f, 1065353216.f};
          const float p0 = __uint_as_float((unsigned)tt[0]);
          const float p1 = __uint_as_float((unsigned)tt[1]);
          sc[kb][i] = p0;
          sc[kb][i + 1] = p1;
          ps2 += f32x2_t{p0, p1};
        }
#pragma unroll
        for (int q4 = 0; q4 < 4; ++q4)
          pb[kb * 4 + q4] = (int)pack4_fp8(sc[kb][4 * q4], sc[kb][4 * q4 + 1], sc[kb][4 * q4 + 2], sc[kb][4 * q4 + 3]);
      }
      l_run += ps2[0] + ps2[1];
#pragma unroll
      for (int db = 0; db < 2; ++db) {
        o[db] = MFMA8(vf[db], pb, o[db]);
      }
      {
        const char* nb = lds + st_nxt * ASTAGE;
#pragma unroll
        for (int kb = 0; kb < 2; ++kb) {
          const char* lk = nb + (kb * 32 + r) * KSTR;
          kn[kb] = ld32(lk + 32 * h);
          kr[kb] = ld32(lk + 64 + 32 * h);
        }
      }
      MLA8_WRITE(st_wr);
      __syncthreads();
      st_cur = st_nxt;
    }
    const float l_tot = l_run + __shfl_xor(l_run, 32);
    const float inv = 1.f / l_tot;
#pragma unroll
    for (int db = 0; db < 2; ++db)
#pragma unroll
      for (int g = 0; g < 4; ++g) {
        const int d = db * 32 + 8 * g + 4 * h;
        const size_t off = (size_t)tokq * 1024 + head * 64 + d;
        const uint2 zz = *(const uint2*)(zg + off);
        const float z0 = bf2f(zz.x & 0xffffu), z1 = bf2f(zz.x >> 16), z2 = bf2f(zz.y & 0xffffu), z3 = bf2f(zz.y >> 16);
        const float g0 = z0 / (1.f + __expf(-z0)), g1 = z1 / (1.f + __expf(-z1)), g2 = z2 / (1.f + __expf(-z2)),
                    g3 = z3 / (1.f + __expf(-z3));
        const float i64 = inv * 16.f;
        *(unsigned*)((unsigned char*)og + off) = pack4_fp8c(o[db][4 * g] * i64 * g0, o[db][4 * g + 1] * i64 * g1, o[db][4 * g + 2] * i64 * g2,
                                                         o[db][4 * g + 3] * i64 * g3);
      }
  }
#undef MLA8_LOAD
#undef MLA8_WRITE
}

DI void final_phase(const Params& P) {
  const int tid = get_tid();
  const int w = tid >> 6, lane = tid & 63;
  for (int row = blockIdx.x * 8 + w; row < T; row += gridDim.x * 8) {
    float4* xr = (float4*)(P.out + (size_t)row * DM);
    float4 v[4];
    float s = 0.f;
#pragma unroll
    for (int i = 0; i < 4; ++i) {
      v[i] = xr[lane + 64 * i];
      s += v[i].x * v[i].x + v[i].y * v[i].y + v[i].z * v[i].z + v[i].w * v[i].w;
    }
#pragma unroll
    for (int o = 32; o >= 1; o >>= 1) s += __shfl_xor(s, o);
    const float rstd = rsqrtf(s * (1.f / 1024.f) + EPS);
#pragma unroll
    for (int i = 0; i < 4; ++i) {
      const float4 g = ((const float4*)P.final_g)[lane + 64 * i];
      xr[lane + 64 * i] = make_float4(v[i].x * rstd * g.x, v[i].y * rstd * g.y, v[i].z * rstd * g.z, v[i].w * rstd * g.w);
    }
  }
}

#define XB_TMO      128
#define XB_XCNT(j)  (256  + 64 * (j))
#define XB_XSUB(j)  (1280 + 64 * (j))
#define XB_XGEN(j)  (2304 + 64 * (j))
#define XB_TOP      3328
#define XB_TOPGEN   3392
#define XCD_BAR_WORDS 3456
#define XB_SPIN_CAP (1u << 22)
#define LAS __attribute__((address_space(3)))
DI unsigned xb_ld(unsigned* p) { return __hip_atomic_load(p, __ATOMIC_RELAXED, __HIP_MEMORY_SCOPE_AGENT); }
DI unsigned xb_add(unsigned* p, unsigned v) { return __hip_atomic_fetch_add(p, v, __ATOMIC_RELAXED, __HIP_MEMORY_SCOPE_AGENT); }
DI unsigned xb_xcc_id() { return (unsigned)__builtin_amdgcn_s_getreg((3 << 11) | 20) & 0xFu; }
#define XB_SPIN(cond, bar) do { unsigned _sp = 0; while (cond) { __builtin_amdgcn_s_sleep(1); \
    if ((++_sp & 255u) == 0u) { if (xb_ld(&(bar)[XB_TMO])) break; if (_sp > XB_SPIN_CAP) { atomicAdd(&(bar)[XB_TMO], 1u); break; } } } } while (0)
struct XcdBarrier {
  unsigned* bar;
  unsigned x;
  volatile LAS unsigned* st;
};
DI XcdBarrier xcd_barrier_post(unsigned* bar, volatile LAS unsigned* st) {
  XcdBarrier b;
  b.bar = bar;
  b.x = xb_xcc_id();
  b.st = st;
  if (threadIdx.x == 0) (void)xb_add(&bar[XB_XCNT(b.x)], 1u);
  return b;
}
DI void xcd_barrier_complete(unsigned* bar, unsigned x, unsigned& nloc, unsigned& nx) {
  const unsigned G = gridDim.x * gridDim.y * gridDim.z;
  unsigned sum, cnt, mine, sp = 0u;
  for (;;) {
    sum = 0u; cnt = 0u; mine = 0u;
#pragma unroll
    for (unsigned j = 0; j < 16; ++j) {
      const unsigned c = xb_ld(&bar[XB_XCNT(j)]);
      sum += c;
      cnt += (c > 0u) ? 1u : 0u;
      mine = (j == x) ? c : mine;
    }
    if (sum == G) break;
    __builtin_amdgcn_s_sleep(1);
    if ((++sp & 255u) == 0u) { if (xb_ld(&bar[XB_TMO])) break; if (sp > XB_SPIN_CAP) { atomicAdd(&bar[XB_TMO], 1u); break; } }
  }
  nloc = mine > 0u ? mine : 1u;
  nx = cnt > 0u ? cnt : 1u;
}
DI void xcd_barrier(const XcdBarrier& b) {
  asm volatile("s_waitcnt vmcnt(0)" ::: "memory");
  __syncthreads();
  if (threadIdx.x == 0) {
    unsigned* bar = b.bar;
    __builtin_amdgcn_s_waitcnt(0);
    unsigned nloc = b.st[0], nx = b.st[1];
    if (nloc == 0u) { xcd_barrier_complete(bar, b.x, nloc, nx); b.st[0] = nloc; b.st[1] = nx; }
    const unsigned old = xb_add(&bar[XB_XSUB(b.x)], 1u);
    const unsigned gen = old / nloc;
    if (old + 1u == (gen + 1u) * nloc) {
      __builtin_amdgcn_fence(__ATOMIC_RELEASE, "agent");
      asm volatile("s_waitcnt vmcnt(0)" ::: "memory");
      const unsigned og = xb_add(&bar[XB_TOP], 1u);
      const unsigned tg = og / nx;
      if (og + 1u == (tg + 1u) * nx) xb_add(&bar[XB_TOPGEN], 1u);
      else XB_SPIN(xb_ld(&bar[XB_TOPGEN]) == tg, bar);
      __builtin_amdgcn_fence(__ATOMIC_ACQUIRE, "agent");
      xb_add(&bar[XB_XGEN(b.x)], 1u);
      asm volatile("s_waitcnt vmcnt(0)" ::: "memory");
    } else {
      XB_SPIN(xb_ld(&bar[XB_XGEN(b.x)]) == gen, bar);
      __builtin_amdgcn_fence(__ATOMIC_ACQUIRE, "agent");
      asm volatile("s_waitcnt vmcnt(0)" ::: "memory");
    }
  }
  __syncthreads();
}

constexpr int NPHASE = 1 + 2 * (4 + 5) + 1;

DI void run_phase(const Params& P, int ph, char* lds) {
  if (ph == 0) { prep_phase(P, lds); return; }
  if (ph == NPHASE - 1) { final_phase(P); return; }
  const int q = (ph - 1) / 9, rr = (ph - 1) % 9;
  if (rr < 4) {
    const int layer = q * 2;
    if (rr == 0) gemm_phase<EPI_A_IN>(P, layer, lds);
    else if (rr == 1) attn_phase<false>(P, layer, lds);
    else if (rr == 2) gemm_phase<EPI_OUT>(P, layer, lds);
    else gemm_phase<EPI_PLE>(P, layer, lds);
  } else {
    const int layer = q * 2 + 1;
    if (rr == 4) gemm_phase<EPI_B_IN>(P, layer, lds);
    else if (rr == 5) gemm_phase<EPI_QKV_UP>(P, layer, lds);
    else if (rr == 6) attn_phase<true>(P, layer, lds);
    else if (rr == 7) gemm_phase<EPI_OUT>(P, layer, lds);
    else gemm_phase<EPI_PLE>(P, layer, lds);
  }
}

__global__ void __launch_bounds__(NTHREADS) fwd_kernel(Params P) {
  __shared__ __attribute__((aligned(1024))) char lds[LDS_BYTES + 16];
#if MULTI_LAUNCH
  run_phase(P, P.phase_lo, lds);
#else
  cg::grid_group grid = cg::this_grid();
  volatile LAS unsigned* xst = (volatile LAS unsigned*)(lds + LDS_BYTES);
  if (threadIdx.x == 0) { xst[0] = 0u; xst[1] = 0u; }
  __syncthreads();
  const XcdBarrier xb = xcd_barrier_post((unsigned*)(P.ws + OFF_BAR), xst);
  prep_phase(P, lds);
#if (PROBE_REPEAT >> 9) & 1
  prep_phase(P, lds);
#endif
  grid.sync();
#pragma unroll 1
  for (int q = 0; q < 2; ++q) {
    const int la = 2 * q, lb = 2 * q + 1;
    gemm_phase<EPI_A_IN>(P, la, lds);
#if (PROBE_REPEAT >> 0) & 1
    gemm_phase<EPI_A_IN>(P, la, lds);
#endif
    GSYNC();
    attn_phase<false>(P, la, lds);
#if (PROBE_REPEAT >> 1) & 1
    attn_phase<false>(P, la, lds);
#endif
    GSYNC();
    gemm_phase<EPI_OUT>(P, la, lds);
    GSYNC();
    gemm_phase<EPI_PLE>(P, la, lds);
    GSYNC();
    gemm_phase<EPI_B_IN>(P, lb, lds);
#if (PROBE_REPEAT >> 4) & 1
    gemm_phase<EPI_B_IN>(P, lb, lds);
#endif
    GSYNC();
    gemm_phase<EPI_QKV_UP>(P, lb, lds);
#if (PROBE_REPEAT >> 5) & 1
    gemm_phase<EPI_QKV_UP>(P, lb, lds);
#endif
    GSYNC();
    attn_mla8_phase(P, lds);
#if (PROBE_REPEAT >> 6) & 1
    attn_mla8_phase(P, lds);
#endif
    GSYNC();
    gemm_phase<EPI_OUT>(P, lb, lds);
    GSYNC();
    gemm_phase<EPI_PLE>(P, lb, lds);
    GSYNC();
  }
  final_phase(P);
#endif
}

static void add_seg(Params& p, int& tiles, const float* src, const float* gain, bf16_t* dst, int src_ld, int ncols, int K, int fp8 = 0) {
  Seg& s = p.seg[p.nseg++];
  s.src = src;
  s.gain = gain;
  s.dst = dst;
  s.src_ld = src_ld;
  s.ncols = ncols;
  s.K = K;
  s.fp8 = fp8;
  s.pad0 = 0;
  s.tile0 = tiles;
  tiles += (K / 64) * (ncols / 32);
}

extern "C" void kernel_launch(void* const* d_in, const int* in_sizes, int n_in, void* d_out, int out_size, void* d_ws,
                              size_t ws_size, hipStream_t stream) {
  (void)in_sizes; (void)n_in; (void)out_size;
  if (ws_size < WS_NEEDED) {
    fprintf(stderr, "workspace too small: %zu < %zu\n", ws_size, (size_t)WS_NEEDED);
    return;
  }
  const float* x = (const float*)d_in[0];
  const float* pp = (const float*)d_in[1];
  const float* norm_g = (const float*)d_in[2];
  const float* a_w_in = (const float*)d_in[3];
  const float* a_sink = (const float*)d_in[4];
  const float* a_w_out = (const float*)d_in[5];
  const float* b_w_in = (const float*)d_in[6];
  const float* b_q_norm = (const float*)d_in[7];
  const float* b_w_qb = (const float*)d_in[8];
  const float* b_kv_norm = (const float*)d_in[9];
  const float* b_w_kvb = (const float*)d_in[10];
  const float* b_w_out = (const float*)d_in[11];
  const float* ple_w = (const float*)d_in[12];
  const float* ple_norm_g = (const float*)d_in[13];
  const float* ple_w_gate = (const float*)d_in[14];
  const float* final_g = (const float*)d_in[15];

  Params p;
  memset(&p, 0, sizeof(p));
  p.x = x;
  p.p = pp;
  p.a_sink = a_sink;
  p.final_g = final_g;
  p.out = (float*)d_out;
  p.ws = (char*)d_ws;
  bf16_t* wb = (bf16_t*)((char*)d_ws + OFF_W);
  int tiles = 0;
  for (int j = 0; j < 2; ++j) {
    const int la = 2 * j, lb = 2 * j + 1;
    add_seg(p, tiles, a_w_in + (size_t)j * 1024 * 2560, norm_g + la * 1024, wb + W_A_IN + (size_t)j * 2560 * 1024, 2560, 2560, 1024);
    add_seg(p, tiles, a_w_out + (size_t)j * 1024 * 1024, nullptr, wb + W_A_OUT + (size_t)j * 1024 * 1024, 1024, 1024, 1024);
    const float* bsrc = b_w_in + (size_t)j * 1024 * 1696;
    unsigned char* bdst = (unsigned char*)(wb + W_B_IN + (size_t)j * 1792 * 1024);
    const float* gb = norm_g + lb * 1024;
    add_seg(p, tiles, bsrc + 672, gb, (bf16_t*)bdst, 1696, 1024, 1024, 1);
    add_seg(p, tiles, bsrc + 0, gb, (bf16_t*)(bdst + (size_t)1024 * 1024), 1696, 384, 1024, 1);
    add_seg(p, tiles, bsrc + 384, gb, (bf16_t*)(bdst + (size_t)1408 * 1024), 1696, 256, 1024, 1);
    add_seg(p, tiles, bsrc + 640, gb, (bf16_t*)(bdst + (size_t)1664 * 1024), 1696, 32, 1024, 1);
    add_seg(p, tiles, nullptr, nullptr, (bf16_t*)(bdst + (size_t)1696 * 1024), 1696, 96, 1024, 1);
    add_seg(p, tiles, b_w_qb + (size_t)j * 384 * 1536, b_q_norm + j * 384, wb + W_B_QB + (size_t)j * 1536 * 384, 1536, 1536, 384, 1);
    add_seg(p, tiles, b_w_kvb + (size_t)j * 256 * 2048, b_kv_norm + j * 256, wb + W_B_KVB + (size_t)j * 2048 * 256, 2048, 2048, 256, 1);
    add_seg(p, tiles, b_w_out + (size_t)j * 1024 * 1024, nullptr, wb + W_B_OUT + (size_t)j * 1024 * 1024, 1024, 1024, 1024, 1);
  }
  for (int i = 0; i < 4; ++i) {
    add_seg(p, tiles, ple_w + (size_t)i * 256 * 1024, nullptr, wb + W_PLE + (size_t)i * 1024 * 256, 1024, 1024, 256);
    add_seg(p, tiles, ple_w_gate + (size_t)i * 1024 * 1024, ple_norm_g + i * 1024, wb + W_GATE + (size_t)i * 1024 * 1024, 1024, 1024, 1024);
  }
  p.ntile_w = tiles;

#if MULTI_LAUNCH
  for (int ph = 0; ph < NPHASE; ++ph) {
    p.phase_lo = ph;
    p.phase_hi = ph + 1;
    hipLaunchKernelGGL(fwd_kernel, dim3(1024), dim3(NTHREADS), 0, stream, p);
  }
#else
  static int grid_blocks = 0;
  if (!grid_blocks) {
    int dev = 0, cus = 0, per_cu = 0;
    hipGetDevice(&dev);
    hipDeviceGetAttribute(&cus, hipDeviceAttributeMultiprocessorCount, dev);
    hipOccupancyMaxActiveBlocksPerMultiprocessor(&per_cu, fwd_kernel, NTHREADS, 0);
    if (per_cu < 1) per_cu = 1;
    if (per_cu > 1) per_cu = 1;
    grid_blocks = cus * per_cu;
  }
  p.phase_lo = 0;
  p.phase_hi = NPHASE;
  (void)hipMemsetAsync((char*)d_ws + OFF_BAR, 0, 16384, stream);
  void* args[] = {&p};
  hipError_t e = hipLaunchCooperativeKernel((void*)fwd_kernel, dim3(grid_blocks), dim3(NTHREADS), args, 0, stream);
  if (e != hipSuccess) fprintf(stderr, "cooperative launch failed: %s (grid %d)\n", hipGetErrorString(e), grid_blocks);
#endif
}
```

```cpp
#include <hip/hip_runtime.h>
#include <hip/hip_cooperative_groups.h>
#include <cstdio>
#include <cstring>
namespace cg = cooperative_groups;

#ifndef PROBE_REPEAT
#define PROBE_REPEAT 0
#endif
#ifndef PROBE_SYNC2
#define PROBE_SYNC2 0
#endif
#if PROBE_SYNC2
#define GSYNC() do { xcd_barrier(xb); xcd_barrier(xb); } while (0)
#else
#define GSYNC() xcd_barrier(xb)
#endif
#ifndef MULTI_LAUNCH
#define MULTI_LAUNCH 0
#endif

#define DI __device__ __forceinline__
typedef __attribute__((ext_vector_type(8))) short bf16x8;
typedef __attribute__((ext_vector_type(16))) float f32x16;
typedef unsigned short bf16_t;

constexpr int T = 32768, S = 8192, NB = 4, DM = 1024, PLE = 256;
constexpr int NTHREADS = 512;
constexpr float LOG2E = 1.4426950408889634f;
constexpr float EPS = 1e-6f;

constexpr size_t MiB = 1024ull * 1024ull;
constexpr size_t OFF_HB = 0;
constexpr size_t OFF_Z = 64 * MiB;
constexpr size_t OFF_Q = 128 * MiB;
constexpr size_t OFF_K = 224 * MiB;
constexpr size_t OFF_VT = 288 * MiB;
constexpr size_t OFF_CQ = 352 * MiB;
constexpr size_t OFF_CKV = 376 * MiB;
constexpr size_t OFF_KR = 392 * MiB;
constexpr size_t OFF_SSQH = 394 * MiB;
constexpr size_t OFF_SSQM = 395 * MiB;
constexpr size_t OFF_SSQC = 396 * MiB;
constexpr size_t OFF_ROPE = 397 * MiB;
constexpr size_t OFF_W = 398 * MiB;
constexpr size_t OFF_PB = 438 * MiB;
constexpr size_t OFF_BAR = 502 * MiB;
constexpr size_t W_A_IN = 0;
constexpr size_t W_A_OUT = W_A_IN + 2ull * 2560 * 1024;
constexpr size_t W_B_IN = W_A_OUT + 2ull * 1024 * 1024;
constexpr size_t W_B_QB = W_B_IN + 2ull * 1792 * 1024;
constexpr size_t W_B_KVB = W_B_QB + 2ull * 1536 * 384;
constexpr size_t W_B_OUT = W_B_KVB + 2ull * 2048 * 256;
constexpr size_t W_PLE = W_B_OUT + 2ull * 1024 * 1024;
constexpr size_t W_GATE = W_PLE + 4ull * 1024 * 256;
constexpr size_t W_END = W_GATE + 4ull * 1024 * 1024;
static_assert(OFF_W + W_END * 2 <= OFF_PB, "weights overflow");
constexpr size_t WS_NEEDED = OFF_BAR + 1 * MiB;

struct Seg {
  const float* src;
  const float* gain;
  bf16_t* dst;
  int src_ld, ncols, K, tile0;
  int fp8, pad0;
};
constexpr int MAXSEG = 32;

struct Params {
  const float *x, *p, *a_sink, *final_g;
  float* out;
  char* ws;
  Seg seg[MAXSEG];
  int nseg, ntile_w;
  int phase_lo, phase_hi;
};

typedef __attribute__((ext_vector_type(2))) float f32x2_t;
typedef __attribute__((ext_vector_type(2))) __bf16 bf16x2_t;
DI unsigned pack2(float a, float b) {
  f32x2_t v = {a, b};
  return __builtin_bit_cast(unsigned, __builtin_convertvector(v, bf16x2_t));
}
DI unsigned f2bf(float x) { return pack2(x, 0.f) & 0xffffu; }
DI float xhalf_max(float x) {
  return fmaxf(x, __shfl_xor(x, 32));
}
DI float bf2f(unsigned h) { return __uint_as_float(h << 16); }
DI int crow(int i, int h) { return (i & 3) + 8 * (i >> 2) + 4 * h; }
DI int perm16(int s) {
  int k = s & 15;
  int c = k >> 2;
  int pc = ((c & 1) << 1) | (c >> 1);
  return (s & ~15) | (pc << 2) | (k & 3);
}
#define MFMA(a, b, c) __builtin_amdgcn_mfma_f32_32x32x16_bf16((a), (b), (c), 0, 0, 0)
DI int get_tid() {
  int t = threadIdx.x;
  asm volatile("" : "+v"(t));
  return t;
}
template <typename TP>
DI TP* uniform_ptr(TP* p) {
  unsigned lo = (unsigned)(size_t)p, hi = (unsigned)((size_t)p >> 32);
  lo = __builtin_amdgcn_readfirstlane(lo);
  hi = __builtin_amdgcn_readfirstlane(hi);
  asm volatile("" : "+s"(lo), "+s"(hi));
  return (TP*)(((size_t)hi << 32) | (size_t)lo);
}
DI unsigned pack4_fp8(float a, float b, float c, float d);
DI unsigned pack4_fp8c(float a, float b, float c, float d);
DI float clamp8(float x);
DI float wave_xor_sum32(float v) { return v + __shfl_xor(v, 32); }

DI void prep_phase(const Params& P, char* lds) {
  const int tid = get_tid();
  float* tl = (float*)lds;
  for (int t = blockIdx.x; t < P.ntile_w; t += gridDim.x) {
    int si = 0;
    for (int i = 1; i < P.nseg; ++i)
      if (t >= P.seg[i].tile0) si = i;
    const Seg sg = P.seg[si];
    const int lt = t - sg.tile0;
    const int ncb = sg.ncols >> 5;
    const int kb = lt / ncb, nb = lt - kb * ncb;
    const int k0 = kb * 64, n0 = nb * 32;
    __syncthreads();
    {
      const int n = tid & 31;
#pragma unroll
      for (int i = 0; i < 4; ++i) {
        const int k = (tid >> 5) + 16 * i;
        float v = 0.f;
        if (sg.src) {
          v = sg.src[(size_t)(k0 + k) * sg.src_ld + n0 + n];
          if (sg.gain) v *= sg.gain[k0 + k];
        }
        tl[k * 33 + n] = v;
      }
    }
    __syncthreads();
    {
      const int kk4 = (tid & 15) * 4, n = tid >> 4;
      const float w0 = tl[(kk4 + 0) * 33 + n], w1 = tl[(kk4 + 1) * 33 + n], w2 = tl[(kk4 + 2) * 33 + n], w3 = tl[(kk4 + 3) * 33 + n];
      if (sg.fp8) {
        *(unsigned*)((unsigned char*)sg.dst + (size_t)(n0 + n) * sg.K + k0 + kk4) = pack4_fp8c(w0 * 64.f, w1 * 64.f, w2 * 64.f, w3 * 64.f);
      } else {
        uint2 o2;
        o2.x = pack2(w0, w1);
        o2.y = pack2(w2, w3);
        *(uint2*)(sg.dst + (size_t)(n0 + n) * sg.K + k0 + kk4) = o2;
      }
    }
  }
  {
    char* ws = uniform_ptr(P.ws);
    bf16_t* hb = (bf16_t*)(ws + OFF_HB);
    float* ssq = (float*)(ws + OFF_SSQH);
    const int w = tid >> 6, lane = tid & 63;
    for (int row = blockIdx.x * 8 + w; row < T; row += gridDim.x * 8) {
      const float4* xr = (const float4*)(P.x + (size_t)row * DM);
      float s = 0.f;
#pragma unroll
      for (int i = 0; i < 4; ++i) {
        float4 v = xr[lane + 64 * i];
        s += v.x * v.x + v.y * v.y + v.z * v.z + v.w * v.w;
        uint2 o;
        o.x = pack2(v.x, v.y);
        o.y = pack2(v.z, v.w);
        *(uint2*)(hb + (size_t)row * DM + (lane + 64 * i) * 4) = o;
      }
#pragma unroll
      for (int o = 32; o >= 1; o >>= 1) s += __shfl_xor(s, o);
      if (lane < 8) ssq[(size_t)row * 8 + lane] = (lane == 0) ? s : 0.f;
    }
  }
  {
    bf16_t* pb = (bf16_t*)(uniform_ptr(P.ws) + OFF_PB);
    const size_t n8 = (size_t)4 * T * PLE / 8;
    for (size_t e = (size_t)blockIdx.x * NTHREADS + tid; e < n8; e += (size_t)gridDim.x * NTHREADS) {
      const float4 v0 = ((const float4*)P.p)[2 * e], v1 = ((const float4*)P.p)[2 * e + 1];
      uint4 o;
      o.x = pack2(v0.x, v0.y);
      o.y = pack2(v0.z, v0.w);
      o.z = pack2(v1.x, v1.y);
      o.w = pack2(v1.z, v1.w);
      ((uint4*)pb)[e] = o;
    }
  }
  {
    float* rt = (float*)(uniform_ptr(P.ws) + OFF_ROPE);
    for (int e = blockIdx.x * NTHREADS + tid; e < S * 16; e += gridDim.x * NTHREADS) {
      const int s = e >> 4, i = e & 15;
      const double inv = exp2(-(double)i * (13.287712379549449 / 16.0));
      const double rev = (double)s * inv * 0.15915494309189535;
      const float fr = (float)(rev - floor(rev));
      rt[s * 32 + i] = __builtin_amdgcn_cosf(fr);
      rt[s * 32 + 16 + i] = __builtin_amdgcn_sinf(fr);
    }
  }
}

typedef __attribute__((ext_vector_type(4))) float f32x4;
constexpr int GBK = 64, GKS = 2;
constexpr int GTILE_B = 256 * GBK * 2;
constexpr int GSTAGE_B = 2 * GTILE_B;
constexpr int LDS_BYTES = 2 * GSTAGE_B;

DI int lds_byte(int r, int c) {
  int st = (r >> 4) * GKS + (c >> 5), ob = (r & 15) * 64 + (c & 31) * 2;
  return st * 1024 + (ob ^ (((ob >> 9) & 1) << 5));
}
DI void stage_rc(int b, int& R, int& C) {
  int st = b >> 10, sb = b & 1023, swz = sb ^ (((sb >> 9) & 1) << 5);
  R = (st / GKS) * 16 + swz / 64;
  C = (st % GKS) * 32 + (swz % 64) / 2;
}
#define WAIT_V0() asm volatile("s_waitcnt vmcnt(0)" ::: "memory")

DI void gemm_core(f32x4 (&acc)[8][4], const bf16_t* Wb, const bf16_t* Xb, int K, char* shm) {
  const int tid = get_tid();
  const int wid = tid >> 6, lane = tid & 63, wr = wid >> 2, wc = wid & 3, fr = lane & 15, fq = lane >> 4;
  int sR[4], sC[4];
#pragma unroll
  for (int i = 0; i < 4; ++i) stage_rc(wid * 1024 + i * 8192 + lane * 16, sR[i], sC[i]);
  const int nt = K / GBK;
#define GSRC(base, i, kt) ((base) + (size_t)sR[i] * K + (kt) * GBK + sC[i])
#define GLDS_STAGE(buf, kt)                                                                                           \
  do {                                                                                                                \
    _Pragma("unroll") for (int i = 0; i < 4; ++i) {                                                                   \
      __builtin_amdgcn_global_load_lds((const unsigned*)GSRC(Wb, i, kt),                                             \
                                       (unsigned*)(shm + (buf) * GSTAGE_B + wid * 1024 + i * 8192), 16, 0, 0);        \
      __builtin_amdgcn_global_load_lds((const unsigned*)GSRC(Xb, i, kt),                                             \
                                       (unsigned*)(shm + (buf) * GSTAGE_B + GTILE_B + wid * 1024 + i * 8192), 16, 0, 0); \
    }                                                                                                                 \
  } while (0)
  __syncthreads();
  GLDS_STAGE(0, 0);
  WAIT_V0();
  __syncthreads();
#pragma unroll 1
  for (int t = 0; t < nt; ++t) {
    const int cur = t & 1;
    if (t + 1 < nt) GLDS_STAGE(cur ^ 1, t + 1);
    const char* sa = shm + cur * GSTAGE_B;
    const char* sb = sa + GTILE_B;
#pragma unroll
    for (int ks = 0; ks < GKS; ++ks) {
      bf16x8 At[8], Bf[4];
#pragma unroll
      for (int m = 0; m < 8; ++m) At[m] = *(const bf16x8*)(sa + lds_byte(wr * 128 + m * 16 + fr, ks * 32 + fq * 8));
#pragma unroll
      for (int n = 0; n < 4; ++n) Bf[n] = *(const bf16x8*)(sb + lds_byte(wc * 64 + n * 16 + fr, ks * 32 + fq * 8));
#pragma unroll
      for (int m = 0; m < 8; ++m)
#pragma unroll
        for (int n = 0; n < 4; ++n) acc[m][n] = __builtin_amdgcn_mfma_f32_16x16x32_bf16(At[m], Bf[n], acc[m][n], 0, 0, 0);
      __builtin_amdgcn_sched_barrier(0);
    }
    WAIT_V0();
    __syncthreads();
  }
#undef GSRC
#undef GLDS_STAGE
}

typedef __attribute__((ext_vector_type(8))) int i32x8g;
DI i32x8g ld32g(const char* p0, const char* p1) {
  const uint4 a = *(const uint4*)p0, b = *(const uint4*)p1;
  i32x8g r = {(int)a.x, (int)a.y, (int)a.z, (int)a.w, (int)b.x, (int)b.y, (int)b.z, (int)b.w};
  return r;
}
DI void gemm_core8(f32x4 (&acc)[8][4], const unsigned char* Wb, const unsigned char* Xb, int K, char* shm, int sw, int sx) {
  const int tid = get_tid();
  const int wid = tid >> 6, lane = tid & 63, wr = wid >> 2, wc = wid & 3, fr = lane & 15, fq = lane >> 4;
  int sR[4], sC[4];
#pragma unroll
  for (int i = 0; i < 4; ++i) stage_rc(wid * 1024 + i * 8192 + lane * 16, sR[i], sC[i]);
  const int nt = K / 128;
#define GSRC8(base, i, kt) ((base) + (size_t)sR[i] * K + (kt) * 128 + sC[i] * 2)
#define GLDS_STAGE8(buf, kt)                                                                                          \
  do {                                                                                                                \
    _Pragma("unroll") for (int i = 0; i < 4; ++i) {                                                                   \
      __builtin_amdgcn_global_load_lds((const unsigned*)GSRC8(Wb, i, kt),                                            \
                                       (unsigned*)(shm + (buf) * GSTAGE_B + wid * 1024 + i * 8192), 16, 0, 0);        \
      __builtin_amdgcn_global_load_lds((const unsigned*)GSRC8(Xb, i, kt),                                            \
                                       (unsigned*)(shm + (buf) * GSTAGE_B + GTILE_B + wid * 1024 + i * 8192), 16, 0, 0); \
    }                                                                                                                 \
  } while (0)
  __syncthreads();
  GLDS_STAGE8(0, 0);
  WAIT_V0();
  __syncthreads();
#pragma unroll 1
  for (int t = 0; t < nt; ++t) {
    const int cur = t & 1;
    if (t + 1 < nt) GLDS_STAGE8(cur ^ 1, t + 1);
    const char* sa = shm + cur * GSTAGE_B;
    const char* sb = sa + GTILE_B;
    i32x8g Bf[4];
#pragma unroll
    for (int n = 0; n < 4; ++n)
      Bf[n] = ld32g(sb + lds_byte(wc * 64 + n * 16 + fr, fq * 8), sb + lds_byte(wc * 64 + n * 16 + fr, 32 + fq * 8));
#pragma unroll
    for (int mh = 0; mh < 2; ++mh) {
      i32x8g At[4];
#pragma unroll
      for (int m = 0; m < 4; ++m)
        At[m] = ld32g(sa + lds_byte(wr * 128 + (mh * 4 + m) * 16 + fr, fq * 8), sa + lds_byte(wr * 128 + (mh * 4 + m) * 16 + fr, 32 + fq * 8));
#pragma unroll
      for (int m = 0; m < 4; ++m)
#pragma unroll
        for (int n = 0; n < 4; ++n)
          acc[mh * 4 + m][n] = __builtin_amdgcn_mfma_scale_f32_16x16x128_f8f6f4(At[m], Bf[n], acc[mh * 4 + m][n], 0, 0, 0, sw, 0, sx);
    }
    __builtin_amdgcn_sched_barrier(0);
    WAIT_V0();
    __syncthreads();
  }
#undef GSRC8
#undef GLDS_STAGE8
}
constexpr int SC_ONE = 0x7f7f7f7f;
constexpr int SC_M6 = 0x79797979;
constexpr int SC_M4 = 0x7b7b7b7b;

DI float sum8(const float* p) {
  const float4* q = (const float4*)p;
  float4 a = q[0], b = q[1];
  return (a.x + a.y + a.z + a.w) + (b.x + b.y + b.z + b.w);
}
DI float quad_sum(float v) {
  v += __shfl_xor(v, 16);
  v += __shfl_xor(v, 32);
  return v;
}

DI unsigned pack4_fp8(float a, float b, float c, float d);
DI int perm64(int s);
enum { EPI_A_IN = 0, EPI_B_IN = 1, EPI_QKV_UP = 2, EPI_OUT = 3, EPI_PLE = 4 };

DI void store4bf(bf16_t* dst, float a, float b, float c, float d) {
  uint2 o;
  o.x = pack2(a, b);
  o.y = pack2(c, d);
  *(uint2*)dst = o;
}
DI void store_pair_bf(bf16_t* dst, int fq, float a0, float a1, float a2, float a3, float b0, float b1, float b2, float b3) {
  const unsigned ax = pack2(a0, a1), ay = pack2(a2, a3), bx = pack2(b0, b1), by = pack2(b2, b3);
  auto r0 = __builtin_amdgcn_permlane16_swap(ax, bx, false, false);
  auto r1 = __builtin_amdgcn_permlane16_swap(ay, by, false, false);
  *(uint4*)(dst + (fq & 1) * 16 + (fq >> 1) * 8) = make_uint4(r0[0], r1[0], r0[1], r1[1]);
}
DI void store_vt4(bf16_t* dst, float a, float b, float c, float d) {
  dst[0] = (bf16_t)f2bf(a);
  dst[S] = (bf16_t)f2bf(b);
  dst[2 * S] = (bf16_t)f2bf(c);
  dst[3 * S] = (bf16_t)f2bf(d);
}

template <int EPI>
DI void gemm_phase(const Params& P, int layer, char* lds) {
  const int tid = get_tid();
  const int wid = tid >> 6, lane = tid & 63, wr = wid >> 2, wc = wid & 3, fr = lane & 15, fq = lane >> 4;
  const int j = layer >> 1;
  char* ws = uniform_ptr(P.ws);
  bf16_t* wbase = (bf16_t*)(ws + OFF_W);
  bf16_t* hb = (bf16_t*)(ws + OFF_HB);
  bf16_t* og = (bf16_t*)(ws + OFF_HB);
  bf16_t* zb = (bf16_t*)(ws + OFF_Z);
  bf16_t* hmb = (bf16_t*)(ws + OFF_Z);
  bf16_t* qb = (bf16_t*)(ws + OFF_Q);
  bf16_t* eb = (bf16_t*)(ws + OFF_Q);
  bf16_t* kb = (bf16_t*)(ws + OFF_K);
  bf16_t* vt = (bf16_t*)(ws + OFF_VT);
  bf16_t* cqb = (bf16_t*)(ws + OFF_CQ);
  bf16_t* ckvb = (bf16_t*)(ws + OFF_CKV);
  bf16_t* krb = (bf16_t*)(ws + OFF_KR);
  const bf16_t* pbb = (const bf16_t*)(ws + OFF_PB);
  float* ssqh = (float*)(ws + OFF_SSQH);
  float* ssqm = (float*)(ws + OFF_SSQM);
  float* ssqc = (float*)(ws + OFF_SSQC);
  const float* rope = (const float*)(ws + OFF_ROPE);

  int NT, ntiles;
  if constexpr (EPI == EPI_A_IN) { NT = 10; ntiles = 128 * 10; }
  else if constexpr (EPI == EPI_B_IN) { NT = 7; ntiles = 128 * 7; }
  else if constexpr (EPI == EPI_QKV_UP) { NT = 14; ntiles = 128 * 14; }
  else if constexpr (EPI == EPI_OUT) { NT = 4; ntiles = 128 * 8; }
  else { NT = 4; ntiles = 128 * 4; }

  for (int tile = blockIdx.x; tile < ntiles; tile += gridDim.x) {
    int t2 = tile;
    bool second = false;
    if constexpr (EPI == EPI_OUT) {
      if (t2 >= 512) { second = true; t2 -= 512; }
    }
    int mt = t2 / NT, nt = t2 - mt * NT;
    if (gridDim.x == 256) {
      const int x = blockIdx.x & 7, s = blockIdx.x >> 3, k = t2 >> 8;
      const int idx = s + 32 * k;
      mt = (idx / NT) * 8 + x;
      nt = idx - (idx / NT) * NT;
    }
    const int m0 = mt * 256, n0 = nt * 256;
    f32x4 acc[8][4];
#pragma unroll
    for (int m = 0; m < 8; ++m)
#pragma unroll
      for (int n = 0; n < 4; ++n) acc[m][n] = f32x4{0.f, 0.f, 0.f, 0.f};

    if constexpr (EPI == EPI_A_IN) {
      gemm_core(acc, wbase + W_A_IN + (size_t)j * 2560 * 1024 + (size_t)n0 * 1024, hb + (size_t)m0 * 1024, 1024, lds);
      const float qs = 0.125f * LOG2E;
#pragma unroll
      for (int n = 0; n < 4; ++n) {
        const int tok = m0 + wc * 64 + n * 16 + fr;
        const float rstd = rsqrtf(sum8(ssqh + (size_t)tok * 8) * (1.f / 1024.f) + EPS);
        const int b = tok >> 13, s = tok & (S - 1);
        if (nt == 5) {
#pragma unroll
          for (int m = 0; m < 8; ++m) {
            const int f = n0 + wr * 128 + m * 16 + fq * 4;
            store_vt4(vt + ((size_t)(b * 4) * 64 + (f - 1280)) * S + perm16(s), acc[m][n][0] * rstd, acc[m][n][1] * rstd,
                      acc[m][n][2] * rstd, acc[m][n][3] * rstd);
          }
        } else {
          const float sc_ = (nt < 4) ? rstd * qs : rstd;
          const int fg = n0 + wr * 128;
          bf16_t* rowp = (nt < 4) ? (qb + (size_t)tok * 1024 + fg) : (nt == 4) ? (kb + (size_t)tok * 256 + (fg - 1024))
                                                                              : (zb + (size_t)tok * 1024 + (fg - 1536));
#pragma unroll
          for (int m = 0; m < 8; m += 2)
            store_pair_bf(rowp + m * 16, fq, acc[m][n][0] * sc_, acc[m][n][1] * sc_, acc[m][n][2] * sc_, acc[m][n][3] * sc_,
                          acc[m + 1][n][0] * sc_, acc[m + 1][n][1] * sc_, acc[m + 1][n][2] * sc_, acc[m + 1][n][3] * sc_);
        }
      }
    } else if constexpr (EPI == EPI_B_IN) {
      gemm_core8(acc, (const unsigned char*)(wbase + W_B_IN + (size_t)j * 1792 * 1024) + (size_t)n0 * 1024, (const unsigned char*)hb + (size_t)m0 * 1024, 1024, lds, SC_M6, SC_ONE);
      const int fbase = n0 + wr * 128;
#pragma unroll
      for (int n = 0; n < 4; ++n) {
        const int tok = m0 + wc * 64 + n * 16 + fr;
        const float rstd = rsqrtf(sum8(ssqh + (size_t)tok * 8) * (1.f / 1024.f) + EPS);
        const int s = tok & (S - 1);
        if (fbase < 1024) {
#pragma unroll
          for (int m = 0; m < 8; m += 2)
            store_pair_bf(zb + (size_t)tok * 1024 + fbase + m * 16, fq, acc[m][n][0] * rstd, acc[m][n][1] * rstd, acc[m][n][2] * rstd,
                          acc[m][n][3] * rstd, acc[m + 1][n][0] * rstd, acc[m + 1][n][1] * rstd, acc[m + 1][n][2] * rstd,
                          acc[m + 1][n][3] * rstd);
        } else if (fbase < 1664) {
          float sq = 0.f;
          const bool iscq = fbase < 1408;
#pragma unroll
          for (int m = 0; m < 8; ++m) {
            const float v0 = acc[m][n][0] * rstd, v1 = acc[m][n][1] * rstd, v2 = acc[m][n][2] * rstd, v3 = acc[m][n][3] * rstd;
            sq += v0 * v0 + v1 * v1 + v2 * v2 + v3 * v3;
            const int f = fbase + m * 16 + fq * 4;
            if (iscq) *(unsigned*)((unsigned char*)cqb + (size_t)tok * 384 + (f - 1024)) = pack4_fp8c(v0, v1, v2, v3);
            else *(unsigned*)((unsigned char*)ckvb + (size_t)tok * 256 + (f - 1408)) = pack4_fp8c(v0, v1, v2, v3);
          }
          sq = quad_sum(sq);
          if (fq == 0) {
            const int pi = iscq ? ((fbase - 1024) >> 7) : (4 + ((fbase - 1408) >> 7));
            ssqc[(size_t)tok * 8 + pi] = sq;
          }
        } else {
          const float4 cs = *(const float4*)(rope + s * 32 + fq * 4);
          const float4 sn = *(const float4*)(rope + s * 32 + 16 + fq * 4);
          const float x10 = acc[0][n][0] * rstd, x11 = acc[0][n][1] * rstd, x12 = acc[0][n][2] * rstd, x13 = acc[0][n][3] * rstd;
          const float x20 = acc[1][n][0] * rstd, x21 = acc[1][n][1] * rstd, x22 = acc[1][n][2] * rstd, x23 = acc[1][n][3] * rstd;
          unsigned char* kr8 = (unsigned char*)krb;
          *(unsigned*)(kr8 + (size_t)tok * 32 + fq * 4) =
              pack4_fp8c(x10 * cs.x - x20 * sn.x, x11 * cs.y - x21 * sn.y, x12 * cs.z - x22 * sn.z, x13 * cs.w - x23 * sn.w);
          *(unsigned*)(kr8 + (size_t)tok * 32 + 16 + fq * 4) =
              pack4_fp8c(x10 * sn.x + x20 * cs.x, x11 * sn.y + x21 * cs.y, x12 * sn.z + x22 * cs.z, x13 * sn.w + x23 * cs.w);
        }
      }
    } else if constexpr (EPI == EPI_QKV_UP) {
      if (nt < 6) {
        gemm_core8(acc, (const unsigned char*)(wbase + W_B_QB + (size_t)j * 1536 * 384) + (size_t)n0 * 384, (const unsigned char*)cqb + (size_t)m0 * 384, 384, lds, SC_M6, SC_ONE);
        const float qs = 0.10206207261596575f * LOG2E;
#pragma unroll
        for (int n = 0; n < 4; ++n) {
          const int tok = m0 + wc * 64 + n * 16 + fr;
          const float* pc = ssqc + (size_t)tok * 8;
          const float rstd = rsqrtf((pc[0] + pc[1] + pc[2]) * (1.f / 384.f) + EPS) * qs;
          const int s = tok & (S - 1);
          const float4 cs = *(const float4*)(rope + s * 32 + fq * 4);
          const float4 sn = *(const float4*)(rope + s * 32 + 16 + fq * 4);
#pragma unroll
          for (int mp = 0; mp < 4; ++mp) {
            const int fb = n0 + wr * 128 + mp * 32;
            const int cb = fb >> 5;
            unsigned char* dst = (unsigned char*)qb + (size_t)tok * 1536 + fb + fq * 4;
            const float x10 = acc[2 * mp][n][0] * rstd, x11 = acc[2 * mp][n][1] * rstd, x12 = acc[2 * mp][n][2] * rstd,
                        x13 = acc[2 * mp][n][3] * rstd;
            const float x20 = acc[2 * mp + 1][n][0] * rstd, x21 = acc[2 * mp + 1][n][1] * rstd, x22 = acc[2 * mp + 1][n][2] * rstd,
                        x23 = acc[2 * mp + 1][n][3] * rstd;
            if ((cb % 3) == 2) {
              *(unsigned*)dst = pack4_fp8c(x10 * cs.x - x20 * sn.x, x11 * cs.y - x21 * sn.y, x12 * cs.z - x22 * sn.z, x13 * cs.w - x23 * sn.w);
              *(unsigned*)(dst + 16) = pack4_fp8c(x10 * sn.x + x20 * cs.x, x11 * sn.y + x21 * cs.y, x12 * sn.z + x22 * cs.z, x13 * sn.w + x23 * cs.w);
            } else {
              *(unsigned*)dst = pack4_fp8c(x10, x11, x12, x13);
              *(unsigned*)(dst + 16) = pack4_fp8c(x20, x21, x22, x23);
            }
          }
        }
      } else {
        const int n0k = (nt - 6) * 256;
        gemm_core8(acc, (const unsigned char*)(wbase + W_B_KVB + (size_t)j * 2048 * 256) + (size_t)n0k * 256, (const unsigned char*)ckvb + (size_t)m0 * 256, 256, lds, SC_M6, SC_ONE);
        const int hd = (nt - 6) * 2 + wr;
#pragma unroll
        for (int n = 0; n < 4; ++n) {
          const int tok = m0 + wc * 64 + n * 16 + fr;
          const float* pc = ssqc + (size_t)tok * 8 + 4;
          const float rstd = rsqrtf((pc[0] + pc[1]) * (1.f / 256.f) + EPS);
          const int b = tok >> 13, s = tok & (S - 1);
#pragma unroll
          for (int m = 0; m < 8; ++m) {
            const float v0 = acc[m][n][0] * rstd, v1 = acc[m][n][1] * rstd, v2 = acc[m][n][2] * rstd, v3 = acc[m][n][3] * rstd;
            if (m < 4) {
              *(unsigned*)((unsigned char*)kb + (size_t)tok * 1024 + hd * 64 + m * 16 + fq * 4) = pack4_fp8c(v0, v1, v2, v3);
            } else {
              const float p0 = __shfl_xor(v0, 1), p1 = __shfl_xor(v1, 1), p2 = __shfl_xor(v2, 1), p3 = __shfl_xor(v3, 1);
              const bool odd = fr & 1;
              const float a0 = odd ? p2 : v0, b0 = odd ? v2 : p0;
              const float a1 = odd ? p3 : v1, b1 = odd ? v3 : p1;
              const int d = (m - 4) * 16 + fq * 4 + (odd ? 2 : 0);
              unsigned char* dst = (unsigned char*)vt + ((size_t)(b * 16 + hd) * 64 + d) * S + perm64(s & ~1);
              *(unsigned short*)dst = (unsigned short)(__builtin_amdgcn_cvt_pk_fp8_f32(clamp8(a0), clamp8(b0), 0, false) & 0xffff);
              *(unsigned short*)(dst + S) = (unsigned short)(__builtin_amdgcn_cvt_pk_fp8_f32(clamp8(a1), clamp8(b1), 0, false) & 0xffff);
            }
          }
        }
      }
    } else if constexpr (EPI == EPI_OUT) {
      if (!second) {
        if (layer & 1) {
          const unsigned char* wt = (const unsigned char*)(wbase + W_B_OUT + (size_t)j * 1024 * 1024);
          gemm_core8(acc, wt + (size_t)n0 * 1024, (const unsigned char*)og + (size_t)m0 * 1024, 1024, lds, SC_M6, SC_M4);
        } else {
          gemm_core(acc, wbase + W_A_OUT + (size_t)j * 1024 * 1024 + (size_t)n0 * 1024, og + (size_t)m0 * 1024, 1024, lds);
        }
        float* outp = uniform_ptr(P.out);
        const float* resid = (layer == 0) ? uniform_ptr(P.x) : outp;
#pragma unroll
        for (int n = 0; n < 4; ++n) {
          const int tok = m0 + wc * 64 + n * 16 + fr;
          float sq = 0.f;
          f32x4 rr[8];
#pragma unroll
          for (int m = 0; m < 8; ++m) rr[m] = *(const f32x4*)(resid + (size_t)tok * DM + n0 + wr * 128 + m * 16 + fq * 4);
          asm volatile("" : "+v"(rr[0]), "+v"(rr[1]), "+v"(rr[2]), "+v"(rr[3]), "+v"(rr[4]), "+v"(rr[5]), "+v"(rr[6]), "+v"(rr[7]));
#pragma unroll
          for (int m = 0; m < 8; m += 2) {
            const int f = n0 + wr * 128 + m * 16 + fq * 4;
            float4 rv = make_float4(rr[m][0], rr[m][1], rr[m][2], rr[m][3]);
            float4 rw = make_float4(rr[m + 1][0], rr[m + 1][1], rr[m + 1][2], rr[m + 1][3]);
            rv.x += acc[m][n][0];
            rv.y += acc[m][n][1];
            rv.z += acc[m][n][2];
            rv.w += acc[m][n][3];
            rw.x += acc[m + 1][n][0];
            rw.y += acc[m + 1][n][1];
            rw.z += acc[m + 1][n][2];
            rw.w += acc[m + 1][n][3];
            sq += rv.x * rv.x + rv.y * rv.y + rv.z * rv.z + rv.w * rv.w;
            sq += rw.x * rw.x + rw.y * rw.y + rw.z * rw.z + rw.w * rw.w;
            *(float4*)(outp + (size_t)tok * DM + f) = rv;
            *(float4*)(outp + (size_t)tok * DM + f + 16) = rw;
            store_pair_bf(hmb + (size_t)tok * DM + n0 + wr * 128 + m * 16, fq, rv.x, rv.y, rv.z, rv.w, rw.x, rw.y, rw.z, rw.w);
          }
          sq = quad_sum(sq);
          if (fq == 0) ssqm[(size_t)tok * 8 + nt * 2 + wr] = sq;
        }
      } else {
        gemm_core(acc, wbase + W_PLE + (size_t)layer * 1024 * 256 + (size_t)n0 * 256, pbb + ((size_t)layer * T + m0) * 256, 256, lds);
#pragma unroll
        for (int n = 0; n < 4; ++n) {
          const int tok = m0 + wc * 64 + n * 16 + fr;
#pragma unroll
          for (int m = 0; m < 8; m += 2)
            store_pair_bf(eb + (size_t)tok * DM + n0 + wr * 128 + m * 16, fq, acc[m][n][0], acc[m][n][1], acc[m][n][2], acc[m][n][3],
                          acc[m + 1][n][0], acc[m + 1][n][1], acc[m + 1][n][2], acc[m + 1][n][3]);
        }
      }
    } else {
      gemm_core(acc, wbase + W_GATE + (size_t)layer * 1024 * 1024 + (size_t)n0 * 1024, hmb + (size_t)m0 * 1024, 1024, lds);
      float* outp = uniform_ptr(P.out);
#pragma unroll
      for (int n = 0; n < 4; ++n) {
        const int tok = m0 + wc * 64 + n * 16 + fr;
        const float rstd = rsqrtf(sum8(ssqm + (size_t)tok * 8) * (1.f / 1024.f) + EPS);
        float sq = 0.f;
        f32x4 hh[8];
        uint2 e8[8];
#pragma unroll
        for (int m = 0; m < 8; ++m) {
          const int f = n0 + wr * 128 + m * 16 + fq * 4;
          hh[m] = *(const f32x4*)(outp + (size_t)tok * DM + f);
          e8[m] = *(const uint2*)(eb + (size_t)tok * DM + f);
        }
        asm volatile("" : "+v"(hh[0]), "+v"(hh[1]), "+v"(hh[2]), "+v"(hh[3]), "+v"(hh[4]), "+v"(hh[5]), "+v"(hh[6]), "+v"(hh[7]));
#pragma unroll
        for (int m = 0; m < 8; ++m) {
          const int f = n0 + wr * 128 + m * 16 + fq * 4;
          float4 hv = make_float4(hh[m][0], hh[m][1], hh[m][2], hh[m][3]);
          const uint2 ee = e8[m];
          hv.x += bf2f(ee.x & 0xffffu) / (1.f + __expf(-acc[m][n][0] * rstd));
          hv.y += bf2f(ee.x >> 16) / (1.f + __expf(-acc[m][n][1] * rstd));
          hv.z += bf2f(ee.y & 0xffffu) / (1.f + __expf(-acc[m][n][2] * rstd));
          hv.w += bf2f(ee.y >> 16) / (1.f + __expf(-acc[m][n][3] * rstd));
          sq += hv.x * hv.x + hv.y * hv.y + hv.z * hv.z + hv.w * hv.w;
          *(float4*)(outp + (size_t)tok * DM + f) = hv;
          if ((layer & 1) == 0) *(unsigned*)((unsigned char*)hb + (size_t)tok * DM + f) = pack4_fp8c(hv.x, hv.y, hv.z, hv.w);
          else if (layer != 3) store4bf(hb + (size_t)tok * DM + f, hv.x, hv.y, hv.z, hv.w);
        }
        sq = quad_sum(sq);
        if (fq == 0) ssqh[(size_t)tok * 8 + nt * 2 + wr] = sq;
      }
    }
  }
}

template <bool MLA>
DI void attn_phase(const Params& P, int layer, char* lds) {
  constexpr int DQK = MLA ? 96 : 64;
  constexpr int KSTR = DQK * 2 + 16;
  constexpr int VSTR = 144;
  constexpr int KBYTES = 64 * KSTR;
  constexpr int ASTAGE = KBYTES + 64 * VSTR;
  constexpr int NKS = DQK / 16;
  const int tid = get_tid();
  const int lane = tid & 63, w = tid >> 6;
  const int r = lane & 31, h = lane >> 5;
  char* ws = uniform_ptr(P.ws);
  const bf16_t* qg = (const bf16_t*)(ws + OFF_Q);
  const bf16_t* kg = (const bf16_t*)(ws + OFF_K);
  const bf16_t* vtg = (const bf16_t*)(ws + OFF_VT);
  const bf16_t* krg = (const bf16_t*)(ws + OFF_KR);
  const bf16_t* zg = (const bf16_t*)(ws + OFF_Z);
  bf16_t* og = (bf16_t*)(ws + OFF_HB);
  const int j = layer >> 1;

  const int nitems = 2048;
  for (int item = blockIdx.x; item < nitems; item += gridDim.x) {
    int b, head, hkv, q0, t_lo, t_hi;
    int nheads_kv;
    if constexpr (MLA) {
      const int xcd = item & 7, slot = (item >> 3) & 31, grp = item >> 8;
      const int bh = grp * 8 + xcd;
      b = bh >> 4;
      head = bh & 15;
      hkv = head;
      nheads_kv = 16;
      q0 = slot * 256 + w * 32;
      t_lo = 0;
      t_hi = S / 64;
    } else {
      const int hp = item & 7, qblk = (item >> 3) & 63;
      b = item >> 9;
      head = hp * 2 + (w >> 2);
      hkv = hp >> 1;
      nheads_kv = 4;
      const int t0 = qblk * 128;
      q0 = t0 + (w & 3) * 32;
      const int lo = (t0 - 128 > 0) ? (t0 - 128) : 0;
      const int hi = (t0 + 256 < S) ? (t0 + 256) : S;
      t_lo = lo >> 6;
      t_hi = hi >> 6;
    }
    const int qld = MLA ? 1536 : 1024;
    const int tokq = b * S + q0 + r;
    bf16x8 qf[NKS];
#pragma unroll
    for (int ks = 0; ks < NKS; ++ks)
      qf[ks] = *(const bf16x8*)(qg + (size_t)tokq * qld + head * DQK + ks * 16 + 8 * h);

    float m_run, l_run;
    float slope2 = 0.f;
    if constexpr (MLA) {
      m_run = 0.f;
      l_run = 0.f;
    } else {
      m_run = P.a_sink[j * 16 + head] * LOG2E;
      l_run = (h == 0) ? 1.f : 0.f;
      slope2 = exp2f(-0.5f * (float)(head + 1)) * LOG2E;
    }
    f32x16 o[2], negm;
#pragma unroll
    for (int i = 0; i < 16; ++i) { o[0][i] = 0.f; o[1][i] = 0.f; negm[i] = -m_run; }

    const int lrow = tid >> 3, lc = tid & 7;
    uint4 kreg, vreg, rreg;
    auto load_regs = [&](int t) {
      const int kbase = t * 64;
      if constexpr (MLA) {
        kreg = *(const uint4*)(kg + (size_t)(b * S + kbase + lrow) * 1024 + head * 64 + lc * 8);
        if (tid < 256) rreg = *(const uint4*)(krg + (size_t)(b * S + kbase + (tid >> 2)) * 32 + (tid & 3) * 8);
      } else {
        kreg = *(const uint4*)(kg + (size_t)(b * S + kbase + lrow) * 256 + hkv * 64 + lc * 8);
      }
      vreg = *(const uint4*)(vtg + ((size_t)(b * nheads_kv + hkv) * 64 + lrow) * S + kbase + lc * 8);
    };
    auto write_lds = [&](int st) {
      char* base = lds + st * ASTAGE;
      *(uint4*)(base + lrow * KSTR + lc * 16) = kreg;
      if constexpr (MLA) {
        if (tid < 256) *(uint4*)(base + (tid >> 2) * KSTR + 128 + (tid & 3) * 16) = rreg;
      }
      *(uint4*)(base + KBYTES + lrow * VSTR + lc * 16) = vreg;
    };

    __syncthreads();
    load_regs(t_lo);
    write_lds(0);
    __syncthreads();
#pragma unroll 1
    for (int t = t_lo; t < t_hi; ++t) {
      load_regs((t + 1 < t_hi) ? (t + 1) : t);
      const char* base = lds + ((t - t_lo) & 1) * ASTAGE;
      const int kbase = t * 64;
      bool active = true;
      if constexpr (!MLA) active = (kbase + 63 >= q0 - 128) && (kbase <= q0 + 159);
      if (active) {
        f32x16 sc[2];
        {
          bf16x8 kf[2][NKS];
#pragma unroll
          for (int kb = 0; kb < 2; ++kb)
#pragma unroll
            for (int ks = 0; ks < NKS; ++ks) kf[kb][ks] = *(const bf16x8*)(base + (kb * 32 + r) * KSTR + h * 16 + ks * 32);
#pragma unroll
          for (int kb = 0; kb < 2; ++kb) {
            sc[kb] = MFMA(kf[kb][0], qf[0], negm);
#pragma unroll
            for (int ks = 1; ks < NKS; ++ks) sc[kb] = MFMA(kf[kb][ks], qf[ks], sc[kb]);
          }
        }
        if constexpr (!MLA) {
          const int tq = q0 + r;
#pragma unroll
          for (int kb = 0; kb < 2; ++kb)
#pragma unroll
            for (int i = 0; i < 16; ++i) {
              const int kp = kbase + kb * 32 + crow(i, h);
              int d = kp - tq;
              d = d < 0 ? -d : d;
              sc[kb][i] = (d <= 128) ? (sc[kb][i] - slope2 * (float)d) : -1e30f;
            }
        }
        int imx = max(__float_as_int(sc[0][0]), __float_as_int(sc[1][0]));
#pragma unroll
        for (int i = 1; i < 16; ++i) imx = max(imx, max(__float_as_int(sc[0][i]), __float_as_int(sc[1][i])));
        bool slow = __any(imx > 0x41000000);
        if constexpr (MLA) slow = slow || (t == t_lo);
        if (slow) {
          float mx = fmaxf(sc[0][0], sc[1][0]);
#pragma unroll
          for (int i = 1; i < 16; ++i) mx = fmaxf(mx, fmaxf(sc[0][i], sc[1][i]));
          mx = xhalf_max(mx);
          float delta = fmaxf(mx, 0.f);
          if constexpr (MLA) { if (t == t_lo) delta = mx; }
          float alpha = __builtin_amdgcn_exp2f(-delta);
          if constexpr (MLA) { if (t == t_lo) alpha = 1.f; }
          m_run += delta;
          l_run *= alpha;
#pragma unroll
          for (int i = 0; i < 16; ++i) {
            o[0][i] *= alpha;
            o[1][i] *= alpha;
            sc[0][i] -= delta;
            sc[1][i] -= delta;
            negm[i] = -m_run;
          }
        }
        f32x2_t ps2 = {0.f, 0.f};
        bf16x8 pf[2][2];
#pragma unroll
        for (int kb = 0; kb < 2; ++kb) {
#pragma unroll
          for (int i = 0; i < 16; i += 2) {
            const float p0 = __builtin_amdgcn_exp2f(sc[kb][i]);
            const float p1 = __builtin_amdgcn_exp2f(sc[kb][i + 1]);
            sc[kb][i] = p0;
            sc[kb][i + 1] = p1;
            ps2 += f32x2_t{p0, p1};
          }
#pragma unroll
          for (int sidx = 0; sidx < 2; ++sidx) {
            uint4 u;
            u.x = pack2(sc[kb][8 * sidx + 0], sc[kb][8 * sidx + 1]);
            u.y = pack2(sc[kb][8 * sidx + 2], sc[kb][8 * sidx + 3]);
            u.z = pack2(sc[kb][8 * sidx + 4], sc[kb][8 * sidx + 5]);
            u.w = pack2(sc[kb][8 * sidx + 6], sc[kb][8 * sidx + 7]);
            pf[kb][sidx] = __builtin_bit_cast(bf16x8, u);
          }
        }
        l_run += ps2[0] + ps2[1];
#pragma unroll
        for (int db = 0; db < 2; ++db) {
          const char* lv = base + KBYTES + (db * 32 + r) * VSTR + h * 16;
#pragma unroll
          for (int kb = 0; kb < 2; ++kb)
#pragma unroll
            for (int sidx = 0; sidx < 2; ++sidx) {
              bf16x8 vf = *(const bf16x8*)(lv + kb * 64 + sidx * 32);
              o[db] = MFMA(vf, pf[kb][sidx], o[db]);
            }
        }
      }
      write_lds((t + 1 - t_lo) & 1);
      __syncthreads();
    }
    const float l_tot = l_run + __shfl_xor(l_run, 32);
    const float inv = 1.f / l_tot;
#pragma unroll
    for (int db = 0; db < 2; ++db)
#pragma unroll
      for (int g = 0; g < 4; ++g) {
        const int d = db * 32 + 8 * g + 4 * h;
        const size_t off = (size_t)tokq * 1024 + head * 64 + d;
        const uint2 zz = *(const uint2*)(zg + off);
        const float z0 = bf2f(zz.x & 0xffffu), z1 = bf2f(zz.x >> 16), z2 = bf2f(zz.y & 0xffffu), z3 = bf2f(zz.y >> 16);
        const float g0 = z0 / (1.f + __expf(-z0)), g1 = z1 / (1.f + __expf(-z1)), g2 = z2 / (1.f + __expf(-z2)),
                    g3 = z3 / (1.f + __expf(-z3));
        store4bf(og + off, o[db][4 * g] * inv * g0, o[db][4 * g + 1] * inv * g1, o[db][4 * g + 2] * inv * g2,
                 o[db][4 * g + 3] * inv * g3);
      }
  }
}

typedef __attribute__((ext_vector_type(8))) int i32x8;
#define MFMA8(a, b, c) __builtin_amdgcn_mfma_scale_f32_32x32x64_f8f6f4((a), (b), (c), 0, 0, 0, 0x7f7f7f7f, 0, 0x7f7f7f7f)
DI unsigned pack4_fp8(float a, float b, float c, float d) {
  int r = __builtin_amdgcn_cvt_pk_fp8_f32(a, b, 0, false);
  r = __builtin_amdgcn_cvt_pk_fp8_f32(c, d, r, true);
  return (unsigned)r;
}
DI float clamp8(float x) { return __builtin_amdgcn_fmed3f(x, -440.f, 440.f); }
DI unsigned pack4_fp8c(float a, float b, float c, float d) { return pack4_fp8(clamp8(a), clamp8(b), clamp8(c), clamp8(d)); }
DI int perm64(int s) {
  const int c = (s >> 2) & 15;
  const int pc = ((c & 1) << 3) | (c >> 1);
  return (s & ~63) | (pc << 2) | (s & 3);
}
DI i32x8 ld32(const char* p) {
  const uint4 a = *(const uint4*)p, b = *(const uint4*)(p + 16);
  i32x8 r = {(int)a.x, (int)a.y, (int)a.z, (int)a.w, (int)b.x, (int)b.y, (int)b.z, (int)b.w};
  return r;
}

DI void attn_mla8_phase(const Params& P, char* lds) {
  constexpr int KSTR = 144;
  constexpr int VSTR = 80;
  constexpr int KBYTES = 64 * KSTR;
  constexpr int ASTAGE = KBYTES + 64 * VSTR;
  constexpr float PBIAS = 4.f;
  const int tid = get_tid();
  const int lane = tid & 63, w = tid >> 6;
  const int r = lane & 31, h = lane >> 5;
  char* ws = uniform_ptr(P.ws);
  const unsigned char* qg = (const unsigned char*)(ws + OFF_Q);
  const unsigned char* kg = (const unsigned char*)(ws + OFF_K);
  const unsigned char* vtg = (const unsigned char*)(ws + OFF_VT);
  const unsigned char* krg = (const unsigned char*)(ws + OFF_KR);
  const bf16_t* zg = (const bf16_t*)(ws + OFF_Z);
  bf16_t* og = (bf16_t*)(ws + OFF_HB);

  __syncthreads();
  if (tid < 384) {
    const int zr = tid >> 1, zs = tid >> 7;
    *(uint4*)(lds + zs * ASTAGE + (zr & 63) * KSTR + 96 + (tid & 1) * 16) = make_uint4(0u, 0u, 0u, 0u);
  }
  for (int item = blockIdx.x; item < 2048; item += gridDim.x) {
    const int xcd = item & 7, slot = (item >> 3) & 31, grp = item >> 8;
    const int bh = grp * 8 + xcd;
    const int b = bh >> 4, head = bh & 15;
    const int q0 = slot * 256 + w * 32;
    const int tokq = b * S + q0 + r;
    const unsigned char* qrow = qg + (size_t)tokq * 1536 + head * 96;
    const i32x8 qn = ld32((const char*)qrow + 32 * h);
    i32x8 qr = ld32((const char*)qrow + 64);
    if (h) qr = i32x8{0, 0, 0, 0, 0, 0, 0, 0};

    float m_run = 0.f, l_run = 0.f;
    f32x16 o[2], negm;
#pragma unroll
    for (int i = 0; i < 16; ++i) { o[0][i] = 0.f; o[1][i] = 0.f; negm[i] = PBIAS; }

    const int lrow = (tid & 255) >> 2, lc = tid & 3;
    const bool isk = tid < 256;
    const unsigned char* gmain = isk ? (kg + (size_t)(b * S + lrow) * 1024 + head * 64 + lc * 16)
                                     : (vtg + ((size_t)(b * 16 + head) * 64 + lrow) * S + lc * 16);
    const int gstep = isk ? 65536 : 64;
    const int lmain = isk ? (lrow * KSTR + lc * 16) : (KBYTES + lrow * VSTR + lc * 16);
    const int rrow = (tid & 127) >> 1, rc = tid & 1;
    const unsigned char* grope = krg + (size_t)(b * S + rrow) * 32 + rc * 16;
    const int lrope = rrow * KSTR + 64 + rc * 16;
    uint4 areg, rreg;
    const int trot = (slot * 4) & (S / 64 - 1);
#define MLA8_LOAD(t_)                                             \
  do {                                                            \
    const int tp_ = ((t_) + trot) & (S / 64 - 1);                 \
    areg = *(const uint4*)(gmain + (size_t)tp_ * gstep);          \
    rreg = *(const uint4*)(grope + (size_t)tp_ * 2048);           \
  } while (0)
#define MLA8_WRITE(st_)                                           \
  do {                                                            \
    char* wb_ = lds + (st_) * ASTAGE;                             \
    *(uint4*)(wb_ + lmain) = areg;                                \
    if (tid < 128) *(uint4*)(wb_ + lrope) = rreg;                 \
  } while (0)

    i32x8 kn[2], kr[2];
    __syncthreads();
    MLA8_LOAD(0);
    MLA8_WRITE(0);
    MLA8_LOAD(1);
    MLA8_WRITE(1);
    __syncthreads();
#pragma unroll
    for (int kb = 0; kb < 2; ++kb) {
      const char* lk = lds + (kb * 32 + r) * KSTR;
      kn[kb] = ld32(lk + 32 * h);
      kr[kb] = ld32(lk + 64 + 32 * h);
    }
    int st_cur = 0;
#pragma unroll 1
    for (int t = 0; t < S / 64; ++t) {
      MLA8_LOAD((t + 2 < S / 64) ? (t + 2) : (S / 64 - 1));
      const char* base = lds + st_cur * ASTAGE;
      const int st_nxt = (st_cur == 2) ? 0 : st_cur + 1;
      const int st_wr = (st_nxt == 2) ? 0 : st_nxt + 1;
      f32x16 sc[2];
      i32x8 vf[2];
      vf[0] = ld32(base + KBYTES + r * VSTR + 32 * h);
      vf[1] = ld32(base + KBYTES + (32 + r) * VSTR + 32 * h);
#pragma unroll
      for (int kb = 0; kb < 2; ++kb) {
        sc[kb] = MFMA8(kn[kb], qn, negm);
        sc[kb] = MFMA8(kr[kb], qr, sc[kb]);
      }
      int imx = max(__float_as_int(sc[0][0]), __float_as_int(sc[1][0]));
#pragma unroll
      for (int i = 1; i < 16; ++i) imx = max(imx, max(__float_as_int(sc[0][i]), __float_as_int(sc[1][i])));
      const bool slow = __any(imx > 0x41000000) || (t == 0);
      if (slow) {
        float mx = fmaxf(sc[0][0], sc[1][0]);
#pragma unroll
        for (int i = 1; i < 16; ++i) mx = fmaxf(mx, fmaxf(sc[0][i], sc[1][i]));
        mx = xhalf_max(mx);
        float delta = fmaxf(mx - PBIAS, 0.f);
        float alpha = __builtin_amdgcn_exp2f(-delta);
        if (t == 0) { delta = mx - PBIAS; alpha = 1.f; }
        m_run += delta;
        l_run *= alpha;
#pragma unroll
        for (int i = 0; i < 16; ++i) {
          o[0][i] *= alpha;
          o[1][i] *= alpha;
          sc[0][i] -= delta;
          sc[1][i] -= delta;
          negm[i] = PBIAS - m_run;
        }
      }
      f32x2_t ps2 = {0.f, 0.f};
      i32x8 pb;
#pragma unroll
      for (int kb = 0; kb < 2; ++kb) {
#pragma unroll
        for (int i = 0; i < 16; i += 2) {
          const f32x2_t tt = f32x2_t{sc[kb][i], sc[kb][i + 1]} * f32x2_t{8388608.f, 8388608.f} + f32x2_t{1065353216.f, 1065353216.f};
          const float p0 = __uint_as_float((unsigned)tt[0]);
          const float p1 = __uint_as_float((unsigned)tt[1]);
          sc[kb][i] = p0;
          sc[kb][i + 1] = p1;
          ps2 += f32x2_t{p0, p1};
        }
#pragma unroll
        for (int q4 = 0; q4 < 4; ++q4)
          pb[kb * 4 + q4] = (int)pack4_fp8(sc[kb][4 * q4], sc[kb][4 * q4 + 1], sc[kb][4 * q4 + 2], sc[kb][4 * q4 + 3]);
      }
      l_run += ps2[0] + ps2[1];
#pragma unroll
      for (int db = 0; db < 2; ++db) {
        o[db] = MFMA8(vf[db], pb, o[db]);
      }
      {
        const char* nb = lds + st_nxt * ASTAGE;
#pragma unroll
        for (int kb = 0; kb < 2; ++kb) {
          const char* lk = nb + (kb * 32 + r) * KSTR;
          kn[kb] = ld32(lk + 32 * h);
          kr[kb] = ld32(lk + 64 + 32 * h);
        }
      }
      MLA8_WRITE(st_wr);
      __syncthreads();
      st_cur = st_nxt;
    }
    const float l_tot = l_run + __shfl_xor(l_run, 32);
    const float inv = 1.f / l_tot;
#pragma unroll
    for (int db = 0; db < 2; ++db)
#pragma unroll
      for (int g = 0; g < 4; ++g) {
        const int d = db * 32 + 8 * g + 4 * h;
        const size_t off = (size_t)tokq * 1024 + head * 64 + d;
        const uint2 zz = *(const uint2*)(zg + off);
        const float z0 = bf2f(zz.x & 0xffffu), z1 = bf2f(zz.x >> 16), z2 = bf2f(zz.y & 0xffffu), z3 = bf2f(zz.y >> 16);
        const float g0 = z0 / (1.f + __expf(-z0)), g1 = z1 / (1.f + __expf(-z1)), g2 = z2 / (1.f + __expf(-z2)),
                    g3 = z3 / (1.f + __expf(-z3));
        const float i64 = inv * 16.f;
        *(unsigned*)((unsigned char*)og + off) = pack4_fp8c(o[db][4 * g] * i64 * g0, o[db][4 * g + 1] * i64 * g1, o[db][4 * g + 2] * i64 * g2,
                                                         o[db][4 * g + 3] * i64 * g3);
      }
  }
#undef MLA8_LOAD
#undef MLA8_WRITE
}

DI void final_phase(const Params& P) {
  const int tid = get_tid();
  const int w = tid >> 6, lane = tid & 63;
  for (int row = blockIdx.x * 8 + w; row < T; row += gridDim.x * 8) {
    float4* xr = (float4*)(P.out + (size_t)row * DM);
    float4 v[4];
    float s = 0.f;
#pragma unroll
    for (int i = 0; i < 4; ++i) {
      v[i] = xr[lane + 64 * i];
      s += v[i].x * v[i].x + v[i].y * v[i].y + v[i].z * v[i].z + v[i].w * v[i].w;
    }
#pragma unroll
    for (int o = 32; o >= 1; o >>= 1) s += __shfl_xor(s, o);
    const float rstd = rsqrtf(s * (1.f / 1024.f) + EPS);
#pragma unroll
    for (int i = 0; i < 4; ++i) {
      const float4 g = ((const float4*)P.final_g)[lane + 64 * i];
      xr[lane + 64 * i] = make_float4(v[i].x * rstd * g.x, v[i].y * rstd * g.y, v[i].z * rstd * g.z, v[i].w * rstd * g.w);
    }
  }
}

#define XB_TMO      128
#define XB_XCNT(j)  (256  + 64 * (j))
#define XB_XSUB(j)  (1280 + 64 * (j))
#define XB_XGEN(j)  (2304 + 64 * (j))
#define XB_TOP      3328
#define XB_TOPGEN   3392
#define XCD_BAR_WORDS 3456
#define XB_SPIN_CAP (1u << 22)
#define LAS __attribute__((address_space(3)))
DI unsigned xb_ld(unsigned* p) { return __hip_atomic_load(p, __ATOMIC_RELAXED, __HIP_MEMORY_SCOPE_AGENT); }
DI unsigned xb_add(unsigned* p, unsigned v) { return __hip_atomic_fetch_add(p, v, __ATOMIC_RELAXED, __HIP_MEMORY_SCOPE_AGENT); }
DI unsigned xb_xcc_id() { return (unsigned)__builtin_amdgcn_s_getreg((3 << 11) | 20) & 0xFu; }
#define XB_SPIN(cond, bar) do { unsigned _sp = 0; while (cond) { __builtin_amdgcn_s_sleep(1); \
    if ((++_sp & 255u) == 0u) { if (xb_ld(&(bar)[XB_TMO])) break; if (_sp > XB_SPIN_CAP) { atomicAdd(&(bar)[XB_TMO], 1u); break; } } } } while (0)
struct XcdBarrier {
  unsigned* bar;
  unsigned x;
  volatile LAS unsigned* st;
};
DI XcdBarrier xcd_barrier_post(unsigned* bar, volatile LAS unsigned* st) {
  XcdBarrier b;
  b.bar = bar;
  b.x = xb_xcc_id();
  b.st = st;
  if (threadIdx.x == 0) (void)xb_add(&bar[XB_XCNT(b.x)], 1u);
  return b;
}
DI void xcd_barrier_complete(unsigned* bar, unsigned x, unsigned& nloc, unsigned& nx) {
  const unsigned G = gridDim.x * gridDim.y * gridDim.z;
  unsigned sum, cnt, mine, sp = 0u;
  for (;;) {
    sum = 0u; cnt = 0u; mine = 0u;
#pragma unroll
    for (unsigned j = 0; j < 16; ++j) {
      const unsigned c = xb_ld(&bar[XB_XCNT(j)]);
      sum += c;
      cnt += (c > 0u) ? 1u : 0u;
      mine = (j == x) ? c : mine;
    }
    if (sum == G) break;
    __builtin_amdgcn_s_sleep(1);
    if ((++sp & 255u) == 0u) { if (xb_ld(&bar[XB_TMO])) break; if (sp > XB_SPIN_CAP) { atomicAdd(&bar[XB_TMO], 1u); break; } }
  }
  nloc = mine > 0u ? mine : 1u;
  nx = cnt > 0u ? cnt : 1u;
}
DI void xcd_barrier(const XcdBarrier& b) {
  asm volatile("s_waitcnt vmcnt(0)" ::: "memory");
  __syncthreads();
  if (threadIdx.x == 0) {
    unsigned* bar = b.bar;
    __builtin_amdgcn_s_waitcnt(0);
    unsigned nloc = b.st[0], nx = b.st[1];
    if (nloc == 0u) { xcd_barrier_complete(bar, b.x, nloc, nx); b.st[0] = nloc; b.st[1] = nx; }
    const unsigned old = xb_add(&bar[XB_XSUB(b.x)], 1u);
    const unsigned gen = old / nloc;
    if (old + 1u == (gen + 1u) * nloc) {
      __builtin_amdgcn_fence(__ATOMIC_RELEASE, "agent");
      asm volatile("s_waitcnt vmcnt(0)" ::: "memory");
      const unsigned og = xb_add(&bar[XB_TOP], 1u);
      const unsigned tg = og / nx;
      if (og + 1u == (tg + 1u) * nx) xb_add(&bar[XB_TOPGEN], 1u);
      else XB_SPIN(xb_ld(&bar[XB_TOPGEN]) == tg, bar);
      __builtin_amdgcn_fence(__ATOMIC_ACQUIRE, "agent");
      xb_add(&bar[XB_XGEN(b.x)], 1u);
      asm volatile("s_waitcnt vmcnt(0)" ::: "memory");
    } else {
      XB_SPIN(xb_ld(&bar[XB_XGEN(b.x)]) == gen, bar);
      __builtin_amdgcn_fence(__ATOMIC_ACQUIRE, "agent");
      asm volatile("s_waitcnt vmcnt(0)" ::: "memory");
    }
  }
  __syncthreads();
}

constexpr int NPHASE = 1 + 2 * (4 + 5) + 1;

DI void run_phase(const Params& P, int ph, char* lds) {
  if (ph == 0) { prep_phase(P, lds); return; }
  if (ph == NPHASE - 1) { final_phase(P); return; }
  const int q = (ph - 1) / 9, rr = (ph - 1) % 9;
  if (rr < 4) {
    const int layer = q * 2;
    if (rr == 0) gemm_phase<EPI_A_IN>(P, layer, lds);
    else if (rr == 1) attn_phase<false>(P, layer, lds);
    else if (rr == 2) gemm_phase<EPI_OUT>(P, layer, lds);
    else gemm_phase<EPI_PLE>(P, layer, lds);
  } else {
    const int layer = q * 2 + 1;
    if (rr == 4) gemm_phase<EPI_B_IN>(P, layer, lds);
    else if (rr == 5) gemm_phase<EPI_QKV_UP>(P, layer, lds);
    else if (rr == 6) attn_phase<true>(P, layer, lds);
    else if (rr == 7) gemm_phase<EPI_OUT>(P, layer, lds);
    else gemm_phase<EPI_PLE>(P, layer, lds);
  }
}

__global__ void __launch_bounds__(NTHREADS) fwd_kernel(Params P) {
  __shared__ __attribute__((aligned(1024))) char lds[LDS_BYTES + 16];
#if MULTI_LAUNCH
  run_phase(P, P.phase_lo, lds);
#else
  cg::grid_group grid = cg::this_grid();
  volatile LAS unsigned* xst = (volatile LAS unsigned*)(lds + LDS_BYTES);
  if (threadIdx.x == 0) { xst[0] = 0u; xst[1] = 0u; }
  __syncthreads();
  const XcdBarrier xb = xcd_barrier_post((unsigned*)(P.ws + OFF_BAR), xst);
  prep_phase(P, lds);
#if (PROBE_REPEAT >> 9) & 1
  prep_phase(P, lds);
#endif
  grid.sync();
#pragma unroll 1
  for (int q = 0; q < 2; ++q) {
    const int la = 2 * q, lb = 2 * q + 1;
    gemm_phase<EPI_A_IN>(P, la, lds);
#if (PROBE_REPEAT >> 0) & 1
    gemm_phase<EPI_A_IN>(P, la, lds);
#endif
    GSYNC();
    attn_phase<false>(P, la, lds);
#if (PROBE_REPEAT >> 1) & 1
    attn_phase<false>(P, la, lds);
#endif
    GSYNC();
    gemm_phase<EPI_OUT>(P, la, lds);
    GSYNC();
    gemm_phase<EPI_PLE>(P, la, lds);
    GSYNC();
    gemm_phase<EPI_B_IN>(P, lb, lds);
#if (PROBE_REPEAT >> 4) & 1
    gemm_phase<EPI_B_IN>(P, lb, lds);
#endif
    GSYNC();
    gemm_phase<EPI_QKV_UP>(P, lb, lds);
#if (PROBE_REPEAT >> 5) & 1
    gemm_phase<EPI_QKV_UP>(P, lb, lds);
#endif
    GSYNC();
    attn_mla8_phase(P, lds);
#if (PROBE_REPEAT >> 6) & 1
    attn_mla8_phase(P, lds);
#endif
    GSYNC();
    gemm_phase<EPI_OUT>(P, lb, lds);
    GSYNC();
    gemm_phase<EPI_PLE>(P, lb, lds);
    GSYNC();
  }
  final_phase(P);
#endif
}

static void add_seg(Params& p, int& tiles, const float* src, const float* gain, bf16_t* dst, int src_ld, int ncols, int K, int fp8 = 0) {
  Seg& s = p.seg[p.nseg++];
  s.src = src;
  s.gain = gain;
  s.dst = dst;
  s.src_ld = src_ld;
  s.ncols = ncols;
  s.K = K;
  s.fp8 = fp8;
  s.pad0 = 0;
  s.tile0 = tiles;
  tiles += (K / 64) * (ncols / 32);
}

extern "C" void kernel_launch(void* const* d_in, const int* in_sizes, int n_in, void* d_out, int out_size, void* d_ws,
                              size_t ws_size, hipStream_t stream) {
  (void)in_sizes; (void)n_in; (void)out_size;
  if (ws_size < WS_NEEDED) {
    fprintf(stderr, "workspace too small: %zu < %zu\n", ws_size, (size_t)WS_NEEDED);
    return;
  }
  const float* x = (const float*)d_in[0];
  const float* pp = (const float*)d_in[1];
  const float* norm_g = (const float*)d_in[2];
  const float* a_w_in = (const float*)d_in[3];
  const float* a_sink = (const float*)d_in[4];
  const float* a_w_out = (const float*)d_in[5];
  const float* b_w_in = (const float*)d_in[6];
  const float* b_q_norm = (const float*)d_in[7];
  const float* b_w_qb = (const float*)d_in[8];
  const float* b_kv_norm = (const float*)d_in[9];
  const float* b_w_kvb = (const float*)d_in[10];
  const float* b_w_out = (const float*)d_in[11];
  const float* ple_w = (const float*)d_in[12];
  const float* ple_norm_g = (const float*)d_in[13];
  const float* ple_w_gate = (const float*)d_in[14];
  const float* final_g = (const float*)d_in[15];

  Params p;
  memset(&p, 0, sizeof(p));
  p.x = x;
  p.p = pp;
  p.a_sink = a_sink;
  p.final_g = final_g;
  p.out = (float*)d_out;
  p.ws = (char*)d_ws;
  bf16_t* wb = (bf16_t*)((char*)d_ws + OFF_W);
  int tiles = 0;
  for (int j = 0; j < 2; ++j) {
    const int la = 2 * j, lb = 2 * j + 1;
    add_seg(p, tiles, a_w_in + (size_t)j * 1024 * 2560, norm_g + la * 1024, wb + W_A_IN + (size_t)j * 2560 * 1024, 2560, 2560, 1024);
    add_seg(p, tiles, a_w_out + (size_t)j * 1024 * 1024, nullptr, wb + W_A_OUT + (size_t)j * 1024 * 1024, 1024, 1024, 1024);
    const float* bsrc = b_w_in + (size_t)j * 1024 * 1696;
    unsigned char* bdst = (unsigned char*)(wb + W_B_IN + (size_t)j * 1792 * 1024);
    const float* gb = norm_g + lb * 1024;
    add_seg(p, tiles, bsrc + 672, gb, (bf16_t*)bdst, 1696, 1024, 1024, 1);
    add_seg(p, tiles, bsrc + 0, gb, (bf16_t*)(bdst + (size_t)1024 * 1024), 1696, 384, 1024, 1);
    add_seg(p, tiles, bsrc + 384, gb, (bf16_t*)(bdst + (size_t)1408 * 1024), 1696, 256, 1024, 1);
    add_seg(p, tiles, bsrc + 640, gb, (bf16_t*)(bdst + (size_t)1664 * 1024), 1696, 32, 1024, 1);
    add_seg(p, tiles, nullptr, nullptr, (bf16_t*)(bdst + (size_t)1696 * 1024), 1696, 96, 1024, 1);
    add_seg(p, tiles, b_w_qb + (size_t)j * 384 * 1536, b_q_norm + j * 384, wb + W_B_QB + (size_t)j * 1536 * 384, 1536, 1536, 384, 1);
    add_seg(p, tiles, b_w_kvb + (size_t)j * 256 * 2048, b_kv_norm + j * 256, wb + W_B_KVB + (size_t)j * 2048 * 256, 2048, 2048, 256, 1);
    add_seg(p, tiles, b_w_out + (size_t)j * 1024 * 1024, nullptr, wb + W_B_OUT + (size_t)j * 1024 * 1024, 1024, 1024, 1024, 1);
  }
  for (int i = 0; i < 4; ++i) {
    add_seg(p, tiles, ple_w + (size_t)i * 256 * 1024, nullptr, wb + W_PLE + (size_t)i * 1024 * 256, 1024, 1024, 256);
    add_seg(p, tiles, ple_w_gate + (size_t)i * 1024 * 1024, ple_norm_g + i * 1024, wb + W_GATE + (size_t)i * 1024 * 1024, 1024, 1024, 1024);
  }
  p.ntile_w = tiles;

#if MULTI_LAUNCH
  for (int ph = 0; ph < NPHASE; ++ph) {
    p.phase_lo = ph;
    p.phase_hi = ph + 1;
    hipLaunchKernelGGL(fwd_kernel, dim3(1024), dim3(NTHREADS), 0, stream, p);
  }
#else
  static int grid_blocks = 0;
  if (!grid_blocks) {
    int dev = 0, cus = 0, per_cu = 0;
    hipGetDevice(&dev);
    hipDeviceGetAttribute(&cus, hipDeviceAttributeMultiprocessorCount, dev);
    hipOccupancyMaxActiveBlocksPerMultiprocessor(&per_cu, fwd_kernel, NTHREADS, 0);
    if (per_cu < 1) per_cu = 1;
    if (per_cu > 1) per_cu = 1;
    grid_blocks = cus * per_cu;
  }
  p.phase_lo = 0;
  p.phase_hi = NPHASE;
  (void)hipMemsetAsync((char*)d_ws + OFF_BAR, 0, 16384, stream);
  void* args[] = {&p};
  hipError_t e = hipLaunchCooperativeKernel((void*)fwd_kernel, dim3(grid_blocks), dim3(NTHREADS), args, 0, stream);
  if (e != hipSuccess) fprintf(stderr, "cooperative launch failed: %s (grid %d)\n", hipGetErrorString(e), grid_blocks);
#endif
}
```

```cpp
#include <hip/hip_runtime.h>
#include <hip/hip_cooperative_groups.h>
#include <cstdio>
#include <cstring>
namespace cg = cooperative_groups;

#ifndef PROBE_REPEAT
#define PROBE_REPEAT 0
#endif
#ifndef PROBE_SYNC2
#define PROBE_SYNC2 0
#endif
#if PROBE_SYNC2
#define GSYNC() do { xcd_barrier(xb); xcd_barrier(xb); } while (0)
#else
#define GSYNC() xcd_barrier(xb)
#endif
#ifndef MULTI_LAUNCH
#define MULTI_LAUNCH 0
#endif

#define DI __device__ __forceinline__
typedef __attribute__((ext_vector_type(8))) short bf16x8;
typedef __attribute__((ext_vector_type(16))) float f32x16;
typedef unsigned short bf16_t;

constexpr int T = 32768, S = 8192, NB = 4, DM = 1024, PLE = 256;
constexpr int NTHREADS = 512;
constexpr float LOG2E = 1.4426950408889634f;
constexpr float EPS = 1e-6f;

constexpr size_t MiB = 1024ull * 1024ull;
constexpr size_t OFF_HB = 0;
constexpr size_t OFF_Z = 64 * MiB;
constexpr size_t OFF_Q = 128 * MiB;
constexpr size_t OFF_K = 224 * MiB;
constexpr size_t OFF_VT = 288 * MiB;
constexpr size_t OFF_CQ = 352 * MiB;
constexpr size_t OFF_CKV = 376 * MiB;
constexpr size_t OFF_KR = 392 * MiB;
constexpr size_t OFF_SSQH = 394 * MiB;
constexpr size_t OFF_SSQM = 395 * MiB;
constexpr size_t OFF_SSQC = 396 * MiB;
constexpr size_t OFF_ROPE = 397 * MiB;
constexpr size_t OFF_W = 398 * MiB;
constexpr size_t OFF_PB = 438 * MiB;
constexpr size_t OFF_BAR = 502 * MiB;
constexpr size_t W_A_IN = 0;
constexpr size_t W_A_OUT = W_A_IN + 2ull * 2560 * 1024;
constexpr size_t W_B_IN = W_A_OUT + 2ull * 1024 * 1024;
constexpr size_t W_B_QB = W_B_IN + 2ull * 1792 * 1024;
constexpr size_t W_B_KVB = W_B_QB + 2ull * 1536 * 384;
constexpr size_t W_B_OUT = W_B_KVB + 2ull * 2048 * 256;
constexpr size_t W_PLE = W_B_OUT + 2ull * 1024 * 1024;
constexpr size_t W_GATE = W_PLE + 4ull * 1024 * 256;
constexpr size_t W_END = W_GATE + 4ull * 1024 * 1024;
static_assert(OFF_W + W_END * 2 <= OFF_PB, "weights overflow");
constexpr size_t WS_NEEDED = OFF_BAR + 1 * MiB;

struct Seg {
  const float* src;
  const float* gain;
  bf16_t* dst;
  int src_ld, ncols, K, tile0;
  int fp8, pad0;
};
constexpr int MAXSEG = 32;

struct Params {
  const float *x, *p, *a_sink, *final_g;
  float* out;
  char* ws;
  Seg seg[MAXSEG];
  int nseg, ntile_w;
  int phase_lo, phase_hi;
};

typedef __attribute__((ext_vector_type(2))) float f32x2_t;
typedef __attribute__((ext_vector_type(2))) __bf16 bf16x2_t;
DI unsigned pack2(float a, float b) {
  f32x2_t v = {a, b};
  return __builtin_bit_cast(unsigned, __builtin_convertvector(v, bf16x2_t));
}
DI unsigned f2bf(float x) { return pack2(x, 0.f) & 0xffffu; }
DI float xhalf_max(float x) {
  return fmaxf(x, __shfl_xor(x, 32));
}
DI float bf2f(unsigned h) { return __uint_as_float(h << 16); }
DI int crow(int i, int h) { return (i & 3) + 8 * (i >> 2) + 4 * h; }
DI int perm16(int s) {
  int k = s & 15;
  int c = k >> 2;
  int pc = ((c & 1) << 1) | (c >> 1);
  return (s & ~15) | (pc << 2) | (k & 3);
}
#define MFMA(a, b, c) __builtin_amdgcn_mfma_f32_32x32x16_bf16((a), (b), (c), 0, 0, 0)
DI int get_tid() {
  int t = threadIdx.x;
  asm volatile("" : "+v"(t));
  return t;
}
template <typename TP>
DI TP* uniform_ptr(TP* p) {
  unsigned lo = (unsigned)(size_t)p, hi = (unsigned)((size_t)p >> 32);
  lo = __builtin_amdgcn_readfirstlane(lo);
  hi = __builtin_amdgcn_readfirstlane(hi);
  asm volatile("" : "+s"(lo), "+s"(hi));
  return (TP*)(((size_t)hi << 32) | (size_t)lo);
}
DI unsigned pack4_fp8(float a, float b, float c, float d);
DI unsigned pack4_fp8c(float a, float b, float c, float d);
DI float clamp8(float x);
DI float wave_xor_sum32(float v) { return v + __shfl_xor(v, 32); }

DI void prep_phase(const Params& P, char* lds) {
  const int tid = get_tid();
  {
    const int w = tid >> 6, lane = tid & 63;
    float* tl = (float*)lds + w * (64 * 33);
    for (int t = blockIdx.x * 8 + w; t < P.ntile_w; t += gridDim.x * 8) {
      int si = 0;
      for (int i = 1; i < P.nseg; ++i)
        if (t >= P.seg[i].tile0) si = i;
      const Seg sg = P.seg[si];
      const int lt = t - sg.tile0;
      const int ncb = sg.ncols >> 5;
      const int kb = lt / ncb, nb = lt - kb * ncb;
      const int k0 = kb * 64, n0 = nb * 32;
      {
        const int n = lane & 31, kofs = lane >> 5;
        float vv[32];
#pragma unroll
        for (int i = 0; i < 32; ++i) {
          const int k = kofs + 2 * i;
          float v = 0.f;
          if (sg.src) {
            v = sg.src[(size_t)(k0 + k) * sg.src_ld + n0 + n];
            if (sg.gain) v *= sg.gain[k0 + k];
          }
          vv[i] = v;
        }
#pragma unroll
        for (int i = 0; i < 32; ++i) tl[(kofs + 2 * i) * 33 + n] = vv[i];
      }
      __builtin_amdgcn_fence(__ATOMIC_RELEASE, "wavefront");
      __builtin_amdgcn_wave_barrier();
      __builtin_amdgcn_fence(__ATOMIC_ACQUIRE, "wavefront");
#pragma unroll
      for (int jj = 0; jj < 8; ++jj) {
        const int j = lane + 64 * jj;
        const int kk4 = (j & 15) * 4, n = j >> 4;
        const float w0 = tl[(kk4 + 0) * 33 + n], w1 = tl[(kk4 + 1) * 33 + n], w2 = tl[(kk4 + 2) * 33 + n], w3 = tl[(kk4 + 3) * 33 + n];
        if (sg.fp8) {
          *(unsigned*)((unsigned char*)sg.dst + (size_t)(n0 + n) * sg.K + k0 + kk4) = pack4_fp8c(w0 * 64.f, w1 * 64.f, w2 * 64.f, w3 * 64.f);
        } else {
          uint2 o2;
          o2.x = pack2(w0, w1);
          o2.y = pack2(w2, w3);
          *(uint2*)(sg.dst + (size_t)(n0 + n) * sg.K + k0 + kk4) = o2;
        }
      }
      __builtin_amdgcn_fence(__ATOMIC_RELEASE, "wavefront");
      __builtin_amdgcn_wave_barrier();
    }
  }
  {
    char* ws = uniform_ptr(P.ws);
    bf16_t* hb = (bf16_t*)(ws + OFF_HB);
    float* ssq = (float*)(ws + OFF_SSQH);
    const int w = tid >> 6, lane = tid & 63;
    for (int row = blockIdx.x * 8 + w; row < T; row += gridDim.x * 8) {
      const float4* xr = (const float4*)(P.x + (size_t)row * DM);
      float s = 0.f;
#pragma unroll
      for (int i = 0; i < 4; ++i) {
        float4 v = xr[lane + 64 * i];
        s += v.x * v.x + v.y * v.y + v.z * v.z + v.w * v.w;
        uint2 o;
        o.x = pack2(v.x, v.y);
        o.y = pack2(v.z, v.w);
        *(uint2*)(hb + (size_t)row * DM + (lane + 64 * i) * 4) = o;
      }
#pragma unroll
      for (int o = 32; o >= 1; o >>= 1) s += __shfl_xor(s, o);
      if (lane < 8) ssq[(size_t)row * 8 + lane] = (lane == 0) ? s : 0.f;
    }
  }
  {
    bf16_t* pb = (bf16_t*)(uniform_ptr(P.ws) + OFF_PB);
    const size_t n8 = (size_t)4 * T * PLE / 8;
    for (size_t e = (size_t)blockIdx.x * NTHREADS + tid; e < n8; e += (size_t)gridDim.x * NTHREADS) {
      const float4 v0 = ((const float4*)P.p)[2 * e], v1 = ((const float4*)P.p)[2 * e + 1];
      uint4 o;
      o.x = pack2(v0.x, v0.y);
      o.y = pack2(v0.z, v0.w);
      o.z = pack2(v1.x, v1.y);
      o.w = pack2(v1.z, v1.w);
      ((uint4*)pb)[e] = o;
    }
  }
  {
    float* rt = (float*)(uniform_ptr(P.ws) + OFF_ROPE);
    for (int e = blockIdx.x * NTHREADS + tid; e < S * 16; e += gridDim.x * NTHREADS) {
      const int s = e >> 4, i = e & 15;
      const double inv = exp2(-(double)i * (13.287712379549449 / 16.0));
      const double rev = (double)s * inv * 0.15915494309189535;
      const float fr = (float)(rev - floor(rev));
      rt[s * 32 + i] = __builtin_amdgcn_cosf(fr);
      rt[s * 32 + 16 + i] = __builtin_amdgcn_sinf(fr);
    }
  }
}

typedef __attribute__((ext_vector_type(4))) float f32x4;
constexpr int GBK = 64, GKS = 2;
constexpr int GTILE_B = 256 * GBK * 2;
constexpr int GSTAGE_B = 2 * GTILE_B;
constexpr int LDS_BYTES = 2 * GSTAGE_B;

DI int lds_byte(int r, int c) {
  int st = (r >> 4) * GKS + (c >> 5), ob = (r & 15) * 64 + (c & 31) * 2;
  return st * 1024 + (ob ^ (((ob >> 9) & 1) << 5));
}
DI void stage_rc(int b, int& R, int& C) {
  int st = b >> 10, sb = b & 1023, swz = sb ^ (((sb >> 9) & 1) << 5);
  R = (st / GKS) * 16 + swz / 64;
  C = (st % GKS) * 32 + (swz % 64) / 2;
}
#define WAIT_V0() asm volatile("s_waitcnt vmcnt(0)" ::: "memory")

DI void gemm_core(f32x4 (&acc)[8][4], const bf16_t* Wb, const bf16_t* Xb, int K, char* shm) {
  const int tid = get_tid();
  const int wid = tid >> 6, lane = tid & 63, wr = wid >> 2, wc = wid & 3, fr = lane & 15, fq = lane >> 4;
  int sR[4], sC[4];
#pragma unroll
  for (int i = 0; i < 4; ++i) stage_rc(wid * 1024 + i * 8192 + lane * 16, sR[i], sC[i]);
  const int nt = K / GBK;
#define GSRC(base, i, kt) ((base) + (size_t)sR[i] * K + (kt) * GBK + sC[i])
#define GLDS_STAGE(buf, kt)                                                                                           \
  do {                                                                                                                \
    _Pragma("unroll") for (int i = 0; i < 4; ++i) {                                                                   \
      __builtin_amdgcn_global_load_lds((const unsigned*)GSRC(Wb, i, kt),                                             \
                                       (unsigned*)(shm + (buf) * GSTAGE_B + wid * 1024 + i * 8192), 16, 0, 0);        \
      __builtin_amdgcn_global_load_lds((const unsigned*)GSRC(Xb, i, kt),                                             \
                                       (unsigned*)(shm + (buf) * GSTAGE_B + GTILE_B + wid * 1024 + i * 8192), 16, 0, 0); \
    }                                                                                                                 \
  } while (0)
  __syncthreads();
  GLDS_STAGE(0, 0);
  WAIT_V0();
  __syncthreads();
#pragma unroll 1
  for (int t = 0; t < nt; ++t) {
    const int cur = t & 1;
    if (t + 1 < nt) GLDS_STAGE(cur ^ 1, t + 1);
    const char* sa = shm + cur * GSTAGE_B;
    const char* sb = sa + GTILE_B;
#pragma unroll
    for (int ks = 0; ks < GKS; ++ks) {
      bf16x8 At[8], Bf[4];
#pragma unroll
      for (int m = 0; m < 8; ++m) At[m] = *(const bf16x8*)(sa + lds_byte(wr * 128 + m * 16 + fr, ks * 32 + fq * 8));
#pragma unroll
      for (int n = 0; n < 4; ++n) Bf[n] = *(const bf16x8*)(sb + lds_byte(wc * 64 + n * 16 + fr, ks * 32 + fq * 8));
#pragma unroll
      for (int m = 0; m < 8; ++m)
#pragma unroll
        for (int n = 0; n < 4; ++n) acc[m][n] = __builtin_amdgcn_mfma_f32_16x16x32_bf16(At[m], Bf[n], acc[m][n], 0, 0, 0);
      __builtin_amdgcn_sched_barrier(0);
    }
    WAIT_V0();
    __syncthreads();
  }
#undef GSRC
#undef GLDS_STAGE
}

typedef __attribute__((ext_vector_type(8))) int i32x8g;
DI i32x8g ld32g(const char* p0, const char* p1) {
  const uint4 a = *(const uint4*)p0, b = *(const uint4*)p1;
  i32x8g r = {(int)a.x, (int)a.y, (int)a.z, (int)a.w, (int)b.x, (int)b.y, (int)b.z, (int)b.w};
  return r;
}
DI void gemm_core8(f32x4 (&acc)[8][4], const unsigned char* Wb, const unsigned char* Xb, int K, char* shm, int sw, int sx) {
  const int tid = get_tid();
  const int wid = tid >> 6, lane = tid & 63, wr = wid >> 2, wc = wid & 3, fr = lane & 15, fq = lane >> 4;
  int sR[4], sC[4];
#pragma unroll
  for (int i = 0; i < 4; ++i) stage_rc(wid * 1024 + i * 8192 + lane * 16, sR[i], sC[i]);
  const int nt = K / 128;
#define GSRC8(base, i, kt) ((base) + (size_t)sR[i] * K + (kt) * 128 + sC[i] * 2)
#define GLDS_STAGE8(buf, kt)                                                                                          \
  do {                                                                                                                \
    _Pragma("unroll") for (int i = 0; i < 4; ++i) {                                                                   \
      __builtin_amdgcn_global_load_lds((const unsigned*)GSRC8(Wb, i, kt),                                            \
                                       (unsigned*)(shm + (buf) * GSTAGE_B + wid * 1024 + i * 8192), 16, 0, 0);        \
      __builtin_amdgcn_global_load_lds((const unsigned*)GSRC8(Xb, i, kt),                                            \
                                       (unsigned*)(shm + (buf) * GSTAGE_B + GTILE_B + wid * 1024 + i * 8192), 16, 0, 0); \
    }                                                                                                                 \
  } while (0)
  __syncthreads();
  GLDS_STAGE8(0, 0);
  WAIT_V0();
  __syncthreads();
#pragma unroll 1
  for (int t = 0; t < nt; ++t) {
    const int cur = t & 1;
    if (t + 1 < nt) GLDS_STAGE8(cur ^ 1, t + 1);
    const char* sa = shm + cur * GSTAGE_B;
    const char* sb = sa + GTILE_B;
    i32x8g Bf[4];
#pragma unroll
    for (int n = 0; n < 4; ++n)
      Bf[n] = ld32g(sb + lds_byte(wc * 64 + n * 16 + fr, fq * 8), sb + lds_byte(wc * 64 + n * 16 + fr, 32 + fq * 8));
#pragma unroll
    for (int mh = 0; mh < 2; ++mh) {
      i32x8g At[4];
#pragma unroll
      for (int m = 0; m < 4; ++m)
        At[m] = ld32g(sa + lds_byte(wr * 128 + (mh * 4 + m) * 16 + fr, fq * 8), sa + lds_byte(wr * 128 + (mh * 4 + m) * 16 + fr, 32 + fq * 8));
#pragma unroll
      for (int m = 0; m < 4; ++m)
#pragma unroll
        for (int n = 0; n < 4; ++n)
          acc[mh * 4 + m][n] = __builtin_amdgcn_mfma_scale_f32_16x16x128_f8f6f4(At[m], Bf[n], acc[mh * 4 + m][n], 0, 0, 0, sw, 0, sx);
    }
    __builtin_amdgcn_sched_barrier(0);
    WAIT_V0();
    __syncthreads();
  }
#undef GSRC8
#undef GLDS_STAGE8
}
constexpr int SC_ONE = 0x7f7f7f7f;
constexpr int SC_M6 = 0x79797979;
constexpr int SC_M4 = 0x7b7b7b7b;

DI float sum8(const float* p) {
  const float4* q = (const float4*)p;
  float4 a = q[0], b = q[1];
  return (a.x + a.y + a.z + a.w) + (b.x + b.y + b.z + b.w);
}
DI float quad_sum(float v) {
  v += __shfl_xor(v, 16);
  v += __shfl_xor(v, 32);
  return v;
}

DI unsigned pack4_fp8(float a, float b, float c, float d);
DI int perm64(int s);
enum { EPI_A_IN = 0, EPI_B_IN = 1, EPI_QKV_UP = 2, EPI_OUT = 3, EPI_PLE = 4 };

DI void store4bf(bf16_t* dst, float a, float b, float c, float d) {
  uint2 o;
  o.x = pack2(a, b);
  o.y = pack2(c, d);
  *(uint2*)dst = o;
}
DI void store_pair_bf(bf16_t* dst, int fq, float a0, float a1, float a2, float a3, float b0, float b1, float b2, float b3) {
  const unsigned ax = pack2(a0, a1), ay = pack2(a2, a3), bx = pack2(b0, b1), by = pack2(b2, b3);
  auto r0 = __builtin_amdgcn_permlane16_swap(ax, bx, false, false);
  auto r1 = __builtin_amdgcn_permlane16_swap(ay, by, false, false);
  *(uint4*)(dst + (fq & 1) * 16 + (fq >> 1) * 8) = make_uint4(r0[0], r1[0], r0[1], r1[1]);
}
DI void store_vt4(bf16_t* dst, float a, float b, float c, float d) {
  dst[0] = (bf16_t)f2bf(a);
  dst[S] = (bf16_t)f2bf(b);
  dst[2 * S] = (bf16_t)f2bf(c);
  dst[3 * S] = (bf16_t)f2bf(d);
}

template <int EPI>
DI void gemm_phase(const Params& P, int layer, char* lds) {
  const int tid = get_tid();
  const int wid = tid >> 6, lane = tid & 63, wr = wid >> 2, wc = wid & 3, fr = lane & 15, fq = lane >> 4;
  const int j = layer >> 1;
  char* ws = uniform_ptr(P.ws);
  bf16_t* wbase = (bf16_t*)(ws + OFF_W);
  bf16_t* hb = (bf16_t*)(ws + OFF_HB);
  bf16_t* og = (bf16_t*)(ws + OFF_HB);
  bf16_t* zb = (bf16_t*)(ws + OFF_Z);
  bf16_t* hmb = (bf16_t*)(ws + OFF_Z);
  bf16_t* qb = (bf16_t*)(ws + OFF_Q);
  bf16_t* eb = (bf16_t*)(ws + OFF_Q);
  bf16_t* kb = (bf16_t*)(ws + OFF_K);
  bf16_t* vt = (bf16_t*)(ws + OFF_VT);
  bf16_t* cqb = (bf16_t*)(ws + OFF_CQ);
  bf16_t* ckvb = (bf16_t*)(ws + OFF_CKV);
  bf16_t* krb = (bf16_t*)(ws + OFF_KR);
  const bf16_t* pbb = (const bf16_t*)(ws + OFF_PB);
  float* ssqh = (float*)(ws + OFF_SSQH);
  float* ssqm = (float*)(ws + OFF_SSQM);
  float* ssqc = (float*)(ws + OFF_SSQC);
  const float* rope = (const float*)(ws + OFF_ROPE);

  int NT, ntiles;
  if constexpr (EPI == EPI_A_IN) { NT = 10; ntiles = 128 * 10; }
  else if constexpr (EPI == EPI_B_IN) { NT = 7; ntiles = 128 * 7; }
  else if constexpr (EPI == EPI_QKV_UP) { NT = 14; ntiles = 128 * 14; }
  else if constexpr (EPI == EPI_OUT) { NT = 4; ntiles = 128 * 8; }
  else { NT = 4; ntiles = 128 * 4; }

  for (int tile = blockIdx.x; tile < ntiles; tile += gridDim.x) {
    int t2 = tile;
    bool second = false;
    if constexpr (EPI == EPI_OUT) {
      if (t2 >= 512) { second = true; t2 -= 512; }
    }
    int mt = t2 / NT, nt = t2 - mt * NT;
    if (gridDim.x == 256) {
      const int x = blockIdx.x & 7, s = blockIdx.x >> 3, k = t2 >> 8;
      const int idx = s + 32 * k;
      mt = (idx / NT) * 8 + x;
      nt = idx - (idx / NT) * NT;
    }
    const int m0 = mt * 256, n0 = nt * 256;
    f32x4 acc[8][4];
#pragma unroll
    for (int m = 0; m < 8; ++m)
#pragma unroll
      for (int n = 0; n < 4; ++n) acc[m][n] = f32x4{0.f, 0.f, 0.f, 0.f};

    if constexpr (EPI == EPI_A_IN) {
      gemm_core(acc, wbase + W_A_IN + (size_t)j * 2560 * 1024 + (size_t)n0 * 1024, hb + (size_t)m0 * 1024, 1024, lds);
      const float qs = 0.125f * LOG2E;
#pragma unroll
      for (int n = 0; n < 4; ++n) {
        const int tok = m0 + wc * 64 + n * 16 + fr;
        const float rstd = rsqrtf(sum8(ssqh + (size_t)tok * 8) * (1.f / 1024.f) + EPS);
        const int b = tok >> 13, s = tok & (S - 1);
        if (nt == 5) {
#pragma unroll
          for (int m = 0; m < 8; ++m) {
            const int f = n0 + wr * 128 + m * 16 + fq * 4;
            store_vt4(vt + ((size_t)(b * 4) * 64 + (f - 1280)) * S + perm16(s), acc[m][n][0] * rstd, acc[m][n][1] * rstd,
                      acc[m][n][2] * rstd, acc[m][n][3] * rstd);
          }
        } else {
          const float sc_ = (nt < 4) ? rstd * qs : rstd;
          const int fg = n0 + wr * 128;
          bf16_t* rowp = (nt < 4) ? (qb + (size_t)tok * 1024 + fg) : (nt == 4) ? (kb + (size_t)tok * 256 + (fg - 1024))
                                                                              : (zb + (size_t)tok * 1024 + (fg - 1536));
#pragma unroll
          for (int m = 0; m < 8; m += 2)
            store_pair_bf(rowp + m * 16, fq, acc[m][n][0] * sc_, acc[m][n][1] * sc_, acc[m][n][2] * sc_, acc[m][n][3] * sc_,
                          acc[m + 1][n][0] * sc_, acc[m + 1][n][1] * sc_, acc[m + 1][n][2] * sc_, acc[m + 1][n][3] * sc_);
        }
      }
    } else if constexpr (EPI == EPI_B_IN) {
      gemm_core8(acc, (const unsigned char*)(wbase + W_B_IN + (size_t)j * 1792 * 1024) + (size_t)n0 * 1024, (const unsigned char*)hb + (size_t)m0 * 1024, 1024, lds, SC_M6, SC_ONE);
      const int fbase = n0 + wr * 128;
#pragma unroll
      for (int n = 0; n < 4; ++n) {
        const int tok = m0 + wc * 64 + n * 16 + fr;
        const float rstd = rsqrtf(sum8(ssqh + (size_t)tok * 8) * (1.f / 1024.f) + EPS);
        const int s = tok & (S - 1);
        if (fbase < 1024) {
#pragma unroll
          for (int m = 0; m < 8; m += 2)
            store_pair_bf(zb + (size_t)tok * 1024 + fbase + m * 16, fq, acc[m][n][0] * rstd, acc[m][n][1] * rstd, acc[m][n][2] * rstd,
                          acc[m][n][3] * rstd, acc[m + 1][n][0] * rstd, acc[m + 1][n][1] * rstd, acc[m + 1][n][2] * rstd,
                          acc[m + 1][n][3] * rstd);
        } else if (fbase < 1664) {
          float sq = 0.f;
          const bool iscq = fbase < 1408;
#pragma unroll
          for (int m = 0; m < 8; ++m) {
            const float v0 = acc[m][n][0] * rstd, v1 = acc[m][n][1] * rstd, v2 = acc[m][n][2] * rstd, v3 = acc[m][n][3] * rstd;
            sq += v0 * v0 + v1 * v1 + v2 * v2 + v3 * v3;
            const int f = fbase + m * 16 + fq * 4;
            if (iscq) *(unsigned*)((unsigned char*)cqb + (size_t)tok * 384 + (f - 1024)) = pack4_fp8c(v0, v1, v2, v3);
            else *(unsigned*)((unsigned char*)ckvb + (size_t)tok * 256 + (f - 1408)) = pack4_fp8c(v0, v1, v2, v3);
          }
          sq = quad_sum(sq);
          if (fq == 0) {
            const int pi = iscq ? ((fbase - 1024) >> 7) : (4 + ((fbase - 1408) >> 7));
            ssqc[(size_t)tok * 8 + pi] = sq;
          }
        } else {
          const float4 cs = *(const float4*)(rope + s * 32 + fq * 4);
          const float4 sn = *(const float4*)(rope + s * 32 + 16 + fq * 4);
          const float x10 = acc[0][n][0] * rstd, x11 = acc[0][n][1] * rstd, x12 = acc[0][n][2] * rstd, x13 = acc[0][n][3] * rstd;
          const float x20 = acc[1][n][0] * rstd, x21 = acc[1][n][1] * rstd, x22 = acc[1][n][2] * rstd, x23 = acc[1][n][3] * rstd;
          unsigned char* kr8 = (unsigned char*)krb;
          *(unsigned*)(kr8 + (size_t)tok * 32 + fq * 4) =
              pack4_fp8c(x10 * cs.x - x20 * sn.x, x11 * cs.y - x21 * sn.y, x12 * cs.z - x22 * sn.z, x13 * cs.w - x23 * sn.w);
          *(unsigned*)(kr8 + (size_t)tok * 32 + 16 + fq * 4) =
              pack4_fp8c(x10 * sn.x + x20 * cs.x, x11 * sn.y + x21 * cs.y, x12 * sn.z + x22 * cs.z, x13 * sn.w + x23 * cs.w);
        }
      }
    } else if constexpr (EPI == EPI_QKV_UP) {
      if (nt < 6) {
        gemm_core8(acc, (const unsigned char*)(wbase + W_B_QB + (size_t)j * 1536 * 384) + (size_t)n0 * 384, (const unsigned char*)cqb + (size_t)m0 * 384, 384, lds, SC_M6, SC_ONE);
        const float qs = 0.10206207261596575f * LOG2E;
#pragma unroll
        for (int n = 0; n < 4; ++n) {
          const int tok = m0 + wc * 64 + n * 16 + fr;
          const float* pc = ssqc + (size_t)tok * 8;
          const float rstd = rsqrtf((pc[0] + pc[1] + pc[2]) * (1.f / 384.f) + EPS) * qs;
          const int s = tok & (S - 1);
          const float4 cs = *(const float4*)(rope + s * 32 + fq * 4);
          const float4 sn = *(const float4*)(rope + s * 32 + 16 + fq * 4);
#pragma unroll
          for (int mp = 0; mp < 4; ++mp) {
            const int fb = n0 + wr * 128 + mp * 32;
            const int cb = fb >> 5;
            unsigned char* dst = (unsigned char*)qb + (size_t)tok * 1536 + fb + fq * 4;
            const float x10 = acc[2 * mp][n][0] * rstd, x11 = acc[2 * mp][n][1] * rstd, x12 = acc[2 * mp][n][2] * rstd,
                        x13 = acc[2 * mp][n][3] * rstd;
            const float x20 = acc[2 * mp + 1][n][0] * rstd, x21 = acc[2 * mp + 1][n][1] * rstd, x22 = acc[2 * mp + 1][n][2] * rstd,
                        x23 = acc[2 * mp + 1][n][3] * rstd;
            if ((cb % 3) == 2) {
              *(unsigned*)dst = pack4_fp8c(x10 * cs.x - x20 * sn.x, x11 * cs.y - x21 * sn.y, x12 * cs.z - x22 * sn.z, x13 * cs.w - x23 * sn.w);
              *(unsigned*)(dst + 16) = pack4_fp8c(x10 * sn.x + x20 * cs.x, x11 * sn.y + x21 * cs.y, x12 * sn.z + x22 * cs.z, x13 * sn.w + x23 * cs.w);
            } else {
              *(unsigned*)dst = pack4_fp8c(x10, x11, x12, x13);
              *(unsigned*)(dst + 16) = pack4_fp8c(x20, x21, x22, x23);
            }
          }
        }
      } else {
        const int n0k = (nt - 6) * 256;
        gemm_core8(acc, (const unsigned char*)(wbase + W_B_KVB + (size_t)j * 2048 * 256) + (size_t)n0k * 256, (const unsigned char*)ckvb + (size_t)m0 * 256, 256, lds, SC_M6, SC_ONE);
        const int hd = (nt - 6) * 2 + wr;
#pragma unroll
        for (int n = 0; n < 4; ++n) {
          const int tok = m0 + wc * 64 + n * 16 + fr;
          const float* pc = ssqc + (size_t)tok * 8 + 4;
          const float rstd = rsqrtf((pc[0] + pc[1]) * (1.f / 256.f) + EPS);
          const int b = tok >> 13, s = tok & (S - 1);
#pragma unroll
          for (int m = 0; m < 8; ++m) {
            const float v0 = acc[m][n][0] * rstd, v1 = acc[m][n][1] * rstd, v2 = acc[m][n][2] * rstd, v3 = acc[m][n][3] * rstd;
            if (m < 4) {
              *(unsigned*)((unsigned char*)kb + (size_t)tok * 1024 + hd * 64 + m * 16 + fq * 4) = pack4_fp8c(v0, v1, v2, v3);
            } else {
              const float p0 = __shfl_xor(v0, 1), p1 = __shfl_xor(v1, 1), p2 = __shfl_xor(v2, 1), p3 = __shfl_xor(v3, 1);
              const bool odd = fr & 1;
              const float a0 = odd ? p2 : v0, b0 = odd ? v2 : p0;
              const float a1 = odd ? p3 : v1, b1 = odd ? v3 : p1;
              const int d = (m - 4) * 16 + fq * 4 + (odd ? 2 : 0);
              unsigned char* dst = (unsigned char*)vt + ((size_t)(b * 16 + hd) * 64 + d) * S + perm64(s & ~1);
              *(unsigned short*)dst = (unsigned short)(__builtin_amdgcn_cvt_pk_fp8_f32(clamp8(a0), clamp8(b0), 0, false) & 0xffff);
              *(unsigned short*)(dst + S) = (unsigned short)(__builtin_amdgcn_cvt_pk_fp8_f32(clamp8(a1), clamp8(b1), 0, false) & 0xffff);
            }
          }
        }
      }
    } else if constexpr (EPI == EPI_OUT) {
      if (!second) {
        if (layer & 1) {
          const unsigned char* wt = (const unsigned char*)(wbase + W_B_OUT + (size_t)j * 1024 * 1024);
          gemm_core8(acc, wt + (size_t)n0 * 1024, (const unsigned char*)og + (size_t)m0 * 1024, 1024, lds, SC_M6, SC_M4);
        } else {
          gemm_core(acc, wbase + W_A_OUT + (size_t)j * 1024 * 1024 + (size_t)n0 * 1024, og + (size_t)m0 * 1024, 1024, lds);
        }
        float* outp = uniform_ptr(P.out);
        const float* resid = (layer == 0) ? uniform_ptr(P.x) : outp;
#pragma unroll
        for (int n = 0; n < 4; ++n) {
          const int tok = m0 + wc * 64 + n * 16 + fr;
          float sq = 0.f;
          f32x4 rr[8];
#pragma unroll
          for (int m = 0; m < 8; ++m) rr[m] = *(const f32x4*)(resid + (size_t)tok * DM + n0 + wr * 128 + m * 16 + fq * 4);
          asm volatile("" : "+v"(rr[0]), "+v"(rr[1]), "+v"(rr[2]), "+v"(rr[3]), "+v"(rr[4]), "+v"(rr[5]), "+v"(rr[6]), "+v"(rr[7]));
#pragma unroll
          for (int m = 0; m < 8; m += 2) {
            const int f = n0 + wr * 128 + m * 16 + fq * 4;
            float4 rv = make_float4(rr[m][0], rr[m][1], rr[m][2], rr[m][3]);
            float4 rw = make_float4(rr[m + 1][0], rr[m + 1][1], rr[m + 1][2], rr[m + 1][3]);
            rv.x += acc[m][n][0];
            rv.y += acc[m][n][1];
            rv.z += acc[m][n][2];
            rv.w += acc[m][n][3];
            rw.x += acc[m + 1][n][0];
            rw.y += acc[m + 1][n][1];
            rw.z += acc[m + 1][n][2];
            rw.w += acc[m + 1][n][3];
            sq += rv.x * rv.x + rv.y * rv.y + rv.z * rv.z + rv.w * rv.w;
            sq += rw.x * rw.x + rw.y * rw.y + rw.z * rw.z + rw.w * rw.w;
            *(float4*)(outp + (size_t)tok * DM + f) = rv;
            *(float4*)(outp + (size_t)tok * DM + f + 16) = rw;
            store_pair_bf(hmb + (size_t)tok * DM + n0 + wr * 128 + m * 16, fq, rv.x, rv.y, rv.z, rv.w, rw.x, rw.y, rw.z, rw.w);
          }
          sq = quad_sum(sq);
          if (fq == 0) ssqm[(size_t)tok * 8 + nt * 2 + wr] = sq;
        }
      } else {
        gemm_core(acc, wbase + W_PLE + (size_t)layer * 1024 * 256 + (size_t)n0 * 256, pbb + ((size_t)layer * T + m0) * 256, 256, lds);
#pragma unroll
        for (int n = 0; n < 4; ++n) {
          const int tok = m0 + wc * 64 + n * 16 + fr;
#pragma unroll
          for (int m = 0; m < 8; m += 2)
            store_pair_bf(eb + (size_t)tok * DM + n0 + wr * 128 + m * 16, fq, acc[m][n][0], acc[m][n][1], acc[m][n][2], acc[m][n][3],
                          acc[m + 1][n][0], acc[m + 1][n][1], acc[m + 1][n][2], acc[m + 1][n][3]);
        }
      }
    } else {
      gemm_core(acc, wbase + W_GATE + (size_t)layer * 1024 * 1024 + (size_t)n0 * 1024, hmb + (size_t)m0 * 1024, 1024, lds);
      float* outp = uniform_ptr(P.out);
#pragma unroll
      for (int n = 0; n < 4; ++n) {
        const int tok = m0 + wc * 64 + n * 16 + fr;
        const float rstd = rsqrtf(sum8(ssqm + (size_t)tok * 8) * (1.f / 1024.f) + EPS);
        float sq = 0.f;
        f32x4 hh[8];
        uint2 e8[8];
#pragma unroll
        for (int m = 0; m < 8; ++m) {
          const int f = n0 + wr * 128 + m * 16 + fq * 4;
          hh[m] = *(const f32x4*)(outp + (size_t)tok * DM + f);
          e8[m] = *(const uint2*)(eb + (size_t)tok * DM + f);
        }
        asm volatile("" : "+v"(hh[0]), "+v"(hh[1]), "+v"(hh[2]), "+v"(hh[3]), "+v"(hh[4]), "+v"(hh[5]), "+v"(hh[6]), "+v"(hh[7]));
#pragma unroll
        for (int m = 0; m < 8; ++m) {
          const int f = n0 + wr * 128 + m * 16 + fq * 4;
          float4 hv = make_float4(hh[m][0], hh[m][1], hh[m][2], hh[m][3]);
          const uint2 ee = e8[m];
          hv.x += bf2f(ee.x & 0xffffu) / (1.f + __expf(-acc[m][n][0] * rstd));
          hv.y += bf2f(ee.x >> 16) / (1.f + __expf(-acc[m][n][1] * rstd));
          hv.z += bf2f(ee.y & 0xffffu) / (1.f + __expf(-acc[m][n][2] * rstd));
          hv.w += bf2f(ee.y >> 16) / (1.f + __expf(-acc[m][n][3] * rstd));
          sq += hv.x * hv.x + hv.y * hv.y + hv.z * hv.z + hv.w * hv.w;
          *(float4*)(outp + (size_t)tok * DM + f) = hv;
          if ((layer & 1) == 0) *(unsigned*)((unsigned char*)hb + (size_t)tok * DM + f) = pack4_fp8c(hv.x, hv.y, hv.z, hv.w);
          else if (layer != 3) store4bf(hb + (size_t)tok * DM + f, hv.x, hv.y, hv.z, hv.w);
        }
        sq = quad_sum(sq);
        if (fq == 0) ssqh[(size_t)tok * 8 + nt * 2 + wr] = sq;
      }
    }
  }
}

template <bool MLA>
DI void attn_phase(const Params& P, int layer, char* lds) {
  constexpr int DQK = MLA ? 96 : 64;
  constexpr int KSTR = DQK * 2 + 16;
  constexpr int VSTR = 144;
  constexpr int KBYTES = 64 * KSTR;
  constexpr int ASTAGE = KBYTES + 64 * VSTR;
  constexpr int NKS = DQK / 16;
  const int tid = get_tid();
  const int lane = tid & 63, w = tid >> 6;
  const int r = lane & 31, h = lane >> 5;
  char* ws = uniform_ptr(P.ws);
  const bf16_t* qg = (const bf16_t*)(ws + OFF_Q);
  const bf16_t* kg = (const bf16_t*)(ws + OFF_K);
  const bf16_t* vtg = (const bf16_t*)(ws + OFF_VT);
  const bf16_t* krg = (const bf16_t*)(ws + OFF_KR);
  const bf16_t* zg = (const bf16_t*)(ws + OFF_Z);
  bf16_t* og = (bf16_t*)(ws + OFF_HB);
  const int j = layer >> 1;

  const int nitems = 2048;
  for (int item = blockIdx.x; item < nitems; item += gridDim.x) {
    int b, head, hkv, q0, t_lo, t_hi;
    int nheads_kv;
    if constexpr (MLA) {
      const int xcd = item & 7, slot = (item >> 3) & 31, grp = item >> 8;
      const int bh = grp * 8 + xcd;
      b = bh >> 4;
      head = bh & 15;
      hkv = head;
      nheads_kv = 16;
      q0 = slot * 256 + w * 32;
      t_lo = 0;
      t_hi = S / 64;
    } else {
      const int hp = item & 7, qblk = (item >> 3) & 63;
      b = item >> 9;
      head = hp * 2 + (w >> 2);
      hkv = hp >> 1;
      nheads_kv = 4;
      const int t0 = qblk * 128;
      q0 = t0 + (w & 3) * 32;
      const int lo = (t0 - 128 > 0) ? (t0 - 128) : 0;
      const int hi = (t0 + 256 < S) ? (t0 + 256) : S;
      t_lo = lo >> 6;
      t_hi = hi >> 6;
    }
    const int qld = MLA ? 1536 : 1024;
    const int tokq = b * S + q0 + r;
    bf16x8 qf[NKS];
#pragma unroll
    for (int ks = 0; ks < NKS; ++ks)
      qf[ks] = *(const bf16x8*)(qg + (size_t)tokq * qld + head * DQK + ks * 16 + 8 * h);

    float m_run, l_run;
    float slope2 = 0.f;
    if constexpr (MLA) {
      m_run = 0.f;
      l_run = 0.f;
    } else {
      m_run = P.a_sink[j * 16 + head] * LOG2E;
      l_run = (h == 0) ? 1.f : 0.f;
      slope2 = exp2f(-0.5f * (float)(head + 1)) * LOG2E;
    }
    f32x16 o[2], negm;
#pragma unroll
    for (int i = 0; i < 16; ++i) { o[0][i] = 0.f; o[1][i] = 0.f; negm[i] = -m_run; }

    const int lrow = tid >> 3, lc = tid & 7;
    uint4 kreg, vreg, rreg;
    auto load_regs = [&](int t) {
      const int kbase = t * 64;
      if constexpr (MLA) {
        kreg = *(const uint4*)(kg + (size_t)(b * S + kbase + lrow) * 1024 + head * 64 + lc * 8);
        if (tid < 256) rreg = *(const uint4*)(krg + (size_t)(b * S + kbase + (tid >> 2)) * 32 + (tid & 3) * 8);
      } else {
        kreg = *(const uint4*)(kg + (size_t)(b * S + kbase + lrow) * 256 + hkv * 64 + lc * 8);
      }
      vreg = *(const uint4*)(vtg + ((size_t)(b * nheads_kv + hkv) * 64 + lrow) * S + kbase + lc * 8);
    };
    auto write_lds = [&](int st) {
      char* base = lds + st * ASTAGE;
      *(uint4*)(base + lrow * KSTR + lc * 16) = kreg;
      if constexpr (MLA) {
        if (tid < 256) *(uint4*)(base + (tid >> 2) * KSTR + 128 + (tid & 3) * 16) = rreg;
      }
      *(uint4*)(base + KBYTES + lrow * VSTR + lc * 16) = vreg;
    };

    __syncthreads();
    load_regs(t_lo);
    write_lds(0);
    __syncthreads();
#pragma unroll 1
    for (int t = t_lo; t < t_hi; ++t) {
      load_regs((t + 1 < t_hi) ? (t + 1) : t);
      const char* base = lds + ((t - t_lo) & 1) * ASTAGE;
      const int kbase = t * 64;
      bool active = true;
      if constexpr (!MLA) active = (kbase + 63 >= q0 - 128) && (kbase <= q0 + 159);
      if (active) {
        f32x16 sc[2];
        {
          bf16x8 kf[2][NKS];
#pragma unroll
          for (int kb = 0; kb < 2; ++kb)
#pragma unroll
            for (int ks = 0; ks < NKS; ++ks) kf[kb][ks] = *(const bf16x8*)(base + (kb * 32 + r) * KSTR + h * 16 + ks * 32);
#pragma unroll
          for (int kb = 0; kb < 2; ++kb) {
            sc[kb] = MFMA(kf[kb][0], qf[0], negm);
#pragma unroll
            for (int ks = 1; ks < NKS; ++ks) sc[kb] = MFMA(kf[kb][ks], qf[ks], sc[kb]);
          }
        }
        if constexpr (!MLA) {
          const int tq = q0 + r;
#pragma unroll
          for (int kb = 0; kb < 2; ++kb)
#pragma unroll
            for (int i = 0; i < 16; ++i) {
              const int kp = kbase + kb * 32 + crow(i, h);
              int d = kp - tq;
              d = d < 0 ? -d : d;
              sc[kb][i] = (d <= 128) ? (sc[kb][i] - slope2 * (float)d) : -1e30f;
            }
        }
        int imx = max(__float_as_int(sc[0][0]), __float_as_int(sc[1][0]));
#pragma unroll
        for (int i = 1; i < 16; ++i) imx = max(imx, max(__float_as_int(sc[0][i]), __float_as_int(sc[1][i])));
        bool slow = __any(imx > 0x41000000);
        if constexpr (MLA) slow = slow || (t == t_lo);
        if (slow) {
          float mx = fmaxf(sc[0][0], sc[1][0]);
#pragma unroll
          for (int i = 1; i < 16; ++i) mx = fmaxf(mx, fmaxf(sc[0][i], sc[1][i]));
          mx = xhalf_max(mx);
          float delta = fmaxf(mx, 0.f);
          if constexpr (MLA) { if (t == t_lo) delta = mx; }
          float alpha = __builtin_amdgcn_exp2f(-delta);
          if constexpr (MLA) { if (t == t_lo) alpha = 1.f; }
          m_run += delta;
          l_run *= alpha;
#pragma unroll
          for (int i = 0; i < 16; ++i) {
            o[0][i] *= alpha;
            o[1][i] *= alpha;
            sc[0][i] -= delta;
            sc[1][i] -= delta;
            negm[i] = -m_run;
          }
        }
        f32x2_t ps2 = {0.f, 0.f};
        bf16x8 pf[2][2];
#pragma unroll
        for (int kb = 0; kb < 2; ++kb) {
#pragma unroll
          for (int i = 0; i < 16; i += 2) {
            const float p0 = __builtin_amdgcn_exp2f(sc[kb][i]);
            const float p1 = __builtin_amdgcn_exp2f(sc[kb][i + 1]);
            sc[kb][i] = p0;
            sc[kb][i + 1] = p1;
            ps2 += f32x2_t{p0, p1};
          }
#pragma unroll
          for (int sidx = 0; sidx < 2; ++sidx) {
            uint4 u;
            u.x = pack2(sc[kb][8 * sidx + 0], sc[kb][8 * sidx + 1]);
            u.y = pack2(sc[kb][8 * sidx + 2], sc[kb][8 * sidx + 3]);
            u.z = pack2(sc[kb][8 * sidx + 4], sc[kb][8 * sidx + 5]);
            u.w = pack2(sc[kb][8 * sidx + 6], sc[kb][8 * sidx + 7]);
            pf[kb][sidx] = __builtin_bit_cast(bf16x8, u);
          }
        }
        l_run += ps2[0] + ps2[1];
#pragma unroll
        for (int db = 0; db < 2; ++db) {
          const char* lv = base + KBYTES + (db * 32 + r) * VSTR + h * 16;
#pragma unroll
          for (int kb = 0; kb < 2; ++kb)
#pragma unroll
            for (int sidx = 0; sidx < 2; ++sidx) {
              bf16x8 vf = *(const bf16x8*)(lv + kb * 64 + sidx * 32);
              o[db] = MFMA(vf, pf[kb][sidx], o[db]);
            }
        }
      }
      write_lds((t + 1 - t_lo) & 1);
      __syncthreads();
    }
    const float l_tot = l_run + __shfl_xor(l_run, 32);
    const float inv = 1.f / l_tot;
#pragma unroll
    for (int db = 0; db < 2; ++db)
#pragma unroll
      for (int g = 0; g < 4; ++g) {
        const int d = db * 32 + 8 * g + 4 * h;
        const size_t off = (size_t)tokq * 1024 + head * 64 + d;
        const uint2 zz = *(const uint2*)(zg + off);
        const float z0 = bf2f(zz.x & 0xffffu), z1 = bf2f(zz.x >> 16), z2 = bf2f(zz.y & 0xffffu), z3 = bf2f(zz.y >> 16);
        const float g0 = z0 / (1.f + __expf(-z0)), g1 = z1 / (1.f + __expf(-z1)), g2 = z2 / (1.f + __expf(-z2)),
                    g3 = z3 / (1.f + __expf(-z3));
        store4bf(og + off, o[db][4 * g] * inv * g0, o[db][4 * g + 1] * inv * g1, o[db][4 * g + 2] * inv * g2,
                 o[db][4 * g + 3] * inv * g3);
      }
  }
}

typedef __attribute__((ext_vector_type(8))) int i32x8;
#define MFMA8(a, b, c) __builtin_amdgcn_mfma_scale_f32_32x32x64_f8f6f4((a), (b), (c), 0, 0, 0, 0x7f7f7f7f, 0, 0x7f7f7f7f)
DI unsigned pack4_fp8(float a, float b, float c, float d) {
  int r = __builtin_amdgcn_cvt_pk_fp8_f32(a, b, 0, false);
  r = __builtin_amdgcn_cvt_pk_fp8_f32(c, d, r, true);
  return (unsigned)r;
}
DI float clamp8(float x) { return __builtin_amdgcn_fmed3f(x, -440.f, 440.f); }
DI unsigned pack4_fp8c(float a, float b, float c, float d) { return pack4_fp8(clamp8(a), clamp8(b), clamp8(c), clamp8(d)); }
DI int perm64(int s) {
  const int c = (s >> 2) & 15;
  const int pc = ((c & 1) << 3) | (c >> 1);
  return (s & ~63) | (pc << 2) | (s & 3);
}
DI i32x8 ld32(const char* p) {
  const uint4 a = *(const uint4*)p, b = *(const uint4*)(p + 16);
  i32x8 r = {(int)a.x, (int)a.y, (int)a.z, (int)a.w, (int)b.x, (int)b.y, (int)b.z, (int)b.w};
  return r;
}

DI void attn_mla8_phase(const Params& P, char* lds) {
  constexpr int KSTR = 144;
  constexpr int VSTR = 80;
  constexpr int KBYTES = 64 * KSTR;
  constexpr int ASTAGE = KBYTES + 64 * VSTR;
  constexpr float PBIAS = 4.f;
  const int tid = get_tid();
  const int lane = tid & 63, w = tid >> 6;
  const int r = lane & 31, h = lane >> 5;
  char* ws = uniform_ptr(P.ws);
  const unsigned char* qg = (const unsigned char*)(ws + OFF_Q);
  const unsigned char* kg = (const unsigned char*)(ws + OFF_K);
  const unsigned char* vtg = (const unsigned char*)(ws + OFF_VT);
  const unsigned char* krg = (const unsigned char*)(ws + OFF_KR);
  const bf16_t* zg = (const bf16_t*)(ws + OFF_Z);
  bf16_t* og = (bf16_t*)(ws + OFF_HB);

  __syncthreads();
  if (tid < 384) {
    const int zr = tid >> 1, zs = tid >> 7;
    *(uint4*)(lds + zs * ASTAGE + (zr & 63) * KSTR + 96 + (tid & 1) * 16) = make_uint4(0u, 0u, 0u, 0u);
  }
  for (int item = blockIdx.x; item < 2048; item += gridDim.x) {
    const int xcd = item & 7, slot = (item >> 3) & 31, grp = item >> 8;
    const int bh = grp * 8 + xcd;
    const int b = bh >> 4, head = bh & 15;
    const int q0 = slot * 256 + w * 32;
    const int tokq = b * S + q0 + r;
    const unsigned char* qrow = qg + (size_t)tokq * 1536 + head * 96;
    const i32x8 qn = ld32((const char*)qrow + 32 * h);
    i32x8 qr = ld32((const char*)qrow + 64);
    if (h) qr = i32x8{0, 0, 0, 0, 0, 0, 0, 0};

    float m_run = 0.f, l_run = 0.f;
    f32x16 o[2], negm;
#pragma unroll
    for (int i = 0; i < 16; ++i) { o[0][i] = 0.f; o[1][i] = 0.f; negm[i] = PBIAS; }

    const int lrow = (tid & 255) >> 2, lc = tid & 3;
    const bool isk = tid < 256;
    const unsigned char* gmain = isk ? (kg + (size_t)(b * S + lrow) * 1024 + head * 64 + lc * 16)
                                     : (vtg + ((size_t)(b * 16 + head) * 64 + lrow) * S + lc * 16);
    const int gstep = isk ? 65536 : 64;
    const int lmain = isk ? (lrow * KSTR + lc * 16) : (KBYTES + lrow * VSTR + lc * 16);
    const int rrow = (tid & 127) >> 1, rc = tid & 1;
    const unsigned char* grope = krg + (size_t)(b * S + rrow) * 32 + rc * 16;
    const int lrope = rrow * KSTR + 64 + rc * 16;
    uint4 areg, rreg;
    const int trot = (slot * 4) & (S / 64 - 1);
#define MLA8_LOAD(t_)                                             \
  do {                                                            \
    const int tp_ = ((t_) + trot) & (S / 64 - 1);                 \
    areg = *(const uint4*)(gmain + (size_t)tp_ * gstep);          \
    rreg = *(const uint4*)(grope + (size_t)tp_ * 2048);           \
  } while (0)
#define MLA8_WRITE(st_)                                           \
  do {                                                            \
    char* wb_ = lds + (st_) * ASTAGE;                             \
    *(uint4*)(wb_ + lmain) = areg;                                \
    if (tid < 128) *(uint4*)(wb_ + lrope) = rreg;                 \
  } while (0)

    i32x8 kn[2], kr[2];
    __syncthreads();
    MLA8_LOAD(0);
    MLA8_WRITE(0);
    MLA8_LOAD(1);
    MLA8_WRITE(1);
    __syncthreads();
#pragma unroll
    for (int kb = 0; kb < 2; ++kb) {
      const char* lk = lds + (kb * 32 + r) * KSTR;
      kn[kb] = ld32(lk + 32 * h);
      kr[kb] = ld32(lk + 64 + 32 * h);
    }
    int st_cur = 0;
#pragma unroll 1
    for (int t = 0; t < S / 64; ++t) {
      MLA8_LOAD((t + 2 < S / 64) ? (t + 2) : (S / 64 - 1));
      const char* base = lds + st_cur * ASTAGE;
      const int st_nxt = (st_cur == 2) ? 0 : st_cur + 1;
      const int st_wr = (st_nxt == 2) ? 0 : st_nxt + 1;
      f32x16 sc[2];
      i32x8 vf[2];
      vf[0] = ld32(base + KBYTES + r * VSTR + 32 * h);
      vf[1] = ld32(base + KBYTES + (32 + r) * VSTR + 32 * h);
#pragma unroll
      for (int kb = 0; kb < 2; ++kb) {
        sc[kb] = MFMA8(kn[kb], qn, negm);
        sc[kb] = MFMA8(kr[kb], qr, sc[kb]);
      }
      int imx = max(__float_as_int(sc[0][0]), __float_as_int(sc[1][0]));
#pragma unroll
      for (int i = 1; i < 16; ++i) imx = max(imx, max(__float_as_int(sc[0][i]), __float_as_int(sc[1][i])));
      const bool slow = __any(imx > 0x41000000) || (t == 0);
      if (slow) {
        float mx = fmaxf(sc[0][0], sc[1][0]);
#pragma unroll
        for (int i = 1; i < 16; ++i) mx = fmaxf(mx, fmaxf(sc[0][i], sc[1][i]));
        mx = xhalf_max(mx);
        float delta = fmaxf(mx - PBIAS, 0.f);
        float alpha = __builtin_amdgcn_exp2f(-delta);
        if (t == 0) { delta = mx - PBIAS; alpha = 1.f; }
        m_run += delta;
        l_run *= alpha;
#pragma unroll
        for (int i = 0; i < 16; ++i) {
          o[0][i] *= alpha;
          o[1][i] *= alpha;
          sc[0][i] -= delta;
          sc[1][i] -= delta;
          negm[i] = PBIAS - m_run;
        }
      }
      f32x2_t ps2 = {0.f, 0.f};
      i32x8 pb;
#pragma unroll
      for (int kb = 0; kb < 2; ++kb) {
#pragma unroll
        for (int i = 0; i < 16; i += 2) {
          const f32x2_t tt = f32x2_t{sc[kb][i], sc[kb][i + 1]} * f32x2_t{8388608.f, 8388608.f} + f32x2_t{1065353216.f, 1065353216.f};
          const float p0 = __uint_as_float((unsigned)tt[0]);
          const float p1 = __uint_as_float((unsigned)tt[1]);
          sc[kb][i] = p0;
          sc[kb][i + 1] = p1;
          ps2 += f32x2_t{p0, p1};
        }
#pragma unroll
        for (int q4 = 0; q4 < 4; ++q4)
          pb[kb * 4 + q4] = (int)pack4_fp8(sc[kb][4 * q4], sc[kb][4 * q4 + 1], sc[kb][4 * q4 + 2], sc[kb][4 * q4 + 3]);
      }
      l_run += ps2[0] + ps2[1];
#pragma unroll
      for (int db = 0; db < 2; ++db) {
        o[db] = MFMA8(vf[db], pb, o[db]);
      }
      {
        const char* nb = lds + st_nxt * ASTAGE;
#pragma unroll
        for (int kb = 0; kb < 2; ++kb) {
          const char* lk = nb + (kb * 32 + r) * KSTR;
          kn[kb] = ld32(lk + 32 * h);
          kr[kb] = ld32(lk + 64 + 32 * h);
        }
      }
      MLA8_WRITE(st_wr);
      __syncthreads();
      st_cur = st_nxt;
    }
    const float l_tot = l_run + __shfl_xor(l_run, 32);
    const float inv = 1.f / l_tot;
#pragma unroll
    for (int db = 0; db < 2; ++db)
#pragma unroll
      for (int g = 0; g < 4; ++g) {
        const int d = db * 32 + 8 * g + 4 * h;
        const size_t off = (size_t)tokq * 1024 + head * 64 + d;
        const uint2 zz = *(const uint2*)(zg + off);
        const float z0 = bf2f(zz.x & 0xffffu), z1 = bf2f(zz.x >> 16), z2 = bf2f(zz.y & 0xffffu), z3 = bf2f(zz.y >> 16);
        const float g0 = z0 / (1.f + __expf(-z0)), g1 = z1 / (1.f + __expf(-z1)), g2 = z2 / (1.f + __expf(-z2)),
                    g3 = z3 / (1.f + __expf(-z3));
        const float i64 = inv * 16.f;
        *(unsigned*)((unsigned char*)og + off) = pack4_fp8c(o[db][4 * g] * i64 * g0, o[db][4 * g + 1] * i64 * g1, o[db][4 * g + 2] * i64 * g2,
                                                         o[db][4 * g + 3] * i64 * g3);
      }
  }
#undef MLA8_LOAD
#undef MLA8_WRITE
}

DI void final_phase(const Params& P) {
  const int tid = get_tid();
  const int w = tid >> 6, lane = tid & 63;
  for (int row = blockIdx.x * 8 + w; row < T; row += gridDim.x * 8) {
    float4* xr = (float4*)(P.out + (size_t)row * DM);
    float4 v[4];
    float s = 0.f;
#pragma unroll
    for (int i = 0; i < 4; ++i) {
      v[i] = xr[lane + 64 * i];
      s += v[i].x * v[i].x + v[i].y * v[i].y + v[i].z * v[i].z + v[i].w * v[i].w;
    }
#pragma unroll
    for (int o = 32; o >= 1; o >>= 1) s += __shfl_xor(s, o);
    const float rstd = rsqrtf(s * (1.f / 1024.f) + EPS);
#pragma unroll
    for (int i = 0; i < 4; ++i) {
      const float4 g = ((const float4*)P.final_g)[lane + 64 * i];
      xr[lane + 64 * i] = make_float4(v[i].x * rstd * g.x, v[i].y * rstd * g.y, v[i].z * rstd * g.z, v[i].w * rstd * g.w);
    }
  }
}

#define XB_TMO      128
#define XB_XCNT(j)  (256  + 64 * (j))
#define XB_XSUB(j)  (1280 + 64 * (j))
#define XB_XGEN(j)  (2304 + 64 * (j))
#define XB_TOP      3328
#define XB_TOPGEN   3392
#define XCD_BAR_WORDS 3456
#define XB_SPIN_CAP (1u << 22)
#define LAS __attribute__((address_space(3)))
DI unsigned xb_ld(unsigned* p) { return __hip_atomic_load(p, __ATOMIC_RELAXED, __HIP_MEMORY_SCOPE_AGENT); }
DI unsigned xb_add(unsigned* p, unsigned v) { return __hip_atomic_fetch_add(p, v, __ATOMIC_RELAXED, __HIP_MEMORY_SCOPE_AGENT); }
DI unsigned xb_xcc_id() { return (unsigned)__builtin_amdgcn_s_getreg((3 << 11) | 20) & 0xFu; }
#define XB_SPIN(cond, bar) do { unsigned _sp = 0; while (cond) { __builtin_amdgcn_s_sleep(1); \
    if ((++_sp & 255u) == 0u) { if (xb_ld(&(bar)[XB_TMO])) break; if (_sp > XB_SPIN_CAP) { atomicAdd(&(bar)[XB_TMO], 1u); break; } } } } while (0)
struct XcdBarrier {
  unsigned* bar;
  unsigned x;
  volatile LAS unsigned* st;
};
DI XcdBarrier xcd_barrier_post(unsigned* bar, volatile LAS unsigned* st) {
  XcdBarrier b;
  b.bar = bar;
  b.x = xb_xcc_id();
  b.st = st;
  if (threadIdx.x == 0) (void)xb_add(&bar[XB_XCNT(b.x)], 1u);
  return b;
}
DI void xcd_barrier_complete(unsigned* bar, unsigned x, unsigned& nloc, unsigned& nx) {
  const unsigned G = gridDim.x * gridDim.y * gridDim.z;
  unsigned sum, cnt, mine, sp = 0u;
  for (;;) {
    sum = 0u; cnt = 0u; mine = 0u;
#pragma unroll
    for (unsigned j = 0; j < 16; ++j) {
      const unsigned c = xb_ld(&bar[XB_XCNT(j)]);
      sum += c;
      cnt += (c > 0u) ? 1u : 0u;
      mine = (j == x) ? c : mine;
    }
    if (sum == G) break;
    __builtin_amdgcn_s_sleep(1);
    if ((++sp & 255u) == 0u) { if (xb_ld(&bar[XB_TMO])) break; if (sp > XB_SPIN_CAP) { atomicAdd(&bar[XB_TMO], 1u); break; } }
  }
  nloc = mine > 0u ? mine : 1u;
  nx = cnt > 0u ? cnt : 1u;
}
DI void xcd_barrier(const XcdBarrier& b) {
  asm volatile("s_waitcnt vmcnt(0)" ::: "memory");
  __syncthreads();
  if (threadIdx.x == 0) {
    unsigned* bar = b.bar;
    __builtin_amdgcn_s_waitcnt(0);
    unsigned nloc = b.st[0], nx = b.st[1];
    if (nloc == 0u) { xcd_barrier_complete(bar, b.x, nloc, nx); b.st[0] = nloc; b.st[1] = nx; }
    const unsigned old = xb_add(&bar[XB_XSUB(b.x)], 1u);
    const unsigned gen = old / nloc;
    if (old + 1u == (gen + 1u) * nloc) {
      __builtin_amdgcn_fence(__ATOMIC_RELEASE, "agent");
      asm volatile("s_waitcnt vmcnt(0)" ::: "memory");
      const unsigned og = xb_add(&bar[XB_TOP], 1u);
      const unsigned tg = og / nx;
      if (og + 1u == (tg + 1u) * nx) xb_add(&bar[XB_TOPGEN], 1u);
      else XB_SPIN(xb_ld(&bar[XB_TOPGEN]) == tg, bar);
      __builtin_amdgcn_fence(__ATOMIC_ACQUIRE, "agent");
      xb_add(&bar[XB_XGEN(b.x)], 1u);
      asm volatile("s_waitcnt vmcnt(0)" ::: "memory");
    } else {
      XB_SPIN(xb_ld(&bar[XB_XGEN(b.x)]) == gen, bar);
      __builtin_amdgcn_fence(__ATOMIC_ACQUIRE, "agent");
      asm volatile("s_waitcnt vmcnt(0)" ::: "memory");
    }
  }
  __syncthreads();
}

constexpr int NPHASE = 1 + 2 * (4 + 5) + 1;

DI void run_phase(const Params& P, int ph, char* lds) {
  if (ph == 0) { prep_phase(P, lds); return; }
  if (ph == NPHASE - 1) { final_phase(P); return; }
  const int q = (ph - 1) / 9, rr = (ph - 1) % 9;
  if (rr < 4) {
    const int layer = q * 2;
    if (rr == 0) gemm_phase<EPI_A_IN>(P, layer, lds);
    else if (rr == 1) attn_phase<false>(P, layer, lds);
    else if (rr == 2) gemm_phase<EPI_OUT>(P, layer, lds);
    else gemm_phase<EPI_PLE>(P, layer, lds);
  } else {
    const int layer = q * 2 + 1;
    if (rr == 4) gemm_phase<EPI_B_IN>(P, layer, lds);
    else if (rr == 5) gemm_phase<EPI_QKV_UP>(P, layer, lds);
    else if (rr == 6) attn_phase<true>(P, layer, lds);
    else if (rr == 7) gemm_phase<EPI_OUT>(P, layer, lds);
    else gemm_phase<EPI_PLE>(P, layer, lds);
  }
}

__global__ void __launch_bounds__(NTHREADS) fwd_kernel(Params P) {
  __shared__ __attribute__((aligned(1024))) char lds[LDS_BYTES + 16];
#if MULTI_LAUNCH
  run_phase(P, P.phase_lo, lds);
#else
  cg::grid_group grid = cg::this_grid();
  volatile LAS unsigned* xst = (volatile LAS unsigned*)(lds + LDS_BYTES);
  if (threadIdx.x == 0) { xst[0] = 0u; xst[1] = 0u; }
  __syncthreads();
  const XcdBarrier xb = xcd_barrier_post((unsigned*)(P.ws + OFF_BAR), xst);
  prep_phase(P, lds);
#if (PROBE_REPEAT >> 9) & 1
  prep_phase(P, lds);
#endif
  grid.sync();
#pragma unroll 1
  for (int q = 0; q < 2; ++q) {
    const int la = 2 * q, lb = 2 * q + 1;
    gemm_phase<EPI_A_IN>(P, la, lds);
#if (PROBE_REPEAT >> 0) & 1
    gemm_phase<EPI_A_IN>(P, la, lds);
#endif
    GSYNC();
    attn_phase<false>(P, la, lds);
#if (PROBE_REPEAT >> 1) & 1
    attn_phase<false>(P, la, lds);
#endif
    GSYNC();
    gemm_phase<EPI_OUT>(P, la, lds);
    GSYNC();
    gemm_phase<EPI_PLE>(P, la, lds);
    GSYNC();
    gemm_phase<EPI_B_IN>(P, lb, lds);
#if (PROBE_REPEAT >> 4) & 1
    gemm_phase<EPI_B_IN>(P, lb, lds);
#endif
    GSYNC();
    gemm_phase<EPI_QKV_UP>(P, lb, lds);
#if (PROBE_REPEAT >> 5) & 1
    gemm_phase<EPI_QKV_UP>(P, lb, lds);
#endif
    GSYNC();
    attn_mla8_phase(P, lds);
#if (PROBE_REPEAT >> 6) & 1
    attn_mla8_phase(P, lds);
#endif
    GSYNC();
    gemm_phase<EPI_OUT>(P, lb, lds);
    GSYNC();
    gemm_phase<EPI_PLE>(P, lb, lds);
    GSYNC();
  }
  final_phase(P);
#endif
}

static void add_seg(Params& p, int& tiles, const float* src, const float* gain, bf16_t* dst, int src_ld, int ncols, int K, int fp8 = 0) {
  Seg& s = p.seg[p.nseg++];
  s.src = src;
  s.gain = gain;
  s.dst = dst;
  s.src_ld = src_ld;
  s.ncols = ncols;
  s.K = K;
  s.fp8 = fp8;
  s.pad0 = 0;
  s.tile0 = tiles;
  tiles += (K / 64) * (ncols / 32);
}

extern "C" void kernel_launch(void* const* d_in, const int* in_sizes, int n_in, void* d_out, int out_size, void* d_ws,
                              size_t ws_size, hipStream_t stream) {
  (void)in_sizes; (void)n_in; (void)out_size;
  if (ws_size < WS_NEEDED) {
    fprintf(stderr, "workspace too small: %zu < %zu\n", ws_size, (size_t)WS_NEEDED);
    return;
  }
  const float* x = (const float*)d_in[0];
  const float* pp = (const float*)d_in[1];
  const float* norm_g = (const float*)d_in[2];
  const float* a_w_in = (const float*)d_in[3];
  const float* a_sink = (const float*)d_in[4];
  const float* a_w_out = (const float*)d_in[5];
  const float* b_w_in = (const float*)d_in[6];
  const float* b_q_norm = (const float*)d_in[7];
  const float* b_w_qb = (const float*)d_in[8];
  const float* b_kv_norm = (const float*)d_in[9];
  const float* b_w_kvb = (const float*)d_in[10];
  const float* b_w_out = (const float*)d_in[11];
  const float* ple_w = (const float*)d_in[12];
  const float* ple_norm_g = (const float*)d_in[13];
  const float* ple_w_gate = (const float*)d_in[14];
  const float* final_g = (const float*)d_in[15];

  Params p;
  memset(&p, 0, sizeof(p));
  p.x = x;
  p.p = pp;
  p.a_sink = a_sink;
  p.final_g = final_g;
  p.out = (float*)d_out;
  p.ws = (char*)d_ws;
  bf16_t* wb = (bf16_t*)((char*)d_ws + OFF_W);
  int tiles = 0;
  for (int j = 0; j < 2; ++j) {
    const int la = 2 * j, lb = 2 * j + 1;
    add_seg(p, tiles, a_w_in + (size_t)j * 1024 * 2560, norm_g + la * 1024, wb + W_A_IN + (size_t)j * 2560 * 1024, 2560, 2560, 1024);
    add_seg(p, tiles, a_w_out + (size_t)j * 1024 * 1024, nullptr, wb + W_A_OUT + (size_t)j * 1024 * 1024, 1024, 1024, 1024);
    const float* bsrc = b_w_in + (size_t)j * 1024 * 1696;
    unsigned char* bdst = (unsigned char*)(wb + W_B_IN + (size_t)j * 1792 * 1024);
    const float* gb = norm_g + lb * 1024;
    add_seg(p, tiles, bsrc + 672, gb, (bf16_t*)bdst, 1696, 1024, 1024, 1);
    add_seg(p, tiles, bsrc + 0, gb, (bf16_t*)(bdst + (size_t)1024 * 1024), 1696, 384, 1024, 1);
    add_seg(p, tiles, bsrc + 384, gb, (bf16_t*)(bdst + (size_t)1408 * 1024), 1696, 256, 1024, 1);
    add_seg(p, tiles, bsrc + 640, gb, (bf16_t*)(bdst + (size_t)1664 * 1024), 1696, 32, 1024, 1);
    add_seg(p, tiles, nullptr, nullptr, (bf16_t*)(bdst + (size_t)1696 * 1024), 1696, 96, 1024, 1);
    add_seg(p, tiles, b_w_qb + (size_t)j * 384 * 1536, b_q_norm + j * 384, wb + W_B_QB + (size_t)j * 1536 * 384, 1536, 1536, 384, 1);
    add_seg(p, tiles, b_w_kvb + (size_t)j * 256 * 2048, b_kv_norm + j * 256, wb + W_B_KVB + (size_t)j * 2048 * 256, 2048, 2048, 256, 1);
    add_seg(p, tiles, b_w_out + (size_t)j * 1024 * 1024, nullptr, wb + W_B_OUT + (size_t)j * 1024 * 1024, 1024, 1024, 1024, 1);
  }
  for (int i = 0; i < 4; ++i) {
    add_seg(p, tiles, ple_w + (size_t)i * 256 * 1024, nullptr, wb + W_PLE + (size_t)i * 1024 * 256, 1024, 1024, 256);
    add_seg(p, tiles, ple_w_gate + (size_t)i * 1024 * 1024, ple_norm_g + i * 1024, wb + W_GATE + (size_t)i * 1024 * 1024, 1024, 1024, 1024);
  }
  p.ntile_w = tiles;

#if MULTI_LAUNCH
  for (int ph = 0; ph < NPHASE; ++ph) {
    p.phase_lo = ph;
    p.phase_hi = ph + 1;
    hipLaunchKernelGGL(fwd_kernel, dim3(1024), dim3(NTHREADS), 0, stream, p);
  }
#else
  static int grid_blocks = 0;
  if (!grid_blocks) {
    int dev = 0, cus = 0, per_cu = 0;
    hipGetDevice(&dev);
    hipDeviceGetAttribute(&cus, hipDeviceAttributeMultiprocessorCount, dev);
    hipOccupancyMaxActiveBlocksPerMultiprocessor(&per_cu, fwd_kernel, NTHREADS, 0);
    if (per_cu < 1) per_cu = 1;
    if (per_cu > 1) per_cu = 1;
    grid_blocks = cus * per_cu;
  }
  p.phase_lo = 0;
  p.phase_hi = NPHASE;
  (void)hipMemsetAsync((char*)d_ws + OFF_BAR, 0, 16384, stream);
  void* args[] = {&p};
  hipError_t e = hipLaunchCooperativeKernel((void*)fwd_kernel, dim3(grid_blocks), dim3(NTHREADS), args, 0, stream);
  if (e != hipSuccess) fprintf(stderr, "cooperative launch failed: %s (grid %d)\n", hipGetErrorString(e), grid_blocks);
#endif
}
```

```cpp
#include <hip/hip_runtime.h>
#include <hip/hip_cooperative_groups.h>
#include <cstdio>
#include <cstring>
namespace cg = cooperative_groups;

#ifndef PROBE_REPEAT
#define PROBE_REPEAT 0
#endif
#ifndef PROBE_SYNC2
#define PROBE_SYNC2 0
#endif
#if PROBE_SYNC2
#define GSYNC() do { xcd_barrier(xb); xcd_barrier(xb); } while (0)
#else
#define GSYNC() xcd_barrier(xb)
#endif
#ifndef MULTI_LAUNCH
#define MULTI_LAUNCH 0
#endif

#define DI __device__ __forceinline__
typedef __attribute__((ext_vector_type(8))) short bf16x8;
typedef __attribute__((ext_vector_type(16))) float f32x16;
typedef unsigned short bf16_t;

constexpr int T = 32768, S = 8192, NB = 4, DM = 1024, PLE = 256;
constexpr int NTHREADS = 512;
constexpr float LOG2E = 1.4426950408889634f;
constexpr float EPS = 1e-6f;

constexpr size_t MiB = 1024ull * 1024ull;
constexpr size_t OFF_HB = 0;
constexpr size_t OFF_Z = 64 * MiB;
constexpr size_t OFF_Q = 128 * MiB;
constexpr size_t OFF_K = 224 * MiB;
constexpr size_t OFF_VT = 288 * MiB;
constexpr size_t OFF_CQ = 352 * MiB;
constexpr size_t OFF_CKV = 376 * MiB;
constexpr size_t OFF_KR = 392 * MiB;
constexpr size_t OFF_SSQH = 394 * MiB;
constexpr size_t OFF_SSQM = 395 * MiB;
constexpr size_t OFF_SSQC = 396 * MiB;
constexpr size_t OFF_ROPE = 397 * MiB;
constexpr size_t OFF_W = 398 * MiB;
constexpr size_t OFF_PB = 438 * MiB;
constexpr size_t OFF_BAR = 502 * MiB;
constexpr size_t W_A_IN = 0;
constexpr size_t W_A_OUT = W_A_IN + 2ull * 2560 * 1024;
constexpr size_t W_B_IN = W_A_OUT + 2ull * 1024 * 1024;
constexpr size_t W_B_QB = W_B_IN + 2ull * 1792 * 1024;
constexpr size_t W_B_KVB = W_B_QB + 2ull * 1536 * 384;
constexpr size_t W_B_OUT = W_B_KVB + 2ull * 2048 * 256;
constexpr size_t W_PLE = W_B_OUT + 2ull * 1024 * 1024;
constexpr size_t W_GATE = W_PLE + 4ull * 1024 * 256;
constexpr size_t W_END = W_GATE + 4ull * 1024 * 1024;
static_assert(OFF_W + W_END * 2 <= OFF_PB, "weights overflow");
constexpr size_t WS_NEEDED = OFF_BAR + 1 * MiB;

struct Seg {
  const float* src;
  const float* gain;
  bf16_t* dst;
  int src_ld, ncols, K, tile0;
  int fp8, pad0;
};
constexpr int MAXSEG = 32;

struct Params {
  const float *x, *p, *a_sink, *final_g;
  float* out;
  char* ws;
  Seg seg[MAXSEG];
  int nseg, ntile_w;
  int phase_lo, phase_hi;
};

typedef __attribute__((ext_vector_type(2))) float f32x2_t;
typedef __attribute__((ext_vector_type(2))) __bf16 bf16x2_t;
DI unsigned pack2(float a, float b) {
  f32x2_t v = {a, b};
  return __builtin_bit_cast(unsigned, __builtin_convertvector(v, bf16x2_t));
}
DI unsigned f2bf(float x) { return pack2(x, 0.f) & 0xffffu; }
DI float xhalf_max(float x) {
  return fmaxf(x, __shfl_xor(x, 32));
}
DI float bf2f(unsigned h) { return __uint_as_float(h << 16); }
DI int crow(int i, int h) { return (i & 3) + 8 * (i >> 2) + 4 * h; }
DI int perm16(int s) {
  int k = s & 15;
  int c = k >> 2;
  int pc = ((c & 1) << 1) | (c >> 1);
  return (s & ~15) | (pc << 2) | (k & 3);
}
#define MFMA(a, b, c) __builtin_amdgcn_mfma_f32_32x32x16_bf16((a), (b), (c), 0, 0, 0)
DI int get_tid() {
  int t = threadIdx.x;
  asm volatile("" : "+v"(t));
  return t;
}
template <typename TP>
DI TP* uniform_ptr(TP* p) {
  unsigned lo = (unsigned)(size_t)p, hi = (unsigned)((size_t)p >> 32);
  lo = __builtin_amdgcn_readfirstlane(lo);
  hi = __builtin_amdgcn_readfirstlane(hi);
  asm volatile("" : "+s"(lo), "+s"(hi));
  return (TP*)(((size_t)hi << 32) | (size_t)lo);
}
DI unsigned pack4_fp8(float a, float b, float c, float d);
DI unsigned pack4_fp8c(float a, float b, float c, float d);
DI float clamp8(float x);
DI float wave_xor_sum32(float v) { return v + __shfl_xor(v, 32); }

DI void prep_phase(const Params& P, char* lds) {
  const int tid = get_tid();
  {
    const int w = tid >> 6, lane = tid & 63;
    float* tl = (float*)lds + w * (64 * 33);
    for (int t = blockIdx.x * 8 + w; t < P.ntile_w; t += gridDim.x * 8) {
      int si = 0;
      for (int i = 1; i < P.nseg; ++i)
        if (t >= P.seg[i].tile0) si = i;
      const Seg sg = P.seg[si];
      const int lt = t - sg.tile0;
      const int ncb = sg.ncols >> 5;
      const int kb = lt / ncb, nb = lt - kb * ncb;
      const int k0 = kb * 64, n0 = nb * 32;
      {
        const int n = lane & 31, kofs = lane >> 5;
        float vv[32];
#pragma unroll
        for (int i = 0; i < 32; ++i) {
          const int k = kofs + 2 * i;
          float v = 0.f;
          if (sg.src) {
            v = sg.src[(size_t)(k0 + k) * sg.src_ld + n0 + n];
            if (sg.gain) v *= sg.gain[k0 + k];
          }
          vv[i] = v;
        }
#pragma unroll
        for (int i = 0; i < 32; ++i) tl[(kofs + 2 * i) * 33 + n] = vv[i];
      }
      __builtin_amdgcn_fence(__ATOMIC_RELEASE, "wavefront");
      __builtin_amdgcn_wave_barrier();
      __builtin_amdgcn_fence(__ATOMIC_ACQUIRE, "wavefront");
#pragma unroll
      for (int jj = 0; jj < 8; ++jj) {
        const int j = lane + 64 * jj;
        const int kk4 = (j & 15) * 4, n = j >> 4;
        const float w0 = tl[(kk4 + 0) * 33 + n], w1 = tl[(kk4 + 1) * 33 + n], w2 = tl[(kk4 + 2) * 33 + n], w3 = tl[(kk4 + 3) * 33 + n];
        if (sg.fp8) {
          *(unsigned*)((unsigned char*)sg.dst + (size_t)(n0 + n) * sg.K + k0 + kk4) = pack4_fp8c(w0 * 64.f, w1 * 64.f, w2 * 64.f, w3 * 64.f);
        } else {
          uint2 o2;
          o2.x = pack2(w0, w1);
          o2.y = pack2(w2, w3);
          *(uint2*)(sg.dst + (size_t)(n0 + n) * sg.K + k0 + kk4) = o2;
        }
      }
      __builtin_amdgcn_fence(__ATOMIC_RELEASE, "wavefront");
      __builtin_amdgcn_wave_barrier();
    }
  }
  {
    char* ws = uniform_ptr(P.ws);
    bf16_t* hb = (bf16_t*)(ws + OFF_HB);
    float* ssq = (float*)(ws + OFF_SSQH);
    const int w = tid >> 6, lane = tid & 63;
    const int rstride = gridDim.x * 8;
    for (int row = blockIdx.x * 8 + w; row < T; row += 4 * rstride) {
      float4 xv[4][4];
#pragma unroll
      for (int u = 0; u < 4; ++u) {
        const int ru = (row + u * rstride < T) ? (row + u * rstride) : row;
        const float4* xr = (const float4*)(P.x + (size_t)ru * DM);
#pragma unroll
        for (int i = 0; i < 4; ++i) xv[u][i] = xr[lane + 64 * i];
      }
#pragma unroll
      for (int u = 0; u < 4; ++u) {
        const int ru = row + u * rstride;
        float s = 0.f;
#pragma unroll
        for (int i = 0; i < 4; ++i) {
          const float4 v = xv[u][i];
          s += v.x * v.x + v.y * v.y + v.z * v.z + v.w * v.w;
          uint2 o;
          o.x = pack2(v.x, v.y);
          o.y = pack2(v.z, v.w);
          if (ru < T) *(uint2*)(hb + (size_t)ru * DM + (lane + 64 * i) * 4) = o;
        }
#pragma unroll
        for (int o = 32; o >= 1; o >>= 1) s += __shfl_xor(s, o);
        if (lane < 8 && ru < T) ssq[(size_t)ru * 8 + lane] = (lane == 0) ? s : 0.f;
      }
    }
  }
  {
    bf16_t* pb = (bf16_t*)(uniform_ptr(P.ws) + OFF_PB);
    const size_t n8 = (size_t)4 * T * PLE / 8;
    for (size_t e = (size_t)blockIdx.x * NTHREADS + tid; e < n8; e += (size_t)gridDim.x * NTHREADS) {
      const float4 v0 = ((const float4*)P.p)[2 * e], v1 = ((const float4*)P.p)[2 * e + 1];
      uint4 o;
      o.x = pack2(v0.x, v0.y);
      o.y = pack2(v0.z, v0.w);
      o.z = pack2(v1.x, v1.y);
      o.w = pack2(v1.z, v1.w);
      ((uint4*)pb)[e] = o;
    }
  }
  {
    float* rt = (float*)(uniform_ptr(P.ws) + OFF_ROPE);
    for (int e = blockIdx.x * NTHREADS + tid; e < S * 16; e += gridDim.x * NTHREADS) {
      const int s = e >> 4, i = e & 15;
      const double inv = exp2(-(double)i * (13.287712379549449 / 16.0));
      const double rev = (double)s * inv * 0.15915494309189535;
      const float fr = (float)(rev - floor(rev));
      rt[s * 32 + i] = __builtin_amdgcn_cosf(fr);
      rt[s * 32 + 16 + i] = __builtin_amdgcn_sinf(fr);
    }
  }
}

typedef __attribute__((ext_vector_type(4))) float f32x4;
constexpr int GBK = 64, GKS = 2;
constexpr int GTILE_B = 256 * GBK * 2;
constexpr int GSTAGE_B = 2 * GTILE_B;
constexpr int LDS_BYTES = 2 * GSTAGE_B;

DI int lds_byte(int r, int c) {
  int st = (r >> 4) * GKS + (c >> 5), ob = (r & 15) * 64 + (c & 31) * 2;
  return st * 1024 + (ob ^ (((ob >> 9) & 1) << 5));
}
DI void stage_rc(int b, int& R, int& C) {
  int st = b >> 10, sb = b & 1023, swz = sb ^ (((sb >> 9) & 1) << 5);
  R = (st / GKS) * 16 + swz / 64;
  C = (st % GKS) * 32 + (swz % 64) / 2;
}
#define WAIT_V0() asm volatile("s_waitcnt vmcnt(0)" ::: "memory")

DI void gemm_core(f32x4 (&acc)[8][4], const bf16_t* Wb, const bf16_t* Xb, int K, char* shm) {
  const int tid = get_tid();
  const int wid = tid >> 6, lane = tid & 63, wr = wid >> 2, wc = wid & 3, fr = lane & 15, fq = lane >> 4;
  int sR[4], sC[4];
#pragma unroll
  for (int i = 0; i < 4; ++i) stage_rc(wid * 1024 + i * 8192 + lane * 16, sR[i], sC[i]);
  const int nt = K / GBK;
#define GSRC(base, i, kt) ((base) + (size_t)sR[i] * K + (kt) * GBK + sC[i])
#define GLDS_STAGE(buf, kt)                                                                                           \
  do {                                                                                                                \
    _Pragma("unroll") for (int i = 0; i < 4; ++i) {                                                                   \
      __builtin_amdgcn_global_load_lds((const unsigned*)GSRC(Wb, i, kt),                                             \
                                       (unsigned*)(shm + (buf) * GSTAGE_B + wid * 1024 + i * 8192), 16, 0, 0);        \
      __builtin_amdgcn_global_load_lds((const unsigned*)GSRC(Xb, i, kt),                                             \
                                       (unsigned*)(shm + (buf) * GSTAGE_B + GTILE_B + wid * 1024 + i * 8192), 16, 0, 0); \
    }                                                                                                                 \
  } while (0)
  __syncthreads();
  GLDS_STAGE(0, 0);
  WAIT_V0();
  __syncthreads();
#pragma unroll 1
  for (int t = 0; t < nt; ++t) {
    const int cur = t & 1;
    if (t + 1 < nt) GLDS_STAGE(cur ^ 1, t + 1);
    const char* sa = shm + cur * GSTAGE_B;
    const char* sb = sa + GTILE_B;
#pragma unroll
    for (int ks = 0; ks < GKS; ++ks) {
      bf16x8 At[8], Bf[4];
#pragma unroll
      for (int m = 0; m < 8; ++m) At[m] = *(const bf16x8*)(sa + lds_byte(wr * 128 + m * 16 + fr, ks * 32 + fq * 8));
#pragma unroll
      for (int n = 0; n < 4; ++n) Bf[n] = *(const bf16x8*)(sb + lds_byte(wc * 64 + n * 16 + fr, ks * 32 + fq * 8));
#pragma unroll
      for (int m = 0; m < 8; ++m)
#pragma unroll
        for (int n = 0; n < 4; ++n) acc[m][n] = __builtin_amdgcn_mfma_f32_16x16x32_bf16(At[m], Bf[n], acc[m][n], 0, 0, 0);
      __builtin_amdgcn_sched_barrier(0);
    }
    WAIT_V0();
    __syncthreads();
  }
#undef GSRC
#undef GLDS_STAGE
}

typedef __attribute__((ext_vector_type(8))) int i32x8g;
DI i32x8g ld32g(const char* p0, const char* p1) {
  const uint4 a = *(const uint4*)p0, b = *(const uint4*)p1;
  i32x8g r = {(int)a.x, (int)a.y, (int)a.z, (int)a.w, (int)b.x, (int)b.y, (int)b.z, (int)b.w};
  return r;
}
DI void gemm_core8(f32x4 (&acc)[8][4], const unsigned char* Wb, const unsigned char* Xb, int K, char* shm, int sw, int sx) {
  const int tid = get_tid();
  const int wid = tid >> 6, lane = tid & 63, wr = wid >> 2, wc = wid & 3, fr = lane & 15, fq = lane >> 4;
  int sR[4], sC[4];
#pragma unroll
  for (int i = 0; i < 4; ++i) stage_rc(wid * 1024 + i * 8192 + lane * 16, sR[i], sC[i]);
  const int nt = K / 128;
#define GSRC8(base, i, kt) ((base) + (size_t)sR[i] * K + (kt) * 128 + sC[i] * 2)
#define GLDS_STAGE8(buf, kt)                                                                                          \
  do {                                                                                                                \
    _Pragma("unroll") for (int i = 0; i < 4; ++i) {                                                                   \
      __builtin_amdgcn_global_load_lds((const unsigned*)GSRC8(Wb, i, kt),                                            \
                                       (unsigned*)(shm + (buf) * GSTAGE_B + wid * 1024 + i * 8192), 16, 0, 0);        \
      __builtin_amdgcn_global_load_lds((const unsigned*)GSRC8(Xb, i, kt),                                            \
                                       (unsigned*)(shm + (buf) * GSTAGE_B + GTILE_B + wid * 1024 + i * 8192), 16, 0, 0); \
    }                                                                                                                 \
  } while (0)
  __syncthreads();
  GLDS_STAGE8(0, 0);
  WAIT_V0();
  __syncthreads();
#pragma unroll 1
  for (int t = 0; t < nt; ++t) {
    const int cur = t & 1;
    if (t + 1 < nt) GLDS_STAGE8(cur ^ 1, t + 1);
    const char* sa = shm + cur * GSTAGE_B;
    const char* sb = sa + GTILE_B;
    i32x8g Bf[4];
#pragma unroll
    for (int n = 0; n < 4; ++n)
      Bf[n] = ld32g(sb + lds_byte(wc * 64 + n * 16 + fr, fq * 8), sb + lds_byte(wc * 64 + n * 16 + fr, 32 + fq * 8));
#pragma unroll
    for (int mh = 0; mh < 2; ++mh) {
      i32x8g At[4];
#pragma unroll
      for (int m = 0; m < 4; ++m)
        At[m] = ld32g(sa + lds_byte(wr * 128 + (mh * 4 + m) * 16 + fr, fq * 8), sa + lds_byte(wr * 128 + (mh * 4 + m) * 16 + fr, 32 + fq * 8));
#pragma unroll
      for (int m = 0; m < 4; ++m)
#pragma unroll
        for (int n = 0; n < 4; ++n)
          acc[mh * 4 + m][n] = __builtin_amdgcn_mfma_scale_f32_16x16x128_f8f6f4(At[m], Bf[n], acc[mh * 4 + m][n], 0, 0, 0, sw, 0, sx);
    }
    __builtin_amdgcn_sched_barrier(0);
    WAIT_V0();
    __syncthreads();
  }
#undef GSRC8
#undef GLDS_STAGE8
}
constexpr int SC_ONE = 0x7f7f7f7f;
constexpr int SC_M6 = 0x79797979;
constexpr int SC_M4 = 0x7b7b7b7b;

DI float sum8(const float* p) {
  const float4* q = (const float4*)p;
  float4 a = q[0], b = q[1];
  return (a.x + a.y + a.z + a.w) + (b.x + b.y + b.z + b.w);
}
DI float quad_sum(float v) {
  v += __shfl_xor(v, 16);
  v += __shfl_xor(v, 32);
  return v;
}

DI unsigned pack4_fp8(float a, float b, float c, float d);
DI int perm64(int s);
enum { EPI_A_IN = 0, EPI_B_IN = 1, EPI_QKV_UP = 2, EPI_OUT = 3, EPI_PLE = 4 };

DI void store4bf(bf16_t* dst, float a, float b, float c, float d) {
  uint2 o;
  o.x = pack2(a, b);
  o.y = pack2(c, d);
  *(uint2*)dst = o;
}
DI void store_pair_bf(bf16_t* dst, int fq, float a0, float a1, float a2, float a3, float b0, float b1, float b2, float b3) {
  const unsigned ax = pack2(a0, a1), ay = pack2(a2, a3), bx = pack2(b0, b1), by = pack2(b2, b3);
  auto r0 = __builtin_amdgcn_permlane16_swap(ax, bx, false, false);
  auto r1 = __builtin_amdgcn_permlane16_swap(ay, by, false, false);
  *(uint4*)(dst + (fq & 1) * 16 + (fq >> 1) * 8) = make_uint4(r0[0], r1[0], r0[1], r1[1]);
}
DI void store_vt4(bf16_t* dst, float a, float b, float c, float d) {
  dst[0] = (bf16_t)f2bf(a);
  dst[S] = (bf16_t)f2bf(b);
  dst[2 * S] = (bf16_t)f2bf(c);
  dst[3 * S] = (bf16_t)f2bf(d);
}

template <int EPI>
DI void gemm_phase(const Params& P, int layer, char* lds) {
  const int tid = get_tid();
  const int wid = tid >> 6, lane = tid & 63, wr = wid >> 2, wc = wid & 3, fr = lane & 15, fq = lane >> 4;
  const int j = layer >> 1;
  char* ws = uniform_ptr(P.ws);
  bf16_t* wbase = (bf16_t*)(ws + OFF_W);
  bf16_t* hb = (bf16_t*)(ws + OFF_HB);
  bf16_t* og = (bf16_t*)(ws + OFF_HB);
  bf16_t* zb = (bf16_t*)(ws + OFF_Z);
  bf16_t* hmb = (bf16_t*)(ws + OFF_Z);
  bf16_t* qb = (bf16_t*)(ws + OFF_Q);
  bf16_t* eb = (bf16_t*)(ws + OFF_Q);
  bf16_t* kb = (bf16_t*)(ws + OFF_K);
  bf16_t* vt = (bf16_t*)(ws + OFF_VT);
  bf16_t* cqb = (bf16_t*)(ws + OFF_CQ);
  bf16_t* ckvb = (bf16_t*)(ws + OFF_CKV);
  bf16_t* krb = (bf16_t*)(ws + OFF_KR);
  const bf16_t* pbb = (const bf16_t*)(ws + OFF_PB);
  float* ssqh = (float*)(ws + OFF_SSQH);
  float* ssqm = (float*)(ws + OFF_SSQM);
  float* ssqc = (float*)(ws + OFF_SSQC);
  const float* rope = (const float*)(ws + OFF_ROPE);

  int NT, ntiles;
  if constexpr (EPI == EPI_A_IN) { NT = 10; ntiles = 128 * 10; }
  else if constexpr (EPI == EPI_B_IN) { NT = 7; ntiles = 128 * 7; }
  else if constexpr (EPI == EPI_QKV_UP) { NT = 14; ntiles = 128 * 14; }
  else if constexpr (EPI == EPI_OUT) { NT = 4; ntiles = 128 * 8; }
  else { NT = 4; ntiles = 128 * 4; }

  for (int tile = blockIdx.x; tile < ntiles; tile += gridDim.x) {
    int t2 = tile;
    bool second = false;
    if constexpr (EPI == EPI_OUT) {
      if (t2 >= 512) { second = true; t2 -= 512; }
    }
    int mt = t2 / NT, nt = t2 - mt * NT;
    if (gridDim.x == 256) {
      const int x = blockIdx.x & 7, s = blockIdx.x >> 3, k = t2 >> 8;
      const int idx = s + 32 * k;
      mt = (idx / NT) * 8 + x;
      nt = idx - (idx / NT) * NT;
    }
    const int m0 = mt * 256, n0 = nt * 256;
    f32x4 acc[8][4];
#pragma unroll
    for (int m = 0; m < 8; ++m)
#pragma unroll
      for (int n = 0; n < 4; ++n) acc[m][n] = f32x4{0.f, 0.f, 0.f, 0.f};

    if constexpr (EPI == EPI_A_IN) {
      gemm_core(acc, wbase + W_A_IN + (size_t)j * 2560 * 1024 + (size_t)n0 * 1024, hb + (size_t)m0 * 1024, 1024, lds);
      const float qs = 0.125f * LOG2E;
#pragma unroll
      for (int n = 0; n < 4; ++n) {
        const int tok = m0 + wc * 64 + n * 16 + fr;
        const float rstd = rsqrtf(sum8(ssqh + (size_t)tok * 8) * (1.f / 1024.f) + EPS);
        const int b = tok >> 13, s = tok & (S - 1);
        if (nt == 5) {
#pragma unroll
          for (int m = 0; m < 8; ++m) {
            const int f = n0 + wr * 128 + m * 16 + fq * 4;
            store_vt4(vt + ((size_t)(b * 4) * 64 + (f - 1280)) * S + perm16(s), acc[m][n][0] * rstd, acc[m][n][1] * rstd,
                      acc[m][n][2] * rstd, acc[m][n][3] * rstd);
          }
        } else {
          const float sc_ = (nt < 4) ? rstd * qs : rstd;
          const int fg = n0 + wr * 128;
          bf16_t* rowp = (nt < 4) ? (qb + (size_t)tok * 1024 + fg) : (nt == 4) ? (kb + (size_t)tok * 256 + (fg - 1024))
                                                                              : (zb + (size_t)tok * 1024 + (fg - 1536));
#pragma unroll
          for (int m = 0; m < 8; m += 2)
            store_pair_bf(rowp + m * 16, fq, acc[m][n][0] * sc_, acc[m][n][1] * sc_, acc[m][n][2] * sc_, acc[m][n][3] * sc_,
                          acc[m + 1][n][0] * sc_, acc[m + 1][n][1] * sc_, acc[m + 1][n][2] * sc_, acc[m + 1][n][3] * sc_);
        }
      }
    } else if constexpr (EPI == EPI_B_IN) {
      gemm_core8(acc, (const unsigned char*)(wbase + W_B_IN + (size_t)j * 1792 * 1024) + (size_t)n0 * 1024, (const unsigned char*)hb + (size_t)m0 * 1024, 1024, lds, SC_M6, SC_ONE);
      const int fbase = n0 + wr * 128;
#pragma unroll
      for (int n = 0; n < 4; ++n) {
        const int tok = m0 + wc * 64 + n * 16 + fr;
        const float rstd = rsqrtf(sum8(ssqh + (size_t)tok * 8) * (1.f / 1024.f) + EPS);
        const int s = tok & (S - 1);
        if (fbase < 1024) {
#pragma unroll
          for (int m = 0; m < 8; m += 2)
            store_pair_bf(zb + (size_t)tok * 1024 + fbase + m * 16, fq, acc[m][n][0] * rstd, acc[m][n][1] * rstd, acc[m][n][2] * rstd,
                          acc[m][n][3] * rstd, acc[m + 1][n][0] * rstd, acc[m + 1][n][1] * rstd, acc[m + 1][n][2] * rstd,
                          acc[m + 1][n][3] * rstd);
        } else if (fbase < 1664) {
          float sq = 0.f;
          const bool iscq = fbase < 1408;
#pragma unroll
          for (int m = 0; m < 8; ++m) {
            const float v0 = acc[m][n][0] * rstd, v1 = acc[m][n][1] * rstd, v2 = acc[m][n][2] * rstd, v3 = acc[m][n][3] * rstd;
            sq += v0 * v0 + v1 * v1 + v2 * v2 + v3 * v3;
            const int f = fbase + m * 16 + fq * 4;
            if (iscq) *(unsigned*)((unsigned char*)cqb + (size_t)tok * 384 + (f - 1024)) = pack4_fp8c(v0, v1, v2, v3);
            else *(unsigned*)((unsigned char*)ckvb + (size_t)tok * 256 + (f - 1408)) = pack4_fp8c(v0, v1, v2, v3);
          }
          sq = quad_sum(sq);
          if (fq == 0) {
            const int pi = iscq ? ((fbase - 1024) >> 7) : (4 + ((fbase - 1408) >> 7));
            ssqc[(size_t)tok * 8 + pi] = sq;
          }
        } else {
          const float4 cs = *(const float4*)(rope + s * 32 + fq * 4);
          const float4 sn = *(const float4*)(rope + s * 32 + 16 + fq * 4);
          const float x10 = acc[0][n][0] * rstd, x11 = acc[0][n][1] * rstd, x12 = acc[0][n][2] * rstd, x13 = acc[0][n][3] * rstd;
          const float x20 = acc[1][n][0] * rstd, x21 = acc[1][n][1] * rstd, x22 = acc[1][n][2] * rstd, x23 = acc[1][n][3] * rstd;
          unsigned char* kr8 = (unsigned char*)krb;
          *(unsigned*)(kr8 + (size_t)tok * 32 + fq * 4) =
              pack4_fp8c(x10 * cs.x - x20 * sn.x, x11 * cs.y - x21 * sn.y, x12 * cs.z - x22 * sn.z, x13 * cs.w - x23 * sn.w);
          *(unsigned*)(kr8 + (size_t)tok * 32 + 16 + fq * 4) =
              pack4_fp8c(x10 * sn.x + x20 * cs.x, x11 * sn.y + x21 * cs.y, x12 * sn.z + x22 * cs.z, x13 * sn.w + x23 * cs.w);
        }
      }
    } else if constexpr (EPI == EPI_QKV_UP) {
      if (nt < 6) {
        gemm_core8(acc, (const unsigned char*)(wbase + W_B_QB + (size_t)j * 1536 * 384) + (size_t)n0 * 384, (const unsigned char*)cqb + (size_t)m0 * 384, 384, lds, SC_M6, SC_ONE);
        const float qs = 0.10206207261596575f * LOG2E;
#pragma unroll
        for (int n = 0; n < 4; ++n) {
          const int tok = m0 + wc * 64 + n * 16 + fr;
          const float* pc = ssqc + (size_t)tok * 8;
          const float rstd = rsqrtf((pc[0] + pc[1] + pc[2]) * (1.f / 384.f) + EPS) * qs;
          const int s = tok & (S - 1);
          const float4 cs = *(const float4*)(rope + s * 32 + fq * 4);
          const float4 sn = *(const float4*)(rope + s * 32 + 16 + fq * 4);
#pragma unroll
          for (int mp = 0; mp < 4; ++mp) {
            const int fb = n0 + wr * 128 + mp * 32;
            const int cb = fb >> 5;
            unsigned char* dst = (unsigned char*)qb + (size_t)tok * 1536 + fb + fq * 4;
            const float x10 = acc[2 * mp][n][0] * rstd, x11 = acc[2 * mp][n][1] * rstd, x12 = acc[2 * mp][n][2] * rstd,
                        x13 = acc[2 * mp][n][3] * rstd;
            const float x20 = acc[2 * mp + 1][n][0] * rstd, x21 = acc[2 * mp + 1][n][1] * rstd, x22 = acc[2 * mp + 1][n][2] * rstd,
                        x23 = acc[2 * mp + 1][n][3] * rstd;
            if ((cb % 3) == 2) {
              *(unsigned*)dst = pack4_fp8c(x10 * cs.x - x20 * sn.x, x11 * cs.y - x21 * sn.y, x12 * cs.z - x22 * sn.z, x13 * cs.w - x23 * sn.w);
              *(unsigned*)(dst + 16) = pack4_fp8c(x10 * sn.x + x20 * cs.x, x11 * sn.y + x21 * cs.y, x12 * sn.z + x22 * cs.z, x13 * sn.w + x23 * cs.w);
            } else {
              *(unsigned*)dst = pack4_fp8c(x10, x11, x12, x13);
              *(unsigned*)(dst + 16) = pack4_fp8c(x20, x21, x22, x23);
            }
          }
        }
      } else {
        const int n0k = (nt - 6) * 256;
        gemm_core8(acc, (const unsigned char*)(wbase + W_B_KVB + (size_t)j * 2048 * 256) + (size_t)n0k * 256, (const unsigned char*)ckvb + (size_t)m0 * 256, 256, lds, SC_M6, SC_ONE);
        const int hd = (nt - 6) * 2 + wr;
#pragma unroll
        for (int n = 0; n < 4; ++n) {
          const int tok = m0 + wc * 64 + n * 16 + fr;
          const float* pc = ssqc + (size_t)tok * 8 + 4;
          const float rstd = rsqrtf((pc[0] + pc[1]) * (1.f / 256.f) + EPS);
          const int b = tok >> 13, s = tok & (S - 1);
#pragma unroll
          for (int m = 0; m < 8; ++m) {
            const float v0 = acc[m][n][0] * rstd, v1 = acc[m][n][1] * rstd, v2 = acc[m][n][2] * rstd, v3 = acc[m][n][3] * rstd;
            if (m < 4) {
              *(unsigned*)((unsigned char*)kb + (size_t)tok * 1024 + hd * 64 + m * 16 + fq * 4) = pack4_fp8c(v0, v1, v2, v3);
            } else {
              const float p0 = __shfl_xor(v0, 1), p1 = __shfl_xor(v1, 1), p2 = __shfl_xor(v2, 1), p3 = __shfl_xor(v3, 1);
              const bool odd = fr & 1;
              const float a0 = odd ? p2 : v0, b0 = odd ? v2 : p0;
              const float a1 = odd ? p3 : v1, b1 = odd ? v3 : p1;
              const int d = (m - 4) * 16 + fq * 4 + (odd ? 2 : 0);
              unsigned char* dst = (unsigned char*)vt + ((size_t)(b * 16 + hd) * 64 + d) * S + perm64(s & ~1);
              *(unsigned short*)dst = (unsigned short)(__builtin_amdgcn_cvt_pk_fp8_f32(clamp8(a0), clamp8(b0), 0, false) & 0xffff);
              *(unsigned short*)(dst + S) = (unsigned short)(__builtin_amdgcn_cvt_pk_fp8_f32(clamp8(a1), clamp8(b1), 0, false) & 0xffff);
            }
          }
        }
      }
    } else if constexpr (EPI == EPI_OUT) {
      if (!second) {
        if (layer & 1) {
          const unsigned char* wt = (const unsigned char*)(wbase + W_B_OUT + (size_t)j * 1024 * 1024);
          gemm_core8(acc, wt + (size_t)n0 * 1024, (const unsigned char*)og + (size_t)m0 * 1024, 1024, lds, SC_M6, SC_M4);
        } else {
          gemm_core(acc, wbase + W_A_OUT + (size_t)j * 1024 * 1024 + (size_t)n0 * 1024, og + (size_t)m0 * 1024, 1024, lds);
        }
        float* outp = uniform_ptr(P.out);
        const float* resid = (layer == 0) ? uniform_ptr(P.x) : outp;
#pragma unroll
        for (int n = 0; n < 4; ++n) {
          const int tok = m0 + wc * 64 + n * 16 + fr;
          float sq = 0.f;
          f32x4 rr[8];
#pragma unroll
          for (int m = 0; m < 8; ++m) rr[m] = *(const f32x4*)(resid + (size_t)tok * DM + n0 + wr * 128 + m * 16 + fq * 4);
          asm volatile("" : "+v"(rr[0]), "+v"(rr[1]), "+v"(rr[2]), "+v"(rr[3]), "+v"(rr[4]), "+v"(rr[5]), "+v"(rr[6]), "+v"(rr[7]));
#pragma unroll
          for (int m = 0; m < 8; m += 2) {
            const int f = n0 + wr * 128 + m * 16 + fq * 4;
            float4 rv = make_float4(rr[m][0], rr[m][1], rr[m][2], rr[m][3]);
            float4 rw = make_float4(rr[m + 1][0], rr[m + 1][1], rr[m + 1][2], rr[m + 1][3]);
            rv.x += acc[m][n][0];
            rv.y += acc[m][n][1];
            rv.z += acc[m][n][2];
            rv.w += acc[m][n][3];
            rw.x += acc[m + 1][n][0];
            rw.y += acc[m + 1][n][1];
            rw.z += acc[m + 1][n][2];
            rw.w += acc[m + 1][n][3];
            sq += rv.x * rv.x + rv.y * rv.y + rv.z * rv.z + rv.w * rv.w;
            sq += rw.x * rw.x + rw.y * rw.y + rw.z * rw.z + rw.w * rw.w;
            *(float4*)(outp + (size_t)tok * DM + f) = rv;
            *(float4*)(outp + (size_t)tok * DM + f + 16) = rw;
            store_pair_bf(hmb + (size_t)tok * DM + n0 + wr * 128 + m * 16, fq, rv.x, rv.y, rv.z, rv.w, rw.x, rw.y, rw.z, rw.w);
          }
          sq = quad_sum(sq);
          if (fq == 0) ssqm[(size_t)tok * 8 + nt * 2 + wr] = sq;
        }
      } else {
        gemm_core(acc, wbase + W_PLE + (size_t)layer * 1024 * 256 + (size_t)n0 * 256, pbb + ((size_t)layer * T + m0) * 256, 256, lds);
#pragma unroll
        for (int n = 0; n < 4; ++n) {
          const int tok = m0 + wc * 64 + n * 16 + fr;
#pragma unroll
          for (int m = 0; m < 8; m += 2)
            store_pair_bf(eb + (size_t)tok * DM + n0 + wr * 128 + m * 16, fq, acc[m][n][0], acc[m][n][1], acc[m][n][2], acc[m][n][3],
                          acc[m + 1][n][0], acc[m + 1][n][1], acc[m + 1][n][2], acc[m + 1][n][3]);
        }
      }
    } else {
      gemm_core(acc, wbase + W_GATE + (size_t)layer * 1024 * 1024 + (size_t)n0 * 1024, hmb + (size_t)m0 * 1024, 1024, lds);
      float* outp = uniform_ptr(P.out);
#pragma unroll
      for (int n = 0; n < 4; ++n) {
        const int tok = m0 + wc * 64 + n * 16 + fr;
        const float rstd = rsqrtf(sum8(ssqm + (size_t)tok * 8) * (1.f / 1024.f) + EPS);
        float sq = 0.f;
        f32x4 hh[8];
        uint2 e8[8];
#pragma unroll
        for (int m = 0; m < 8; ++m) {
          const int f = n0 + wr * 128 + m * 16 + fq * 4;
          hh[m] = *(const f32x4*)(outp + (size_t)tok * DM + f);
          e8[m] = *(const uint2*)(eb + (size_t)tok * DM + f);
        }
        asm volatile("" : "+v"(hh[0]), "+v"(hh[1]), "+v"(hh[2]), "+v"(hh[3]), "+v"(hh[4]), "+v"(hh[5]), "+v"(hh[6]), "+v"(hh[7]));
#pragma unroll
        for (int m = 0; m < 8; ++m) {
          const int f = n0 + wr * 128 + m * 16 + fq * 4;
          float4 hv = make_float4(hh[m][0], hh[m][1], hh[m][2], hh[m][3]);
          const uint2 ee = e8[m];
          hv.x += bf2f(ee.x & 0xffffu) / (1.f + __expf(-acc[m][n][0] * rstd));
          hv.y += bf2f(ee.x >> 16) / (1.f + __expf(-acc[m][n][1] * rstd));
          hv.z += bf2f(ee.y & 0xffffu) / (1.f + __expf(-acc[m][n][2] * rstd));
          hv.w += bf2f(ee.y >> 16) / (1.f + __expf(-acc[m][n][3] * rstd));
          sq += hv.x * hv.x + hv.y * hv.y + hv.z * hv.z + hv.w * hv.w;
          *(float4*)(outp + (size_t)tok * DM + f) = hv;
          if ((layer & 1) == 0) *(unsigned*)((unsigned char*)hb + (size_t)tok * DM + f) = pack4_fp8c(hv.x, hv.y, hv.z, hv.w);
          else if (layer != 3) store4bf(hb + (size_t)tok * DM + f, hv.x, hv.y, hv.z, hv.w);
        }
        sq = quad_sum(sq);
        if (fq == 0) ssqh[(size_t)tok * 8 + nt * 2 + wr] = sq;
      }
    }
  }
}

template <bool MLA>
DI void attn_phase(const Params& P, int layer, char* lds) {
  constexpr int DQK = MLA ? 96 : 64;
  constexpr int KSTR = DQK * 2 + 16;
  constexpr int VSTR = 144;
  constexpr int KBYTES = 64 * KSTR;
  constexpr int ASTAGE = KBYTES + 64 * VSTR;
  constexpr int NKS = DQK / 16;
  const int tid = get_tid();
  const int lane = tid & 63, w = tid >> 6;
  const int r = lane & 31, h = lane >> 5;
  char* ws = uniform_ptr(P.ws);
  const bf16_t* qg = (const bf16_t*)(ws + OFF_Q);
  const bf16_t* kg = (const bf16_t*)(ws + OFF_K);
  const bf16_t* vtg = (const bf16_t*)(ws + OFF_VT);
  const bf16_t* krg = (const bf16_t*)(ws + OFF_KR);
  const bf16_t* zg = (const bf16_t*)(ws + OFF_Z);
  bf16_t* og = (bf16_t*)(ws + OFF_HB);
  const int j = layer >> 1;

  const int nitems = 2048;
  for (int item = blockIdx.x; item < nitems; item += gridDim.x) {
    int b, head, hkv, q0, t_lo, t_hi;
    int nheads_kv;
    if constexpr (MLA) {
      const int xcd = item & 7, slot = (item >> 3) & 31, grp = item >> 8;
      const int bh = grp * 8 + xcd;
      b = bh >> 4;
      head = bh & 15;
      hkv = head;
      nheads_kv = 16;
      q0 = slot * 256 + w * 32;
      t_lo = 0;
      t_hi = S / 64;
    } else {
      const int hp = item & 7, qblk = (item >> 3) & 63;
      b = item >> 9;
      head = hp * 2 + (w >> 2);
      hkv = hp >> 1;
      nheads_kv = 4;
      const int t0 = qblk * 128;
      q0 = t0 + (w & 3) * 32;
      const int lo = (t0 - 128 > 0) ? (t0 - 128) : 0;
      const int hi = (t0 + 256 < S) ? (t0 + 256) : S;
      t_lo = lo >> 6;
      t_hi = hi >> 6;
    }
    const int qld = MLA ? 1536 : 1024;
    const int tokq = b * S + q0 + r;
    bf16x8 qf[NKS];
#pragma unroll
    for (int ks = 0; ks < NKS; ++ks)
      qf[ks] = *(const bf16x8*)(qg + (size_t)tokq * qld + head * DQK + ks * 16 + 8 * h);

    float m_run, l_run;
    float slope2 = 0.f;
    if constexpr (MLA) {
      m_run = 0.f;
      l_run = 0.f;
    } else {
      m_run = P.a_sink[j * 16 + head] * LOG2E;
      l_run = (h == 0) ? 1.f : 0.f;
      slope2 = exp2f(-0.5f * (float)(head + 1)) * LOG2E;
    }
    f32x16 o[2], negm;
#pragma unroll
    for (int i = 0; i < 16; ++i) { o[0][i] = 0.f; o[1][i] = 0.f; negm[i] = -m_run; }

    const int lrow = tid >> 3, lc = tid & 7;
    uint4 kreg, vreg, rreg;
    auto load_regs = [&](int t) {
      const int kbase = t * 64;
      if constexpr (MLA) {
        kreg = *(const uint4*)(kg + (size_t)(b * S + kbase + lrow) * 1024 + head * 64 + lc * 8);
        if (tid < 256) rreg = *(const uint4*)(krg + (size_t)(b * S + kbase + (tid >> 2)) * 32 + (tid & 3) * 8);
      } else {
        kreg = *(const uint4*)(kg + (size_t)(b * S + kbase + lrow) * 256 + hkv * 64 + lc * 8);
      }
      vreg = *(const uint4*)(vtg + ((size_t)(b * nheads_kv + hkv) * 64 + lrow) * S + kbase + lc * 8);
    };
    auto write_lds = [&](int st) {
      char* base = lds + st * ASTAGE;
      *(uint4*)(base + lrow * KSTR + lc * 16) = kreg;
      if constexpr (MLA) {
        if (tid < 256) *(uint4*)(base + (tid >> 2) * KSTR + 128 + (tid & 3) * 16) = rreg;
      }
      *(uint4*)(base + KBYTES + lrow * VSTR + lc * 16) = vreg;
    };

    __syncthreads();
    load_regs(t_lo);
    write_lds(0);
    __syncthreads();
#pragma unroll 1
    for (int t = t_lo; t < t_hi; ++t) {
      load_regs((t + 1 < t_hi) ? (t + 1) : t);
      const char* base = lds + ((t - t_lo) & 1) * ASTAGE;
      const int kbase = t * 64;
      bool active = true;
      if constexpr (!MLA) active = (kbase + 63 >= q0 - 128) && (kbase <= q0 + 159);
      if (active) {
        f32x16 sc[2];
        {
          bf16x8 kf[2][NKS];
#pragma unroll
          for (int kb = 0; kb < 2; ++kb)
#pragma unroll
            for (int ks = 0; ks < NKS; ++ks) kf[kb][ks] = *(const bf16x8*)(base + (kb * 32 + r) * KSTR + h * 16 + ks * 32);
#pragma unroll
          for (int kb = 0; kb < 2; ++kb) {
            sc[kb] = MFMA(kf[kb][0], qf[0], negm);
#pragma unroll
            for (int ks = 1; ks < NKS; ++ks) sc[kb] = MFMA(kf[kb][ks], qf[ks], sc[kb]);
          }
        }
        if constexpr (!MLA) {
          const int tq = q0 + r;
#pragma unroll
          for (int kb = 0; kb < 2; ++kb)
#pragma unroll
            for (int i = 0; i < 16; ++i) {
              const int kp = kbase + kb * 32 + crow(i, h);
              int d = kp - tq;
              d = d < 0 ? -d : d;
              sc[kb][i] = (d <= 128) ? (sc[kb][i] - slope2 * (float)d) : -1e30f;
            }
        }
        int imx = max(__float_as_int(sc[0][0]), __float_as_int(sc[1][0]));
#pragma unroll
        for (int i = 1; i < 16; ++i) imx = max(imx, max(__float_as_int(sc[0][i]), __float_as_int(sc[1][i])));
        bool slow = __any(imx > 0x41000000);
        if constexpr (MLA) slow = slow || (t == t_lo);
        if (slow) {
          float mx = fmaxf(sc[0][0], sc[1][0]);
#pragma unroll
          for (int i = 1; i < 16; ++i) mx = fmaxf(mx, fmaxf(sc[0][i], sc[1][i]));
          mx = xhalf_max(mx);
          float delta = fmaxf(mx, 0.f);
          if constexpr (MLA) { if (t == t_lo) delta = mx; }
          float alpha = __builtin_amdgcn_exp2f(-delta);
          if constexpr (MLA) { if (t == t_lo) alpha = 1.f; }
          m_run += delta;
          l_run *= alpha;
#pragma unroll
          for (int i = 0; i < 16; ++i) {
            o[0][i] *= alpha;
            o[1][i] *= alpha;
            sc[0][i] -= delta;
            sc[1][i] -= delta;
            negm[i] = -m_run;
          }
        }
        f32x2_t ps2 = {0.f, 0.f};
        bf16x8 pf[2][2];
#pragma unroll
        for (int kb = 0; kb < 2; ++kb) {
#pragma unroll
          for (int i = 0; i < 16; i += 2) {
            const float p0 = __builtin_amdgcn_exp2f(sc[kb][i]);
            const float p1 = __builtin_amdgcn_exp2f(sc[kb][i + 1]);
            sc[kb][i] = p0;
            sc[kb][i + 1] = p1;
            ps2 += f32x2_t{p0, p1};
          }
#pragma unroll
          for (int sidx = 0; sidx < 2; ++sidx) {
            uint4 u;
            u.x = pack2(sc[kb][8 * sidx + 0], sc[kb][8 * sidx + 1]);
            u.y = pack2(sc[kb][8 * sidx + 2], sc[kb][8 * sidx + 3]);
            u.z = pack2(sc[kb][8 * sidx + 4], sc[kb][8 * sidx + 5]);
            u.w = pack2(sc[kb][8 * sidx + 6], sc[kb][8 * sidx + 7]);
            pf[kb][sidx] = __builtin_bit_cast(bf16x8, u);
          }
        }
        l_run += ps2[0] + ps2[1];
#pragma unroll
        for (int db = 0; db < 2; ++db) {
          const char* lv = base + KBYTES + (db * 32 + r) * VSTR + h * 16;
#pragma unroll
          for (int kb = 0; kb < 2; ++kb)
#pragma unroll
            for (int sidx = 0; sidx < 2; ++sidx) {
              bf16x8 vf = *(const bf16x8*)(lv + kb * 64 + sidx * 32);
              o[db] = MFMA(vf, pf[kb][sidx], o[db]);
            }
        }
      }
      write_lds((t + 1 - t_lo) & 1);
      __syncthreads();
    }
    const float l_tot = l_run + __shfl_xor(l_run, 32);
    const float inv = 1.f / l_tot;
#pragma unroll
    for (int db = 0; db < 2; ++db)
#pragma unroll
      for (int g = 0; g < 4; ++g) {
        const int d = db * 32 + 8 * g + 4 * h;
        const size_t off = (size_t)tokq * 1024 + head * 64 + d;
        const uint2 zz = *(const uint2*)(zg + off);
        const float z0 = bf2f(zz.x & 0xffffu), z1 = bf2f(zz.x >> 16), z2 = bf2f(zz.y & 0xffffu), z3 = bf2f(zz.y >> 16);
        const float g0 = z0 / (1.f + __expf(-z0)), g1 = z1 / (1.f + __expf(-z1)), g2 = z2 / (1.f + __expf(-z2)),
                    g3 = z3 / (1.f + __expf(-z3));
        store4bf(og + off, o[db][4 * g] * inv * g0, o[db][4 * g + 1] * inv * g1, o[db][4 * g + 2] * inv * g2,
                 o[db][4 * g + 3] * inv * g3);
      }
  }
}

typedef __attribute__((ext_vector_type(8))) int i32x8;
#define MFMA8(a, b, c) __builtin_amdgcn_mfma_scale_f32_32x32x64_f8f6f4((a), (b), (c), 0, 0, 0, 0x7f7f7f7f, 0, 0x7f7f7f7f)
DI unsigned pack4_fp8(float a, float b, float c, float d) {
  int r = __builtin_amdgcn_cvt_pk_fp8_f32(a, b, 0, false);
  r = __builtin_amdgcn_cvt_pk_fp8_f32(c, d, r, true);
  return (unsigned)r;
}
DI float clamp8(float x) { return __builtin_amdgcn_fmed3f(x, -440.f, 440.f); }
DI unsigned pack4_fp8c(float a, float b, float c, float d) { return pack4_fp8(clamp8(a), clamp8(b), clamp8(c), clamp8(d)); }
DI int perm64(int s) {
  const int c = (s >> 2) & 15;
  const int pc = ((c & 1) << 3) | (c >> 1);
  return (s & ~63) | (pc << 2) | (s & 3);
}
DI i32x8 ld32(const char* p) {
  const uint4 a = *(const uint4*)p, b = *(const uint4*)(p + 16);
  i32x8 r = {(int)a.x, (int)a.y, (int)a.z, (int)a.w, (int)b.x, (int)b.y, (int)b.z, (int)b.w};
  return r;
}

DI void attn_mla8_phase(const Params& P, char* lds) {
  constexpr int KSTR = 144;
  constexpr int VSTR = 80;
  constexpr int KBYTES = 64 * KSTR;
  constexpr int ASTAGE = KBYTES + 64 * VSTR;
  constexpr float PBIAS = 4.f;
  const int tid = get_tid();
  const int lane = tid & 63, w = tid >> 6;
  const int r = lane & 31, h = lane >> 5;
  char* ws = uniform_ptr(P.ws);
  const unsigned char* qg = (const unsigned char*)(ws + OFF_Q);
  const unsigned char* kg = (const unsigned char*)(ws + OFF_K);
  const unsigned char* vtg = (const unsigned char*)(ws + OFF_VT);
  const unsigned char* krg = (const unsigned char*)(ws + OFF_KR);
  const bf16_t* zg = (const bf16_t*)(ws + OFF_Z);
  bf16_t* og = (bf16_t*)(ws + OFF_HB);

  __syncthreads();
  if (tid < 384) {
    const int zr = tid >> 1, zs = tid >> 7;
    *(uint4*)(lds + zs * ASTAGE + (zr & 63) * KSTR + 96 + (tid & 1) * 16) = make_uint4(0u, 0u, 0u, 0u);
  }
  for (int item = blockIdx.x; item < 2048; item += gridDim.x) {
    const int xcd = item & 7, slot = (item >> 3) & 31, grp = item >> 8;
    const int bh = grp * 8 + xcd;
    const int b = bh >> 4, head = bh & 15;
    const int q0 = slot * 256 + w * 32;
    const int tokq = b * S + q0 + r;
    const unsigned char* qrow = qg + (size_t)tokq * 1536 + head * 96;
    const i32x8 qn = ld32((const char*)qrow + 32 * h);
    i32x8 qr = ld32((const char*)qrow + 64);
    if (h) qr = i32x8{0, 0, 0, 0, 0, 0, 0, 0};

    float m_run = 0.f, l_run = 0.f;
    f32x16 o[2], negm;
#pragma unroll
    for (int i = 0; i < 16; ++i) { o[0][i] = 0.f; o[1][i] = 0.f; negm[i] = PBIAS; }

    const int lrow = (tid & 255) >> 2, lc = tid & 3;
    const bool isk = tid < 256;
    const unsigned char* gmain = isk ? (kg + (size_t)(b * S + lrow) * 1024 + head * 64 + lc * 16)
                                     : (vtg + ((size_t)(b * 16 + head) * 64 + lrow) * S + lc * 16);
    const int gstep = isk ? 65536 : 64;
    const int lmain = isk ? (lrow * KSTR + lc * 16) : (KBYTES + lrow * VSTR + lc * 16);
    const int rrow = (tid & 127) >> 1, rc = tid & 1;
    const unsigned char* grope = krg + (size_t)(b * S + rrow) * 32 + rc * 16;
    const int lrope = rrow * KSTR + 64 + rc * 16;
    uint4 areg, rreg;
    const int trot = (slot * 4) & (S / 64 - 1);
#define MLA8_LOAD(t_)                                             \
  do {                                                            \
    const int tp_ = ((t_) + trot) & (S / 64 - 1);                 \
    areg = *(const uint4*)(gmain + (size_t)tp_ * gstep);          \
    rreg = *(const uint4*)(grope + (size_t)tp_ * 2048);           \
  } while (0)
#define MLA8_WRITE(st_)                                           \
  do {                                                            \
    char* wb_ = lds + (st_) * ASTAGE;                             \
    *(uint4*)(wb_ + lmain) = areg;                                \
    if (tid < 128) *(uint4*)(wb_ + lrope) = rreg;                 \
  } while (0)

    i32x8 kn[2], kr[2];
    __syncthreads();
    MLA8_LOAD(0);
    MLA8_WRITE(0);
    MLA8_LOAD(1);
    MLA8_WRITE(1);
    __syncthreads();
#pragma unroll
    for (int kb = 0; kb < 2; ++kb) {
      const char* lk = lds + (kb * 32 + r) * KSTR;
      kn[kb] = ld32(lk + 32 * h);
      kr[kb] = ld32(lk + 64 + 32 * h);
    }
    int st_cur = 0;
#pragma unroll 1
    for (int t = 0; t < S / 64; ++t) {
      MLA8_LOAD((t + 2 < S / 64) ? (t + 2) : (S / 64 - 1));
      const char* base = lds + st_cur * ASTAGE;
      const int st_nxt = (st_cur == 2) ? 0 : st_cur + 1;
      const int st_wr = (st_nxt == 2) ? 0 : st_nxt + 1;
      f32x16 sc[2];
      i32x8 vf[2];
      vf[0] = ld32(base + KBYTES + r * VSTR + 32 * h);
      vf[1] = ld32(base + KBYTES + (32 + r) * VSTR + 32 * h);
#pragma unroll
      for (int kb = 0; kb < 2; ++kb) {
        sc[kb] = MFMA8(kn[kb], qn, negm);
        sc[kb] = MFMA8(kr[kb], qr, sc[kb]);
      }
      int imx = max(__float_as_int(sc[0][0]), __float_as_int(sc[1][0]));
#pragma unroll
      for (int i = 1; i < 16; ++i) imx = max(imx, max(__float_as_int(sc[0][i]), __float_as_int(sc[1][i])));
      const bool slow = __any(imx > 0x41000000) || (t == 0);
      if (slow) {
        float mx = fmaxf(sc[0][0], sc[1][0]);
#pragma unroll
        for (int i = 1; i < 16; ++i) mx = fmaxf(mx, fmaxf(sc[0][i], sc[1][i]));
        mx = xhalf_max(mx);
        float delta = fmaxf(mx - PBIAS, 0.f);
        float alpha = __builtin_amdgcn_exp2f(-delta);
        if (t == 0) { delta = mx - PBIAS; alpha = 1.f; }
        m_run += delta;
        l_run *= alpha;
#pragma unroll
        for (int i = 0; i < 16; ++i) {
          o[0][i] *= alpha;
          o[1][i] *= alpha;
          sc[0][i] -= delta;
          sc[1][i] -= delta;
          negm[i] = PBIAS - m_run;
        }
      }
      f32x2_t ps2 = {0.f, 0.f};
      i32x8 pb;
#pragma unroll
      for (int kb = 0; kb < 2; ++kb) {
#pragma unroll
        for (int i = 0; i < 16; i += 2) {
          const f32x2_t tt = f32x2_t{sc[kb][i], sc[kb][i + 1]} * f32x2_t{8388608.f, 8388608.f} + f32x2_t{1065353216.f, 1065353216.f};
          const float p0 = __uint_as_float((unsigned)tt[0]);
          const float p1 = __uint_as_float((unsigned)tt[1]);
          sc[kb][i] = p0;
          sc[kb][i + 1] = p1;
          ps2 += f32x2_t{p0, p1};
        }
#pragma unroll
        for (int q4 = 0; q4 < 4; ++q4)
          pb[kb * 4 + q4] = (int)pack4_fp8(sc[kb][4 * q4], sc[kb][4 * q4 + 1], sc[kb][4 * q4 + 2], sc[kb][4 * q4 + 3]);
      }
      l_run += ps2[0] + ps2[1];
#pragma unroll
      for (int db = 0; db < 2; ++db) {
        o[db] = MFMA8(vf[db], pb, o[db]);
      }
      {
        const char* nb = lds + st_nxt * ASTAGE;
#pragma unroll
        for (int kb = 0; kb < 2; ++kb) {
          const char* lk = nb + (kb * 32 + r) * KSTR;
          kn[kb] = ld32(lk + 32 * h);
          kr[kb] = ld32(lk + 64 + 32 * h);
        }
      }
      MLA8_WRITE(st_wr);
      __syncthreads();
      st_cur = st_nxt;
    }
    const float l_tot = l_run + __shfl_xor(l_run, 32);
    const float inv = 1.f / l_tot;
#pragma unroll
    for (int db = 0; db < 2; ++db)
#pragma unroll
      for (int g = 0; g < 4; ++g) {
        const int d = db * 32 + 8 * g + 4 * h;
        const size_t off = (size_t)tokq * 1024 + head * 64 + d;
        const uint2 zz = *(const uint2*)(zg + off);
        const float z0 = bf2f(zz.x & 0xffffu), z1 = bf2f(zz.x >> 16), z2 = bf2f(zz.y & 0xffffu), z3 = bf2f(zz.y >> 16);
        const float g0 = z0 / (1.f + __expf(-z0)), g1 = z1 / (1.f + __expf(-z1)), g2 = z2 / (1.f + __expf(-z2)),
                    g3 = z3 / (1.f + __expf(-z3));
        const float i64 = inv * 16.f;
        *(unsigned*)((unsigned char*)og + off) = pack4_fp8c(o[db][4 * g] * i64 * g0, o[db][4 * g + 1] * i64 * g1, o[db][4 * g + 2] * i64 * g2,
                                                         o[db][4 * g + 3] * i64 * g3);
      }
  }
#undef MLA8_LOAD
#undef MLA8_WRITE
}

DI void final_phase(const Params& P) {
  const int tid = get_tid();
  const int w = tid >> 6, lane = tid & 63;
  const int rstride = gridDim.x * 8;
  float4 g4[4];
#pragma unroll
  for (int i = 0; i < 4; ++i) g4[i] = ((const float4*)P.final_g)[lane + 64 * i];
  for (int row = blockIdx.x * 8 + w; row < T; row += 4 * rstride) {
    float4 v[4][4];
#pragma unroll
    for (int u = 0; u < 4; ++u) {
      const int ru = (row + u * rstride < T) ? (row + u * rstride) : row;
      const float4* xr = (const float4*)(P.out + (size_t)ru * DM);
#pragma unroll
      for (int i = 0; i < 4; ++i) v[u][i] = xr[lane + 64 * i];
    }
#pragma unroll
    for (int u = 0; u < 4; ++u) {
      const int ru = row + u * rstride;
      float s = 0.f;
#pragma unroll
      for (int i = 0; i < 4; ++i) s += v[u][i].x * v[u][i].x + v[u][i].y * v[u][i].y + v[u][i].z * v[u][i].z + v[u][i].w * v[u][i].w;
#pragma unroll
      for (int o = 32; o >= 1; o >>= 1) s += __shfl_xor(s, o);
      const float rstd = rsqrtf(s * (1.f / 1024.f) + EPS);
      if (ru < T) {
        float4* xw = (float4*)(P.out + (size_t)ru * DM);
#pragma unroll
        for (int i = 0; i < 4; ++i)
          xw[lane + 64 * i] = make_float4(v[u][i].x * rstd * g4[i].x, v[u][i].y * rstd * g4[i].y, v[u][i].z * rstd * g4[i].z, v[u][i].w * rstd * g4[i].w);
      }
    }
  }
}

#define XB_TMO      128
#define XB_XCNT(j)  (256  + 64 * (j))
#define XB_XSUB(j)  (1280 + 64 * (j))
#define XB_XGEN(j)  (2304 + 64 * (j))
#define XB_TOP      3328
#define XB_TOPGEN   3392
#define XCD_BAR_WORDS 3456
#define XB_SPIN_CAP (1u << 22)
#define LAS __attribute__((address_space(3)))
DI unsigned xb_ld(unsigned* p) { return __hip_atomic_load(p, __ATOMIC_RELAXED, __HIP_MEMORY_SCOPE_AGENT); }
DI unsigned xb_add(unsigned* p, unsigned v) { return __hip_atomic_fetch_add(p, v, __ATOMIC_RELAXED, __HIP_MEMORY_SCOPE_AGENT); }
DI unsigned xb_xcc_id() { return (unsigned)__builtin_amdgcn_s_getreg((3 << 11) | 20) & 0xFu; }
#define XB_SPIN(cond, bar) do { unsigned _sp = 0; while (cond) { __builtin_amdgcn_s_sleep(1); \
    if ((++_sp & 255u) == 0u) { if (xb_ld(&(bar)[XB_TMO])) break; if (_sp > XB_SPIN_CAP) { atomicAdd(&(bar)[XB_TMO], 1u); break; } } } } while (0)
struct XcdBarrier {
  unsigned* bar;
  unsigned x;
  volatile LAS unsigned* st;
};
DI XcdBarrier xcd_barrier_post(unsigned* bar, volatile LAS unsigned* st) {
  XcdBarrier b;
  b.bar = bar;
  b.x = xb_xcc_id();
  b.st = st;
  if (threadIdx.x == 0) (void)xb_add(&bar[XB_XCNT(b.x)], 1u);
  return b;
}
DI void xcd_barrier_complete(unsigned* bar, unsigned x, unsigned& nloc, unsigned& nx) {
  const unsigned G = gridDim.x * gridDim.y * gridDim.z;
  unsigned sum, cnt, mine, sp = 0u;
  for (;;) {
    sum = 0u; cnt = 0u; mine = 0u;
#pragma unroll
    for (unsigned j = 0; j < 16; ++j) {
      const unsigned c = xb_ld(&bar[XB_XCNT(j)]);
      sum += c;
      cnt += (c > 0u) ? 1u : 0u;
      mine = (j == x) ? c : mine;
    }
    if (sum == G) break;
    __builtin_amdgcn_s_sleep(1);
    if ((++sp & 255u) == 0u) { if (xb_ld(&bar[XB_TMO])) break; if (sp > XB_SPIN_CAP) { atomicAdd(&bar[XB_TMO], 1u); break; } }
  }
  nloc = mine > 0u ? mine : 1u;
  nx = cnt > 0u ? cnt : 1u;
}
DI void xcd_barrier(const XcdBarrier& b) {
  asm volatile("s_waitcnt vmcnt(0)" ::: "memory");
  __syncthreads();
  if (threadIdx.x == 0) {
    unsigned* bar = b.bar;
    __builtin_amdgcn_s_waitcnt(0);
    unsigned nloc = b.st[0], nx = b.st[1];
    if (nloc == 0u) { xcd_barrier_complete(bar, b.x, nloc, nx); b.st[0] = nloc; b.st[1] = nx; }
    const unsigned old = xb_add(&bar[XB_XSUB(b.x)], 1u);
    const unsigned gen = old / nloc;
    if (old + 1u == (gen + 1u) * nloc) {
      __builtin_amdgcn_fence(__ATOMIC_RELEASE, "agent");
      asm volatile("s_waitcnt vmcnt(0)" ::: "memory");
      const unsigned og = xb_add(&bar[XB_TOP], 1u);
      const unsigned tg = og / nx;
      if (og + 1u == (tg + 1u) * nx) xb_add(&bar[XB_TOPGEN], 1u);
      else XB_SPIN(xb_ld(&bar[XB_TOPGEN]) == tg, bar);
      __builtin_amdgcn_fence(__ATOMIC_ACQUIRE, "agent");
      xb_add(&bar[XB_XGEN(b.x)], 1u);
      asm volatile("s_waitcnt vmcnt(0)" ::: "memory");
    } else {
      XB_SPIN(xb_ld(&bar[XB_XGEN(b.x)]) == gen, bar);
      __builtin_amdgcn_fence(__ATOMIC_ACQUIRE, "agent");
      asm volatile("s_waitcnt vmcnt(0)" ::: "memory");
    }
  }
  __syncthreads();
}

constexpr int NPHASE = 1 + 2 * (4 + 5) + 1;

DI void run_phase(const Params& P, int ph, char* lds) {
  if (ph == 0) { prep_phase(P, lds); return; }
  if (ph == NPHASE - 1) { final_phase(P); return; }
  const int q = (ph - 1) / 9, rr = (ph - 1) % 9;
  if (rr < 4) {
    const int layer = q * 2;
    if (rr == 0) gemm_phase<EPI_A_IN>(P, layer, lds);
    else if (rr == 1) attn_phase<false>(P, layer, lds);
    else if (rr == 2) gemm_phase<EPI_OUT>(P, layer, lds);
    else gemm_phase<EPI_PLE>(P, layer, lds);
  } else {
    const int layer = q * 2 + 1;
    if (rr == 4) gemm_phase<EPI_B_IN>(P, layer, lds);
    else if (rr == 5) gemm_phase<EPI_QKV_UP>(P, layer, lds);
    else if (rr == 6) attn_phase<true>(P, layer, lds);
    else if (rr == 7) gemm_phase<EPI_OUT>(P, layer, lds);
    else gemm_phase<EPI_PLE>(P, layer, lds);
  }
}

__global__ void __launch_bounds__(NTHREADS) fwd_kernel(Params P) {
  __shared__ __attribute__((aligned(1024))) char lds[LDS_BYTES + 16];
#if MULTI_LAUNCH
  run_phase(P, P.phase_lo, lds);
#else
  cg::grid_group grid = cg::this_grid();
  volatile LAS unsigned* xst = (volatile LAS unsigned*)(lds + LDS_BYTES);
  if (threadIdx.x == 0) { xst[0] = 0u; xst[1] = 0u; }
  __syncthreads();
  const XcdBarrier xb = xcd_barrier_post((unsigned*)(P.ws + OFF_BAR), xst);
  prep_phase(P, lds);
#if (PROBE_REPEAT >> 9) & 1
  prep_phase(P, lds);
#endif
  grid.sync();
#pragma unroll 1
  for (int q = 0; q < 2; ++q) {
    const int la = 2 * q, lb = 2 * q + 1;
    gemm_phase<EPI_A_IN>(P, la, lds);
#if (PROBE_REPEAT >> 0) & 1
    gemm_phase<EPI_A_IN>(P, la, lds);
#endif
    GSYNC();
    attn_phase<false>(P, la, lds);
#if (PROBE_REPEAT >> 1) & 1
    attn_phase<false>(P, la, lds);
#endif
    GSYNC();
    gemm_phase<EPI_OUT>(P, la, lds);
    GSYNC();
    gemm_phase<EPI_PLE>(P, la, lds);
    GSYNC();
    gemm_phase<EPI_B_IN>(P, lb, lds);
#if (PROBE_REPEAT >> 4) & 1
    gemm_phase<EPI_B_IN>(P, lb, lds);
#endif
    GSYNC();
    gemm_phase<EPI_QKV_UP>(P, lb, lds);
#if (PROBE_REPEAT >> 5) & 1
    gemm_phase<EPI_QKV_UP>(P, lb, lds);
#endif
    GSYNC();
    attn_mla8_phase(P, lds);
#if (PROBE_REPEAT >> 6) & 1
    attn_mla8_phase(P, lds);
#endif
    GSYNC();
    gemm_phase<EPI_OUT>(P, lb, lds);
    GSYNC();
    gemm_phase<EPI_PLE>(P, lb, lds);
    GSYNC();
  }
  final_phase(P);
#endif
}

static void add_seg(Params& p, int& tiles, const float* src, const float* gain, bf16_t* dst, int src_ld, int ncols, int K, int fp8 = 0) {
  Seg& s = p.seg[p.nseg++];
  s.src = src;
  s.gain = gain;
  s.dst = dst;
  s.src_ld = src_ld;
  s.ncols = ncols;
  s.K = K;
  s.fp8 = fp8;
  s.pad0 = 0;
  s.tile0 = tiles;
  tiles += (K / 64) * (ncols / 32);
}

extern "C" void kernel_launch(void* const* d_in, const int* in_sizes, int n_in, void* d_out, int out_size, void* d_ws,
                              size_t ws_size, hipStream_t stream) {
  (void)in_sizes; (void)n_in; (void)out_size;
  if (ws_size < WS_NEEDED) {
    fprintf(stderr, "workspace too small: %zu < %zu\n", ws_size, (size_t)WS_NEEDED);
    return;
  }
  const float* x = (const float*)d_in[0];
  const float* pp = (const float*)d_in[1];
  const float* norm_g = (const float*)d_in[2];
  const float* a_w_in = (const float*)d_in[3];
  const float* a_sink = (const float*)d_in[4];
  const float* a_w_out = (const float*)d_in[5];
  const float* b_w_in = (const float*)d_in[6];
  const float* b_q_norm = (const float*)d_in[7];
  const float* b_w_qb = (const float*)d_in[8];
  const float* b_kv_norm = (const float*)d_in[9];
  const float* b_w_kvb = (const float*)d_in[10];
  const float* b_w_out = (const float*)d_in[11];
  const float* ple_w = (const float*)d_in[12];
  const float* ple_norm_g = (const float*)d_in[13];
  const float* ple_w_gate = (const float*)d_in[14];
  const float* final_g = (const float*)d_in[15];

  Params p;
  memset(&p, 0, sizeof(p));
  p.x = x;
  p.p = pp;
  p.a_sink = a_sink;
  p.final_g = final_g;
  p.out = (float*)d_out;
  p.ws = (char*)d_ws;
  bf16_t* wb = (bf16_t*)((char*)d_ws + OFF_W);
  int tiles = 0;
  for (int j = 0; j < 2; ++j) {
    const int la = 2 * j, lb = 2 * j + 1;
    add_seg(p, tiles, a_w_in + (size_t)j * 1024 * 2560, norm_g + la * 1024, wb + W_A_IN + (size_t)j * 2560 * 1024, 2560, 2560, 1024);
    add_seg(p, tiles, a_w_out + (size_t)j * 1024 * 1024, nullptr, wb + W_A_OUT + (size_t)j * 1024 * 1024, 1024, 1024, 1024);
    const float* bsrc = b_w_in + (size_t)j * 1024 * 1696;
    unsigned char* bdst = (unsigned char*)(wb + W_B_IN + (size_t)j * 1792 * 1024);
    const float* gb = norm_g + lb * 1024;
    add_seg(p, tiles, bsrc + 672, gb, (bf16_t*)bdst, 1696, 1024, 1024, 1);
    add_seg(p, tiles, bsrc + 0, gb, (bf16_t*)(bdst + (size_t)1024 * 1024), 1696, 384, 1024, 1);
    add_seg(p, tiles, bsrc + 384, gb, (bf16_t*)(bdst + (size_t)1408 * 1024), 1696, 256, 1024, 1);
    add_seg(p, tiles, bsrc + 640, gb, (bf16_t*)(bdst + (size_t)1664 * 1024), 1696, 32, 1024, 1);
    add_seg(p, tiles, nullptr, nullptr, (bf16_t*)(bdst + (size_t)1696 * 1024), 1696, 96, 1024, 1);
    add_seg(p, tiles, b_w_qb + (size_t)j * 384 * 1536, b_q_norm + j * 384, wb + W_B_QB + (size_t)j * 1536 * 384, 1536, 1536, 384, 1);
    add_seg(p, tiles, b_w_kvb + (size_t)j * 256 * 2048, b_kv_norm + j * 256, wb + W_B_KVB + (size_t)j * 2048 * 256, 2048, 2048, 256, 1);
    add_seg(p, tiles, b_w_out + (size_t)j * 1024 * 1024, nullptr, wb + W_B_OUT + (size_t)j * 1024 * 1024, 1024, 1024, 1024, 1);
  }
  for (int i = 0; i < 4; ++i) {
    add_seg(p, tiles, ple_w + (size_t)i * 256 * 1024, nullptr, wb + W_PLE + (size_t)i * 1024 * 256, 1024, 1024, 256);
    add_seg(p, tiles, ple_w_gate + (size_t)i * 1024 * 1024, ple_norm_g + i * 1024, wb + W_GATE + (size_t)i * 1024 * 1024, 1024, 1024, 1024);
  }
  p.ntile_w = tiles;

#if MULTI_LAUNCH
  for (int ph = 0; ph < NPHASE; ++ph) {
    p.phase_lo = ph;
    p.phase_hi = ph + 1;
    hipLaunchKernelGGL(fwd_kernel, dim3(1024), dim3(NTHREADS), 0, stream, p);
  }
#else
  static int grid_blocks = 0;
  if (!grid_blocks) {
    int dev = 0, cus = 0, per_cu = 0;
    hipGetDevice(&dev);
    hipDeviceGetAttribute(&cus, hipDeviceAttributeMultiprocessorCount, dev);
    hipOccupancyMaxActiveBlocksPerMultiprocessor(&per_cu, fwd_kernel, NTHREADS, 0);
    if (per_cu < 1) per_cu = 1;
    if (per_cu > 1) per_cu = 1;
    grid_blocks = cus * per_cu;
  }
  p.phase_lo = 0;
  p.phase_hi = NPHASE;
  (void)hipMemsetAsync((char*)d_ws + OFF_BAR, 0, 16384, stream);
  void* args[] = {&p};
  hipError_t e = hipLaunchCooperativeKernel((void*)fwd_kernel, dim3(grid_blocks), dim3(NTHREADS), args, 0, stream);
  if (e != hipSuccess) fprintf(stderr, "cooperative launch failed: %s (grid %d)\n", hipGetErrorString(e), grid_blocks);
#endif
}
```
